# Optimizing an MI355X kernel written in HIP

```python
import jax, jax.numpy as jnp
from jax import lax
import numpy as np

D_MODEL = 1024
BATCH = 8
SEQ = 2048
DEPTH = 4

CTX_LEN = 256
GRID_W = 64
MIX_WIDTH = D_MODEL
POOL_WIDTH = MIX_WIDTH // 2
POOL_GROUPS = 4
POOL_GROUP_W = POOL_WIDTH // POOL_GROUPS
POOL_WINDOWS = (2, 4, 8, 16)
GLA_WIDTH = MIX_WIDTH - POOL_WIDTH
GLA_HEADS = 4
GLA_DV = GLA_WIDTH // GLA_HEADS
GLA_DK = GLA_DV // 2
GLA_QK = GLA_HEADS * GLA_DK
GATE_RANK = 16
GATE_NORM = 16.0
CHUNK = 32
N_EXPERTS = 16
N_GROUPS = 4
EXPERTS_PER_GROUP = N_EXPERTS // N_GROUPS
TOP_K = 2
D_EXPERT = D_MODEL // 2
MOE_BLOCK = 128
N_MOD = 6
EPS = 1e-6
IN_SPLITS = (POOL_WIDTH, POOL_WIDTH + GLA_QK, POOL_WIDTH + 2 * GLA_QK,
             POOL_WIDTH + 2 * GLA_QK + GLA_WIDTH, POOL_WIDTH + 2 * GLA_QK + 2 * GLA_WIDTH)
IN_WIDTH = IN_SPLITS[-1] + 2 * GATE_RANK

kernel_name = "hybrid_pool_gla_moe_prefix_dit"


def _rmsnorm(x, gain):
    xf = x.astype(jnp.float32)
    y = xf * lax.rsqrt(jnp.mean(xf * xf, axis=-1, keepdims=True) + EPS)
    return (y * gain.astype(jnp.float32)).astype(x.dtype)


def _modulation(cvec, w_mod, b_mod):
    return jnp.split(jax.nn.silu(cvec) @ w_mod + b_mod, N_MOD, axis=-1)


def _box_mean(u, axis, w):
    L = u.shape[axis]
    idx = np.arange(L)
    lo = np.clip(idx - w // 2, 0, L)
    hi = np.clip(idx + w - w // 2, 0, L)
    pad = [(0, 0)] * u.ndim
    pad[axis] = (1, 0)
    cs = jnp.pad(jnp.cumsum(u, axis=axis), pad)
    total = jnp.take(cs, hi, axis=axis) - jnp.take(cs, lo, axis=axis)
    cnt = (hi - lo).astype(np.float32).reshape((L,) + (1,) * (u.ndim - axis - 1))
    return total / cnt


def _pool_mixer(u, w_pool, pool_scale, grid):
    B, L, _ = u.shape
    uf = u.astype(jnp.float32)
    if grid:
        rows = L // GRID_W
        ug = uf.reshape(B, rows, GRID_W, POOL_GROUPS, POOL_GROUP_W)
        means = [_box_mean(_box_mean(ug[..., g, :], 1, w), 2, w) for g, w in enumerate(POOL_WINDOWS)]
    else:
        ug = uf.reshape(B, L, POOL_GROUPS, POOL_GROUP_W)
        means = [_box_mean(ug[..., g, :], 1, w) for g, w in enumerate(POOL_WINDOWS)]
    pooled = jnp.stack(means, axis=-2).reshape(B, L, POOL_GROUPS, POOL_GROUP_W) \
        - uf.reshape(B, L, POOL_GROUPS, POOL_GROUP_W)
    mixed = jnp.einsum('blgc,gcd->blgd', pooled, w_pool)
    return (mixed.reshape(B, L, POOL_WIDTH) * pool_scale).astype(u.dtype)


def _split_proj(p, w_gk2, b_gk):
    B, L, _ = p.shape
    u, q, k, v, g, r = jnp.split(p, IN_SPLITS, axis=-1)
    heads = lambda t, d: t.reshape(B, L, GLA_HEADS, d).transpose(0, 2, 1, 3)
    q = heads(q, GLA_DK) * (GLA_DK ** -0.5)
    k = heads(k, GLA_DK)
    v = heads(v, GLA_DV)
    r = r.reshape(B, L, 2, GATE_RANK)
    logit = jnp.einsum('blnr,nrk->nblk', r, w_gk2) + b_gk[:, None, None, :]
    lg = jax.nn.log_sigmoid(logit.astype(jnp.float32)) / GATE_NORM
    lg = lg.reshape(2, B, L, GLA_HEADS, GLA_DK).transpose(0, 1, 3, 2, 4)
    return u, q, k, v, g, lg


def _gla_chunked(q, k, v, lg, s0):
    B, H, L, dk = q.shape
    dv = v.shape[-1]
    n = L // CHUNK
    q = q.reshape(B, H, n, CHUNK, dk)
    k = k.reshape(B, H, n, CHUNK, dk)
    v = v.reshape(B, H, n, CHUNK, dv)
    b = jnp.cumsum(lg.reshape(B, H, n, CHUNK, dk), axis=3)
    b_last = b[:, :, :, -1:, :]
    mask = np.tril(np.ones((CHUNK, CHUNK), dtype=bool))[:, :, None]
    decay = jnp.exp(jnp.where(mask, b[..., :, None, :] - b[..., None, :, :], -jnp.inf))
    scores = jnp.einsum('bhnid,bhnjd,bhnijd->bhnij', q, k, decay)
    o_intra = jnp.einsum('bhnij,bhnje->bhnie', scores, v)
    kv = jnp.einsum('bhncd,bhnce->bhnde', k * jnp.exp(b_last - b), v)
    chunk_decay = jnp.exp(b_last[:, :, :, 0, :])

    def step(S, inp):
        a, kvn = inp
        return a[..., None] * S + kvn, S

    s_final, s_prev = lax.scan(step, s0, (jnp.moveaxis(chunk_decay, 2, 0), jnp.moveaxis(kv, 2, 0)))
    s_prev = jnp.moveaxis(s_prev, 0, 2)
    o_inter = jnp.einsum('bhncd,bhnde->bhnce', q * jnp.exp(b), s_prev)
    return (o_intra + o_inter).reshape(B, H, L, dv), s_final


def _mix_out(u, o, g, grid, w_pool, pool_scale, gla_gain, w_out):
    B, L, _ = u.shape
    pool = _pool_mixer(u, w_pool, pool_scale, grid)
    o = _rmsnorm(o, gla_gain).transpose(0, 2, 1, 3).reshape(B, L, GLA_WIDTH)
    gla = (o * jax.nn.silu(g)).astype(u.dtype)
    return jnp.concatenate([pool, gla], axis=-1) @ w_out


def _mixer(hx, hc, w_in, w_gk2, b_gk, w_pool, pool_scale, gla_gain, w_out, need_ctx):
    ux, qx, kx, vx, gx, lgx = _split_proj(hx @ w_in, w_gk2, b_gk)
    uc, qc, kc, vc, gc, lgc = _split_proj(hc @ w_in, w_gk2, b_gk)
    B = hx.shape[0]
    zero = jnp.zeros((B, GLA_HEADS, GLA_DK, GLA_DV), jnp.float32)
    flip = lambda t: jnp.flip(t, axis=2)
    oc_f, s_f = _gla_chunked(qc, kc, vc, lgc[0], zero)
    ox_f, _ = _gla_chunked(qx, kx, vx, lgx[0], s_f)
    oc_b, s_b = _gla_chunked(flip(qc), flip(kc), flip(vc), flip(lgc[1]), zero)
    ox_b, _ = _gla_chunked(flip(qx), flip(kx), flip(vx), flip(lgx[1]), s_b)
    yx = _mix_out(ux, ox_f + flip(ox_b), gx, True, w_pool, pool_scale, gla_gain, w_out)
    yc = _mix_out(uc, oc_f + flip(oc_b), gc, False, w_pool, pool_scale, gla_gain, w_out) if need_ctx else None
    return yx, yc


def _moe(xf, w_router, router_bias, w1, w3, w2):
    T, D = xf.shape
    s = jax.nn.sigmoid((xf @ w_router).astype(jnp.float32))
    sb = (s + router_bias).reshape(T, N_GROUPS, EXPERTS_PER_GROUP)
    group_score = lax.top_k(sb, 2)[0].sum(-1)
    gsel = jnp.argmax(group_score, axis=-1)
    in_group = jnp.take_along_axis(sb, gsel[:, None, None], axis=1)[:, 0]
    _, loc = lax.top_k(in_group, TOP_K)
    eidx = gsel[:, None] * EXPERTS_PER_GROUP + loc
    wts = jnp.take_along_axis(s, eidx, axis=1)
    wts = wts / jnp.sum(wts, axis=-1, keepdims=True)
    flat_e = eidx.reshape(-1)
    order = jnp.argsort(flat_e)
    se = flat_e[order]
    tok = order // TOP_K
    counts = jnp.bincount(flat_e, length=N_EXPERTS)
    padded = (counts + MOE_BLOCK - 1) // MOE_BLOCK * MOE_BLOCK
    start = jnp.cumsum(counts) - counts
    pend = jnp.cumsum(padded)
    pstart = pend - padded
    dest = pstart[se] + (jnp.arange(T * TOP_K) - start[se])
    n_blocks = (T * TOP_K + N_EXPERTS * (MOE_BLOCK - 1) + MOE_BLOCK - 1) // MOE_BLOCK
    xb = jnp.zeros((n_blocks * MOE_BLOCK, D), xf.dtype).at[dest].set(xf[tok])
    block_e = jnp.clip(jnp.searchsorted(pend, jnp.arange(n_blocks) * MOE_BLOCK, side='right'), 0, N_EXPERTS - 1)

    def expert_block(args):
        xblk, e = args
        return (jax.nn.silu(xblk @ w1[e]) * (xblk @ w3[e])) @ w2[e]

    yb = lax.map(expert_block, (xb.reshape(n_blocks, MOE_BLOCK, D), block_e)).reshape(-1, D)
    y = (yb[dest] * wts.reshape(-1)[order][:, None]).astype(xf.dtype)
    return jnp.zeros_like(xf).at[tok].add(y)


def setup_inputs(seed: int = 0) -> dict:
    key = jax.random.key(seed)
    ks = jax.random.split(key, 22)
    nrm = lambda kk, shape, scale: scale * jax.random.normal(kk, shape, jnp.float32)
    return {
        "x": nrm(ks[0], (BATCH, SEQ, D_MODEL), 1.0),
        "c": nrm(ks[1], (BATCH, D_MODEL), 1.0),
        "ctx": nrm(ks[2], (BATCH, CTX_LEN, D_MODEL), 1.0),
        "c_ctx": nrm(ks[3], (D_MODEL,), 1.0),
        "w_mod": nrm(ks[4], (DEPTH, D_MODEL, N_MOD * D_MODEL), 0.5 * D_MODEL ** -0.5),
        "b_mod": nrm(ks[5], (DEPTH, N_MOD * D_MODEL), 0.02),
        "norm1": 1.0 + nrm(ks[6], (DEPTH, D_MODEL), 0.05),
        "norm2": 1.0 + nrm(ks[7], (DEPTH, D_MODEL), 0.05),
        "w_in": nrm(ks[8], (DEPTH, D_MODEL, IN_WIDTH), D_MODEL ** -0.5),
        "w_gk2": nrm(ks[9], (DEPTH, 2, GATE_RANK, GLA_QK), GATE_RANK ** -0.5),
        "b_gk": nrm(ks[10], (DEPTH, 2, GLA_QK), 0.5),
        "w_pool": nrm(ks[11], (DEPTH, POOL_GROUPS, POOL_GROUP_W, POOL_GROUP_W), POOL_GROUP_W ** -0.5),
        "pool_scale": 1.0 + nrm(ks[12], (DEPTH, POOL_WIDTH), 0.1),
        "gla_gain": 1.0 + nrm(ks[13], (DEPTH, GLA_DV), 0.05),
        "w_out": nrm(ks[14], (DEPTH, MIX_WIDTH, D_MODEL), MIX_WIDTH ** -0.5),
        "w_router": nrm(ks[15], (D_MODEL, N_EXPERTS), D_MODEL ** -0.5),
        "router_bias": nrm(ks[16], (N_EXPERTS,), 0.01),
        "w1": nrm(ks[17], (DEPTH, N_EXPERTS, D_MODEL, D_EXPERT), D_MODEL ** -0.5),
        "w3": nrm(ks[18], (DEPTH, N_EXPERTS, D_MODEL, D_EXPERT), D_MODEL ** -0.5),
        "w2": nrm(ks[19], (DEPTH, N_EXPERTS, D_EXPERT, D_MODEL), D_EXPERT ** -0.5),
        "norm_f": 1.0 + nrm(ks[20], (D_MODEL,), 0.05),
    }


def reference(x, c, ctx, c_ctx, w_mod, b_mod, norm1, norm2, w_in, w_gk2, b_gk, w_pool, pool_scale,
              gla_gain, w_out, w_router, router_bias, w1, w3, w2, norm_f):
    B, S, D = x.shape
    for l in range(DEPTH):
        keep_ctx = l < DEPTH - 1
        sx1, cx1, gx1, sx2, cx2, gx2 = [m[:, None, :] for m in _modulation(c, w_mod[l], b_mod[l])]
        sc1, cc1, gc1, sc2, cc2, gc2 = _modulation(c_ctx, w_mod[l], b_mod[l])
        hx = _rmsnorm(x, norm1[l]) * (1.0 + cx1) + sx1
        hc = _rmsnorm(ctx, norm1[l]) * (1.0 + cc1) + sc1
        yx, yc = _mixer(hx, hc, w_in[l], w_gk2[l], b_gk[l], w_pool[l], pool_scale[l], gla_gain[l], w_out[l],
                        keep_ctx)
        x = x + gx1 * yx
        hx = _rmsnorm(x, norm2[l]) * (1.0 + cx2) + sx2
        if keep_ctx:
            ctx = ctx + gc1 * yc
            hc = _rmsnorm(ctx, norm2[l]) * (1.0 + cc2) + sc2
            tokens = jnp.concatenate([hx.reshape(-1, D), hc.reshape(-1, D)], axis=0)
            out = _moe(tokens, w_router, router_bias, w1[l], w3[l], w2[l])
            x = x + gx2 * out[:B * S].reshape(x.shape)
            ctx = ctx + gc2 * out[B * S:].reshape(ctx.shape)
        else:
            x = x + gx2 * _moe(hx.reshape(-1, D), w_router, router_bias, w1[l], w3[l], w2[l]).reshape(x.shape)
    return _rmsnorm(x, norm_f)
```

```cpp
#define FUSED 1
#include <hip/hip_runtime.h>
#include <cstdio>
#include <cstdint>
typedef unsigned short bf16_t;
constexpr int D = 1024, NB = 8, SEQ = 2048, DEPTH = 4, CTXL = 256;
constexpr int NX = NB * SEQ, NC = NB * CTXL, NT = NX + NC;
constexpr int INW = 2080, PLD = 2304, NE = 16, DE = 512;
constexpr int NCH = 36;
constexpr int MAXSLOT = 41216;
constexpr size_t MiB = 1u << 20;
constexpr size_t WS_CTL = 0, CTL_BYTES = 1 * MiB;
constexpr size_t WS_MOD = 1 * MiB;
constexpr size_t WS_WPOOL = 2 * MiB;
constexpr size_t WS_WGP = 2 * MiB + 512 * 1024;
constexpr size_t WS_WRP = 2 * MiB + 640 * 1024;
constexpr size_t WS_TOK = 3 * MiB;
constexpr size_t WS_WTS = 3 * MiB + 256 * 1024;
constexpr size_t WS_NEIDX = 3 * MiB + 512 * 1024;
constexpr size_t WS_NWTS = 3 * MiB + 768 * 1024;
constexpr size_t WS_LIST = 4 * MiB;
constexpr size_t WS_WIN = 6 * MiB;
constexpr size_t WS_WOUT = 24 * MiB;
constexpr size_t WS_W13 = 32 * MiB;
constexpr size_t WS_W2 = 160 * MiB;
constexpr size_t WS_XC = 224 * MiB;
constexpr size_t WS_HB = 232 * MiB;
constexpr size_t WS_P = 268 * MiB;
constexpr size_t WS_KVS = 349 * MiB;
constexpr size_t WS_ADEC = 385 * MiB;
constexpr size_t WS_HID = 386 * MiB;
constexpr size_t WS_XB = 427 * MiB;
constexpr size_t WS_END = 463 * MiB;

struct In {
    const float *x, *c, *ctx, *c_ctx, *w_mod, *b_mod, *norm1, *norm2, *w_in, *w_gk2, *b_gk, *w_pool, *pool_scale, *gla_gain, *w_out, *w_router, *router_bias, *w1, *w3, *w2, *norm_f;
};

__host__ __device__ __forceinline__ unsigned f2bf(float f) { unsigned u = __builtin_bit_cast(unsigned, f); return (u + 0x7fffu + ((u >> 16) & 1u)) >> 16; }
__host__ __device__ __forceinline__ float bf2f(bf16_t h) { return __builtin_bit_cast(float, (unsigned)h << 16); }
typedef float pk2_f32x2 __attribute__((ext_vector_type(2)));
typedef __bf16 pk2_bf16x2 __attribute__((ext_vector_type(2)));
__device__ __forceinline__ unsigned pk2(float lo, float hi) { const pk2_f32x2 v = {lo, hi}; return __builtin_bit_cast(unsigned, __builtin_convertvector(v, pk2_bf16x2)); }
__device__ __forceinline__ float silu_f(float x) { return x / (1.f + expf(-x)); }
__device__ __forceinline__ float sigmoid_f(float x) { return 1.f / (1.f + expf(-x)); }
__device__ __forceinline__ float logsigmoid_f(float x) { return fminf(x, 0.f) - log1pf(expf(-fabsf(x))); }
__device__ __forceinline__ int variant_of_row(int row) { return row < NX ? (row >> 11) : 8; }
__device__ __forceinline__ float* resid_row(float* xl, float* xc, int row) { return row < NX ? xl + (size_t)row * D : xc + (size_t)(row - NX) * D; }
__device__ __forceinline__ int chunk_row0(int b, int j) { return j < 4 ? NX + b * CTXL + j * 64 : b * SEQ + (j - 4) * 64; }
#define GAS __attribute__((address_space(1)))
#define LAS __attribute__((address_space(3)))
typedef unsigned v4u __attribute__((ext_vector_type(4)));
typedef unsigned v2u __attribute__((ext_vector_type(2)));
typedef float f32x4 __attribute__((ext_vector_type(4)));
typedef float f32x16 __attribute__((ext_vector_type(16)));
typedef short bf16x8 __attribute__((ext_vector_type(8)));
typedef GAS unsigned gu32;
#define RLX_AGENT __ATOMIC_RELAXED, __HIP_MEMORY_SCOPE_AGENT
#define LDS_WAIT() asm volatile("s_waitcnt lgkmcnt(0)" ::: "memory")
#define VM_WAIT() asm volatile("s_waitcnt vmcnt(0)" ::: "memory")
constexpr int NWAVES = 8, NTHR = 512;
constexpr int RING_BYTES = 131072;
constexpr int LDSCTL_OFF = RING_BYTES, MISC_OFF = LDSCTL_OFF + 320;
constexpr int LDS_BYTES = 147456;
constexpr int CW_BAR = 4096;
constexpr int CW_ECNT = 8192;
constexpr int CW_CVT = 16384;

__device__ __forceinline__ float wave_sum(float v) {
    v += __builtin_bit_cast(float, __builtin_amdgcn_update_dpp(0, __builtin_bit_cast(int, v), 0xB1, 0xF, 0xF, true));
    v += __builtin_bit_cast(float, __builtin_amdgcn_update_dpp(0, __builtin_bit_cast(int, v), 0x4E, 0xF, 0xF, true));
    v += __builtin_bit_cast(float, __builtin_amdgcn_update_dpp(0, __builtin_bit_cast(int, v), 0x141, 0xF, 0xF, true));
    v += __builtin_bit_cast(float, __builtin_amdgcn_update_dpp(0, __builtin_bit_cast(int, v), 0x140, 0xF, 0xF, true));
    const int iv = __builtin_bit_cast(int, v);
    const float r0 = __builtin_bit_cast(float, __builtin_amdgcn_readlane(iv, 0)), r1 = __builtin_bit_cast(float, __builtin_amdgcn_readlane(iv, 16));
    const float r2 = __builtin_bit_cast(float, __builtin_amdgcn_readlane(iv, 32)), r3 = __builtin_bit_cast(float, __builtin_amdgcn_readlane(iv, 48));
    return (r0 + r1) + (r2 + r3);
}

#define XB_TMO      128
#define XB_XCNT(j)  (256  + 64 * (j))
#define XB_XSUB(j)  (1280 + 64 * (j))
#define XB_XGEN(j)  (2304 + 64 * (j))
#define XB_TOP      3328
#define XB_TOPGEN   3392
#define XCD_BAR_WORDS 3456
#define XB_SPIN_CAP (1u << 18)
__device__ __forceinline__ unsigned xb_ld(unsigned* p)              { return __hip_atomic_load(p, __ATOMIC_RELAXED, __HIP_MEMORY_SCOPE_AGENT); }
__device__ __forceinline__ unsigned xb_add(unsigned* p, unsigned v) { return __hip_atomic_fetch_add(p, v, __ATOMIC_RELAXED, __HIP_MEMORY_SCOPE_AGENT); }
__device__ __forceinline__ unsigned xb_xcc_id() { return (unsigned)__builtin_amdgcn_s_getreg((3 << 11) | 20) & 0xFu; }
#define XB_SPIN(cond, bar) do { unsigned _sp = 0; while (cond) { __builtin_amdgcn_s_sleep(1); \
    if ((++_sp & 255u) == 0u) { if (xb_ld(&(bar)[XB_TMO])) break; if (_sp > XB_SPIN_CAP) { atomicAdd(&(bar)[XB_TMO], 1u); break; } } } } while (0)
struct XcdBarrier { unsigned* bar; unsigned x; volatile LAS unsigned* st; };
__device__ __forceinline__ XcdBarrier xcd_barrier_post(unsigned* bar, volatile LAS unsigned* st) {
    XcdBarrier b; b.bar = bar; b.x = xb_xcc_id(); b.st = st;
    if (threadIdx.x == 0) (void)xb_add(&bar[XB_XCNT(b.x)], 1u);
    return b;
}
__device__ __forceinline__ void xcd_barrier(const XcdBarrier& b) {
    asm volatile("s_waitcnt vmcnt(0)" ::: "memory");
    __syncthreads();
    if (threadIdx.x < 64 && b.st[0] == 0u) {
        unsigned* bar = b.bar; const unsigned G = gridDim.x * gridDim.y * gridDim.z; const int lane = threadIdx.x; unsigned sp = 0u, c, sum, cnt;
        for (;;) {
            c = lane < 16 ? xb_ld(&bar[XB_XCNT(lane)]) : 0u; sum = c; cnt = c > 0u ? 1u : 0u;
#pragma unroll
            for (int o = 1; o < 16; o <<= 1) { sum += __shfl_xor(sum, o); cnt += __shfl_xor(cnt, o); }
            sum = __builtin_amdgcn_readfirstlane(sum); cnt = __builtin_amdgcn_readfirstlane(cnt);
            if (sum == G) break;
            __builtin_amdgcn_s_sleep(1);
            if ((++sp & 255u) == 0u) { if (__builtin_amdgcn_readfirstlane(xb_ld(&bar[XB_TMO]))) break; if (sp > XB_SPIN_CAP) { if (lane == 0) atomicAdd(&bar[XB_TMO], 1u); break; } }
        }
        const unsigned mine = __builtin_amdgcn_readlane(c, b.x);
        if (lane == 0) { b.st[0] = mine > 0u ? mine : 1u; b.st[1] = cnt > 0u ? cnt : 1u; }
        asm volatile("s_waitcnt lgkmcnt(0)" ::: "memory");
    }
    if (threadIdx.x == 0) {
        unsigned* bar = b.bar;
        __builtin_amdgcn_s_waitcnt(0);
        const unsigned nloc = b.st[0], nx = b.st[1];
        const unsigned old = xb_add(&bar[XB_XSUB(b.x)], 1u);
        const unsigned gen = old / nloc;
        if (old + 1u == (gen + 1u) * nloc) {
            __builtin_amdgcn_fence(__ATOMIC_RELEASE, "agent");
            asm volatile("s_waitcnt vmcnt(0)" ::: "memory");
            const unsigned og = xb_add(&bar[XB_TOP], 1u);
            const unsigned tg = og / nx;
            if (og + 1u == (tg + 1u) * nx) xb_add(&bar[XB_TOPGEN], 1u);
            else XB_SPIN(xb_ld(&bar[XB_TOPGEN]) == tg, bar);
            __builtin_amdgcn_fence(__ATOMIC_ACQUIRE, "agent");
            xb_add(&bar[XB_XGEN(b.x)], 1u);
            asm volatile("s_waitcnt vmcnt(0)" ::: "memory");
        } else {
            XB_SPIN(xb_ld(&bar[XB_XGEN(b.x)]) == gen, bar);
            __builtin_amdgcn_fence(__ATOMIC_ACQUIRE, "agent");
            asm volatile("s_waitcnt vmcnt(0)" ::: "memory");
        }
    }
    __syncthreads();
}

namespace pg8 {
constexpr int BM = 256, BK = 64, HALF = 128, HTB = HALF * BK * 2, STAGE_BYTES = 8 * HTB, NXCD = 8, WGM = 8;
__host__ __device__ __forceinline__ int lds_byte(int r, int c) { const int st = (r >> 4) * 2 + (c >> 5), rr = r & 15, cc = c & 31, ob = rr * 64 + cc * 2; return st * 1024 + (ob ^ (((ob >> 9) & 1) << 5)); }
__host__ __device__ __forceinline__ void stage_rc(int b, int& R, int& C) { const int st = b / 1024, sb = b % 1024, swz = sb ^ (((sb >> 9) & 1) << 5); R = (st >> 1) * 16 + swz / 64; C = (st & 1) * 32 + (swz % 64) / 2; }
__host__ __device__ __forceinline__ int perm32(int rho) { const int n = rho >> 4, i = rho & 15; return 8 * (i >> 2) + 4 * n + (i & 3); }

struct Unit { int pm, pn, e, ti; };

struct TileOrder {
    int nM, nN, nwg, G, c;
    __device__ void init(int nM_, int nN_, int G_, int c_) { nM = nM_; nN = nN_; nwg = nM * nN; G = G_; c = c_; }
    __device__ bool tile(int i, int& pm, int& pn) const {
        const long L = (long)i * G + c; if (L >= nwg) return false;
        int wgid = (int)L; { const int q = nwg / NXCD, r = nwg % NXCD, xcd = wgid % NXCD, off = wgid / NXCD; wgid = (xcd < r ? xcd * (q + 1) : r * (q + 1) + (xcd - r) * q) + off; }
        const int nig = WGM * nN, gid = wgid / nig, fm = gid * WGM, gsz = (nM - fm) < WGM ? (nM - fm) : WGM;
        pm = fm + ((wgid % nig) % gsz); pn = (wgid % nig) / gsz; return true;
    }
};
struct GCfg {
    TileOrder T; const char* Abase; const char* Bbase; int K; int amode, bmode; size_t bexp; const int* list; const LAS int* tab;
    int emode;
    bf16_t* O; int ldc;
    float* xl; float* xc; const float* MODl; int gidx; float gscale;
    __device__ __forceinline__ bool next(int i, Unit& u) const {
        u.e = 0; u.ti = 0; if (!T.tile(i, u.pm, u.pn)) return false;
        if (bmode) { int e = 0;
#pragma unroll
            for (int j = 1; j < 16; ++j) e += (u.pm >= tab[j]) ? 1 : 0;
            u.e = e; u.ti = u.pm - tab[e]; }
        return true; }
    __device__ __forceinline__ const char* b_base(const Unit& u) const { return Bbase + (size_t)u.e * bexp + (size_t)u.pn * BM * K * 2; }
    __device__ __forceinline__ unsigned a_off(const Unit& u, int h, int R, int C) const {
        if (amode) { const int cnt = tab[32 + u.e]; int pos = u.ti * BM + h * HALF + R; pos = pos < cnt ? pos : cnt - 1; const int src = list[u.e * NT + pos]; return (unsigned)((src * K + C) * 2); }
        return (unsigned)(((u.pm * BM + h * HALF + R) * K + C) * 2); }
    __device__ __forceinline__ bool perm() const { return emode != 2; }
    __device__ __forceinline__ void epi(const f32x4 (&acc)[2][2][4][2], const Unit& u, int wr, int wc, int fr, int fq) const {
        if (emode == 0) {
            const int row0 = u.pm * BM + wr * 64 + fr; const int col0 = u.pn * BM + wc * 32 + 8 * fq;
#pragma unroll
            for (int ai = 0; ai < 2; ++ai)
#pragma unroll
                for (int m = 0; m < 4; ++m) { bf16_t* rowp = O + (size_t)(row0 + ai * HALF + m * 16) * ldc + col0;
#pragma unroll
                    for (int bj = 0; bj < 2; ++bj) { const f32x4 v0 = acc[ai][bj][m][0], v1 = acc[ai][bj][m][1];
                        v4u w; w.x = pk2(v0[0], v0[1]); w.y = pk2(v0[2], v0[3]); w.z = pk2(v1[0], v1[1]); w.w = pk2(v1[2], v1[3]);
                        if (ldc == D) __builtin_nontemporal_store(w, (v4u*)(rowp + bj * HALF)); else *(v4u*)(rowp + bj * HALF) = w; } }
        } else if (emode == 1) {
            const int rowt = u.pm * BM; const int v = rowt < NX ? (rowt >> 11) : 8;
            const float* gate = MODl + (size_t)v * 6144 + gidx * D; const float gsc = gscale;
            const int row0 = rowt + wr * 64 + fr; const int col0 = u.pn * BM + wc * 32 + 8 * fq;
            f32x4 gv[2][2];
#pragma unroll
            for (int bj = 0; bj < 2; ++bj)
#pragma unroll
                for (int n = 0; n < 2; ++n) gv[bj][n] = *(const f32x4*)(gate + col0 + bj * HALF + 4 * n) * gsc;
#pragma unroll
            for (int ai = 0; ai < 2; ++ai) {
                v4u xw[4][2];
#pragma unroll
                for (int m = 0; m < 4; ++m)
#pragma unroll
                    for (int bj = 0; bj < 2; ++bj) xw[m][bj] = *(const v4u*)(O + (size_t)(row0 + ai * HALF + m * 16) * D + col0 + bj * HALF);
#pragma unroll
                for (int m = 0; m < 4; ++m) { bf16_t* rowp = O + (size_t)(row0 + ai * HALF + m * 16) * D + col0;
#pragma unroll
                    for (int bj = 0; bj < 2; ++bj) { v4u* p = (v4u*)(rowp + bj * HALF); const v4u w = xw[m][bj];
                        const f32x4 x0 = {__builtin_bit_cast(float, w.x << 16), __builtin_bit_cast(float, w.x & 0xffff0000u), __builtin_bit_cast(float, w.y << 16), __builtin_bit_cast(float, w.y & 0xffff0000u)};
                        const f32x4 x1 = {__builtin_bit_cast(float, w.z << 16), __builtin_bit_cast(float, w.z & 0xffff0000u), __builtin_bit_cast(float, w.w << 16), __builtin_bit_cast(float, w.w & 0xffff0000u)};
                        const f32x4 y0 = x0 + gv[bj][0] * acc[ai][bj][m][0], y1 = x1 + gv[bj][1] * acc[ai][bj][m][1];
                        v4u o; o.x = pk2(y0[0], y0[1]); o.y = pk2(y0[2], y0[3]); o.z = pk2(y1[0], y1[1]); o.w = pk2(y1[2], y1[3]); *p = o; } }
            }
        } else {
            const int row0 = u.pm * BM + wr * 64 + fr; const int j0 = u.pn * 128 + wc * 32 + 8 * fq;
#pragma unroll
            for (int ai = 0; ai < 2; ++ai)
#pragma unroll
                for (int m = 0; m < 4; ++m) { float hv[8];
#pragma unroll
                    for (int bj = 0; bj < 2; ++bj)
#pragma unroll
                        for (int i = 0; i < 4; ++i) { const float a = acc[ai][bj][m][0][i], b = acc[ai][bj][m][1][i]; hv[bj * 4 + i] = a * b * __builtin_amdgcn_rcpf(1.f + __expf(-a)); }
                    v4u w; w.x = pk2(hv[0], hv[1]); w.y = pk2(hv[2], hv[3]); w.z = pk2(hv[4], hv[5]); w.w = pk2(hv[6], hv[7]);
                    *(v4u*)(O + (size_t)(row0 + ai * HALF + m * 16) * DE + j0) = w; }
        }
    }
};

__device__ __forceinline__ void gemm_phase(LAS unsigned char* lds, const GCfg& S) {
    const char* const Abase = S.Abase; const int K = S.K; const bool PERMB = S.perm();
    int tid_ = threadIdx.x; asm volatile("" : "+v"(tid_));
    const int tid = tid_, wid = __builtin_amdgcn_readfirstlane(tid >> 6), lane = tid & 63, wr = wid >> 2, wc = wid & 3, fr = lane & 15, fq = lane >> 4;
    const int nt = K / BK;
    int sR[2], sC[2]; unsigned voffB[2];
#pragma unroll
    for (int i = 0; i < 2; ++i) { stage_rc(tid * 16 + i * 8192, sR[i], sC[i]); const int Rb = PERMB ? ((sR[i] & ~31) + perm32(sR[i] & 31)) : sR[i]; voffB[i] = (unsigned)(Rb * K + sC[i]) * 2u; }
    const unsigned kstep = (unsigned)(BK * 2);
    const size_t hstepB = (size_t)HALF * K * 2;
    const unsigned ldsw = (unsigned)wid * 1024u;
    const int aoff = lds_byte(wr * 64 + fr, fq * 8), boff = lds_byte(wc * 32 + fr, fq * 8);
#define PG8_SA(b, h) (((b) * 2 + (h)) * HTB)
#define PG8_SB(b, h) ((4 + (b) * 2 + (h)) * HTB)
#define PG8_STAGE_B(bufoff, gbase) do { _Pragma("unroll") for (int _i = 0; _i < 2; ++_i) \
        __builtin_amdgcn_global_load_lds((const unsigned*)((const char*)(gbase) + voffB[_i]), (LAS unsigned*)(lds + (bufoff) + ldsw + _i * 8192), 16, 0, 0); } while (0)
#define PG8_STAGE_A(bufoff, o0, o1, kb) do { \
        __builtin_amdgcn_global_load_lds((const unsigned*)(Abase + (size_t)((o0) + (kb))), (LAS unsigned*)(lds + (bufoff) + ldsw), 16, 0, 0); \
        __builtin_amdgcn_global_load_lds((const unsigned*)(Abase + (size_t)((o1) + (kb))), (LAS unsigned*)(lds + (bufoff) + ldsw + 8192), 16, 0, 0); } while (0)
#define PG8_LDA(dst, b, h) do { _Pragma("unroll") for (int m = 0; m < 4; ++m) _Pragma("unroll") for (int k = 0; k < 2; ++k) dst[m][k] = *(const LAS bf16x8*)(lds + PG8_SA(b, h) + aoff + m * 2048 + k * 1024); } while (0)
#define PG8_LDB(dst, b, h) do { _Pragma("unroll") for (int n = 0; n < 2; ++n) _Pragma("unroll") for (int k = 0; k < 2; ++k) dst[n][k] = *(const LAS bf16x8*)(lds + PG8_SB(b, h) + boff + n * 2048 + k * 1024); } while (0)
#define PG8_MMA(ai, bj, At, Bt) do { __builtin_amdgcn_s_setprio(1); _Pragma("unroll") for (int m = 0; m < 4; ++m) _Pragma("unroll") for (int n = 0; n < 2; ++n) _Pragma("unroll") for (int k = 0; k < 2; ++k) \
        acc[ai][bj][m][n] = __builtin_amdgcn_mfma_f32_16x16x32_bf16(Bt[n][k], At[m][k], acc[ai][bj][m][n], 0, 0, 0); __builtin_amdgcn_s_setprio(0); } while (0)
#define PG8_WAIT_V(n) asm volatile("s_waitcnt vmcnt(" #n ")" ::: "memory")
#define PG8_WAIT_L(n) asm volatile("s_waitcnt lgkmcnt(" #n ")" ::: "memory")
#define PG8_BAR __builtin_amdgcn_s_barrier()
#define PG8_SCHED __builtin_amdgcn_sched_barrier(0)
    Unit cur, nxt; int ui = 0;
    if (!S.next(0, cur)) return;
    f32x4 acc[2][2][4][2];
#pragma unroll
    for (int a = 0; a < 2; ++a)
#pragma unroll
        for (int b = 0; b < 2; ++b)
#pragma unroll
            for (int m = 0; m < 4; ++m)
#pragma unroll
                for (int n = 0; n < 2; ++n) acc[a][b][m][n] = (f32x4){0.f, 0.f, 0.f, 0.f};
    bf16x8 At[4][2], B0[2][2], B1[2][2];
    unsigned c00 = S.a_off(cur, 0, sR[0], sC[0]), c01 = S.a_off(cur, 0, sR[1], sC[1]), c10 = S.a_off(cur, 1, sR[0], sC[0]), c11 = S.a_off(cur, 1, sR[1], sC[1]);
    const char* cB = S.b_base(cur);
    PG8_STAGE_B(PG8_SB(0, 0), cB); PG8_STAGE_B(PG8_SB(0, 1), cB + hstepB); PG8_STAGE_A(PG8_SA(0, 0), c00, c01, 0u); PG8_STAGE_A(PG8_SA(0, 1), c10, c11, 0u);
    if (wr == 1) PG8_BAR;
    PG8_WAIT_V(2); PG8_BAR;
    PG8_STAGE_B(PG8_SB(1, 0), cB + kstep); PG8_STAGE_A(PG8_SA(1, 0), c00, c01, kstep); PG8_STAGE_B(PG8_SB(1, 1), cB + hstepB + kstep);
    PG8_WAIT_V(6); PG8_BAR;
    for (;;) {
        const bool has_next = S.next(ui + 1, nxt);
        const char* nB = cB; unsigned n00 = c00, n01 = c01, n10 = c10, n11 = c11;
        if (has_next) {
            int t2 = tid; asm volatile("" : "+v"(t2)); int r0_, c0_, r1_, c1_; stage_rc(t2 * 16, r0_, c0_); stage_rc(t2 * 16 + 8192, r1_, c1_);
            n00 = S.a_off(nxt, 0, r0_, c0_); n01 = S.a_off(nxt, 0, r1_, c1_); n10 = S.a_off(nxt, 1, r0_, c0_); n11 = S.a_off(nxt, 1, r1_, c1_); nB = S.b_base(nxt); }
        for (int t = 0; t < nt; t += 2) {
            const bool last = (t == nt - 2);
            const unsigned k1 = (unsigned)(t + 1) * kstep;
            const unsigned k2 = last ? 0u : (unsigned)(t + 2) * kstep, k3 = k2 + kstep;
            const unsigned s00 = last ? n00 : c00, s01 = last ? n01 : c01, s10 = last ? n10 : c10, s11 = last ? n11 : c11;
            const char* b2 = last ? nB : cB + (size_t)(t + 2) * kstep; const char* b3 = b2 + kstep;
            const bool relax = (t == 0 && ui > 0);
            PG8_LDB(B0, 0, 0); PG8_LDB(B1, 0, 1); PG8_SCHED; PG8_LDA(At, 0, 0); PG8_STAGE_A(PG8_SA(1, 1), c10, c11, k1);
            if (relax) { if (S.emode == 2) PG8_WAIT_V(16); else PG8_WAIT_V(24); } else PG8_WAIT_V(8);
            PG8_WAIT_L(0); PG8_BAR; PG8_MMA(0, 0, At, B0); PG8_MMA(0, 1, At, B1); PG8_BAR; PG8_SCHED;
            PG8_LDA(At, 0, 1); PG8_STAGE_B(PG8_SB(0, 0), b2); PG8_STAGE_B(PG8_SB(0, 1), b2 + hstepB); PG8_STAGE_A(PG8_SA(0, 0), s00, s01, k2);
            if (relax) { if (S.emode == 2) PG8_WAIT_V(16); else PG8_WAIT_V(24); } else PG8_WAIT_V(8);
            PG8_WAIT_L(0); PG8_BAR; PG8_MMA(1, 0, At, B0); PG8_MMA(1, 1, At, B1); PG8_BAR; PG8_SCHED;
            PG8_LDB(B0, 1, 0); PG8_LDB(B1, 1, 1); PG8_SCHED; PG8_LDA(At, 1, 0); PG8_STAGE_A(PG8_SA(0, 1), s10, s11, k2);
            PG8_WAIT_V(8); PG8_WAIT_L(0); PG8_BAR; PG8_MMA(0, 0, At, B0); PG8_MMA(0, 1, At, B1); PG8_BAR; PG8_SCHED;
            PG8_LDA(At, 1, 1); PG8_STAGE_B(PG8_SB(1, 0), b3); PG8_STAGE_B(PG8_SB(1, 1), b3 + hstepB); PG8_STAGE_A(PG8_SA(1, 0), s00, s01, k3);
            PG8_WAIT_V(8); PG8_WAIT_L(0); PG8_BAR; PG8_MMA(1, 0, At, B0); PG8_MMA(1, 1, At, B1); PG8_BAR; PG8_SCHED;
        }
        if (wr == 0) PG8_BAR;
        S.epi(acc, cur, wr, wc, fr, fq);
        if (!has_next) break;
#pragma unroll
        for (int a = 0; a < 2; ++a)
#pragma unroll
            for (int b = 0; b < 2; ++b)
#pragma unroll
                for (int m = 0; m < 4; ++m)
#pragma unroll
                    for (int n = 0; n < 2; ++n) acc[a][b][m][n] = (f32x4){0.f, 0.f, 0.f, 0.f};
        cur = nxt; c00 = n00; c01 = n01; c10 = n10; c11 = n11; cB = nB; ++ui;
        if (wr == 1) PG8_BAR;
    }
    PG8_WAIT_V(0);
    PG8_BAR;
#undef PG8_SA
#undef PG8_SB
#undef PG8_STAGE_A
#undef PG8_STAGE_B
#undef PG8_LDA
#undef PG8_LDB
#undef PG8_MMA
#undef PG8_WAIT_V
#undef PG8_WAIT_L
#undef PG8_BAR
#undef PG8_SCHED
}
}
struct Args { In in; float* out; unsigned char* ws; int ph_lo, ph_hi, flags, pad; };
typedef const __attribute__((address_space(4))) Args* KArgs;
__device__ __forceinline__ KArgs kargs() { KArgs a = (KArgs)__builtin_amdgcn_kernarg_segment_ptr(); asm volatile("" : "+s"(a)); return a; }
struct Ctx {
    LAS unsigned char* lds; int tid, lane, wave, G, bid;
};
extern __shared__ __attribute__((aligned(16))) unsigned char lds_raw[];
__device__ __forceinline__ Ctx mkctx() { Ctx F; int t = threadIdx.x; asm volatile("" : "+v"(t)); F.lds = (LAS unsigned char*)lds_raw; F.tid = t; F.lane = t & 63; F.wave = __builtin_amdgcn_readfirstlane(t >> 6); F.G = gridDim.x; F.bid = blockIdx.x; return F; }

struct MapIdent { float qs; int qlo, qhi; __device__ __forceinline__ int row(int n) const { return n; } __device__ __forceinline__ float scale(int n) const { return (n >= qlo && n < qhi) ? qs : 1.f; } };
struct MapW13 { int sel; __device__ __forceinline__ int row(int j) const { return 256 * (j >> 7) + 128 * ((j >> 2) & 1) + 32 * ((j >> 5) & 3) + 16 * sel + 4 * ((j >> 3) & 3) + (j & 3); } __device__ __forceinline__ float scale(int) const { return 1.f; } };
template <bool DEEP, class Map>
__device__ __forceinline__ void transpose_item(const float* W, int ldn, int k0, int n0, bf16_t* WT, int ldk, LAS float* scr, int lane, const Map& map) {
    if (DEEP) {
        float ld[32];
#pragma unroll
        for (int i = 0; i < 32; ++i) ld[i] = W[(size_t)(k0 + 2 * i + (lane >> 5)) * ldn + n0 + (lane & 31)];
#pragma unroll
        for (int i = 0; i < 32; ++i) scr[(2 * i + (lane >> 5)) * 33 + (lane & 31)] = ld[i];
    } else {
#pragma unroll 8
        for (int i = 0; i < 32; ++i) { const int kk = 2 * i + (lane >> 5); scr[kk * 33 + (lane & 31)] = W[(size_t)(k0 + kk) * ldn + n0 + (lane & 31)]; }
    }
    LDS_WAIT(); asm volatile("" ::: "memory");
    const int c = lane & 7;
#pragma unroll
    for (int j = 0; j < 4; ++j) { const int n = (lane >> 3) + 8 * j; const LAS float* s = scr + (8 * c) * 33 + n; const float sc = map.scale(n0 + n);
        v4u o; o.x = pk2(s[0 * 33] * sc, s[1 * 33] * sc); o.y = pk2(s[2 * 33] * sc, s[3 * 33] * sc); o.z = pk2(s[4 * 33] * sc, s[5 * 33] * sc); o.w = pk2(s[6 * 33] * sc, s[7 * 33] * sc);
        *(GAS v4u*)(WT + (size_t)map.row(n0 + n) * ldk + k0 + 8 * c) = o; }
    LDS_WAIT(); asm volatile("" ::: "memory");
}

template <bool DEEP>
__device__ __forceinline__ void convert_layer_items(const Ctx& F, KArgs A, int l, int widx, int nw) {
    unsigned char* const ws = A->ws;
    LAS float* scr = (LAS float*)(F.lds + F.wave * 16384);
    bf16_t* WIN = (bf16_t*)(ws + WS_WIN) + (size_t)l * PLD * D; bf16_t* WOUT = (bf16_t*)(ws + WS_WOUT) + (size_t)l * D * D;
    bf16_t* W13 = (bf16_t*)(ws + WS_W13) + (size_t)l * NE * 1024 * D; bf16_t* W2 = (bf16_t*)(ws + WS_W2) + (size_t)l * NE * D * DE; bf16_t* WPL = (bf16_t*)(ws + WS_WPOOL) + (size_t)l * 4 * 128 * 128;
    constexpr int I_IN = 16 * 65, I_OUT = 16 * 32, I_W1 = NE * 256, I_W2 = NE * 256, I_PL = 4 * 8, I_Z = 224;
    constexpr int NITEMS = I_IN + I_OUT + 2 * I_W1 + I_W2 + I_PL + I_Z;
    for (int it = widx; it < NITEMS; it += nw) {
        int r = it;
        if (r < I_IN) { const int kb = r / 65, nb = r % 65;
            transpose_item<DEEP>(A->in.w_in + (size_t)l * D * INW, INW, kb * 64, nb * 32, WIN, D, scr, F.lane, MapIdent{0.125f, 512, 768}); continue; } r -= I_IN;
        if (r < I_OUT) { const int kb = r / 32, nb = r % 32;
            transpose_item<DEEP>(A->in.w_out + (size_t)l * D * D, D, kb * 64, nb * 32, WOUT, D, scr, F.lane, MapIdent{1.f, 0, 0}); continue; } r -= I_OUT;
        if (r < 2 * I_W1) { const int sel = r >= I_W1; if (sel) r -= I_W1; const int e = r / 256, q = r % 256, kb = q / 16, nb = q % 16;
            transpose_item<DEEP>((sel ? A->in.w3 : A->in.w1) + ((size_t)l * NE + e) * D * DE, DE, kb * 64, nb * 32, W13 + (size_t)e * 1024 * D, D, scr, F.lane, MapW13{sel}); continue; } r -= 2 * I_W1;
        if (r < I_W2) { const int e = r / 256, q = r % 256, kb = q / 32, nb = q % 32;
            transpose_item<DEEP>(A->in.w2 + ((size_t)l * NE + e) * DE * D, D, kb * 64, nb * 32, W2 + (size_t)e * D * DE, DE, scr, F.lane, MapIdent{1.f, 0, 0}); continue; } r -= I_W2;
        if (r < I_PL) { const int g = r / 8, q = r % 8, kb = q / 4, nb = q % 4;
            transpose_item<DEEP>(A->in.w_pool + ((size_t)l * 4 + g) * 128 * 128, 128, kb * 64, nb * 32, WPL + (size_t)g * 128 * 128, 128, scr, F.lane, MapIdent{1.f, 0, 0}); continue; } r -= I_PL;
        { const int row = INW + r; v4u z = {0u, 0u, 0u, 0u}; GAS v4u* p = (GAS v4u*)(WIN + (size_t)row * D) + F.lane; p[0] = z; p[64] = z; }
    }
}

__device__ __forceinline__ void convert_from_cursor(int l, int max_rounds) {
    const Ctx F = mkctx(); KArgs A = kargs();
    gu32* cur = (gu32*)(A->ws + WS_CTL) + CW_CVT + l * 64;
    volatile LAS unsigned* slot = (volatile LAS unsigned*)(F.lds + LDSCTL_OFF + 256);
    constexpr int NITEMS = 16 * 65 + 16 * 32 + 3 * NE * 256 + 4 * 8 + 224;
    for (int r = 0; max_rounds < 0 || r < max_rounds; ++r) {
        if (F.tid == 0) *slot = __hip_atomic_fetch_add(cur, 8u, RLX_AGENT);
        __syncthreads();
        const int start = (int)*slot;
        __syncthreads();
        if (start >= NITEMS) break;
        convert_layer_items<true>(F, A, l, start + F.wave, NITEMS + 8);
    }
}

__device__ __forceinline__ void p0_prologue() {
    const Ctx F = mkctx(); KArgs A = kargs(); unsigned char* const ws = A->ws;
    {
        LAS float* sc = (LAS float*)F.lds;
        LAS float* red = (LAS float*)(F.lds + 9 * 1024 * 4);
        for (int i = F.tid; i < 9 * 1024; i += NTHR) { const int v = i >> 10, k = i & 1023; const float cv = v < 8 ? A->in.c[v * D + k] : A->in.c_ctx[k]; sc[i] = silu_f(cv); }
        __syncthreads();
        float* MOD = (float*)(ws + WS_MOD);
        for (int it = F.bid; it < DEPTH * 96; it += F.G) {
            const int l = it / 96, j0 = (it % 96) * 64;
            const float* w = A->in.w_mod + ((size_t)l * D + F.wave * 128) * 6144 + j0 + F.lane;
            float acc[9];
#pragma unroll
            for (int v = 0; v < 9; ++v) acc[v] = 0.f;
            for (int k0 = 0; k0 < 128; k0 += 32) { float wv[32];
#pragma unroll
                for (int kk = 0; kk < 32; ++kk) wv[kk] = w[(size_t)(k0 + kk) * 6144];
#pragma unroll
                for (int kk = 0; kk < 32; ++kk) {
#pragma unroll
                    for (int v = 0; v < 9; ++v) acc[v] += sc[v * 1024 + F.wave * 128 + k0 + kk] * wv[kk]; } }
#pragma unroll
            for (int v = 0; v < 9; ++v) red[(F.wave * 9 + v) * 64 + F.lane] = acc[v];
            __syncthreads();
            for (int o = F.tid; o < 9 * 64; o += NTHR) { const int v = o >> 6, jj = o & 63; float s = 0.f;
#pragma unroll
                for (int wv = 0; wv < 8; ++wv) s += red[(wv * 9 + v) * 64 + jj];
                MOD[((size_t)l * 9 + v) * 6144 + j0 + jj] = s + A->in.b_mod[l * 6144 + j0 + jj]; }
            __syncthreads();
        }
    }
    { bf16_t* WGP = (bf16_t*)(ws + WS_WGP);
      for (int i = F.bid * NTHR + F.tid; i < DEPTH * 2 * 4 * 64 * 16; i += F.G * NTHR) { const int r = i & 15, d = (i >> 4) & 63, h = (i >> 10) & 3, n = (i >> 12) & 1, l = i >> 13;
          const float w = A->in.w_gk2[((size_t)(l * 2 + n) * 16 + r) * 256 + h * 64 + d]; const unsigned hi = f2bf(w); const float rem = w - __builtin_bit_cast(float, hi << 16);
          bf16_t* o = WGP + (size_t)l * 2 * 2 * 4 * 64 * 16 + ((size_t)(n * 4 + h) * 64 + d) * 16 + r; o[0] = (bf16_t)hi; o[2 * 4 * 64 * 16] = (bf16_t)f2bf(rem); } }
    { bf16_t* WRP = (bf16_t*)(ws + WS_WRP);
      for (int i = F.bid * NTHR + F.tid; i < NE * D; i += F.G * NTHR) { const int e = i & 15, k = i >> 4; const float w = A->in.w_router[i]; const unsigned hi = f2bf(w); const float rem = w - __builtin_bit_cast(float, hi << 16);
          WRP[(size_t)e * D + k] = (bf16_t)hi; WRP[(size_t)NE * D + (size_t)e * D + k] = (bf16_t)f2bf(rem); } }
    convert_layer_items<false>(F, A, 0, F.bid * NWAVES + F.wave, F.G * NWAVES);
}

template <bool FINAL, bool FROMIN>
__device__ __forceinline__ void rowpass_n1(int l, bool combine, int nrows, bool zero_w) {
    const Ctx F = mkctx(); KArgs A = kargs(); unsigned char* const ws = A->ws; float* const outp = A->out; gu32* const ctl = (gu32*)(ws + WS_CTL);
    const int gw = F.bid * NWAVES + F.wave, NGW = F.G * NWAVES;
    bf16_t* XB = (bf16_t*)(ws + WS_XB);
    const float* MOD = (const float*)(ws + WS_MOD);
    bf16_t* H = (bf16_t*)(ws + WS_HB);
    const bf16_t* YB = (const bf16_t*)(ws + WS_P);
    const int* TOK = (const int*)(ws + WS_TOK); const float* WTS = (const float*)(ws + WS_WTS);
    LAS int* pst = (LAS int*)(F.lds);
    if (combine) {
        if (F.tid < NE) pst[32 + F.tid] = (int)__hip_atomic_load(ctl + CW_ECNT + ((l - 1) * NE + F.tid) * 64, RLX_AGENT);
        __syncthreads();
        if (F.tid == 0) { int run = 0; for (int e = 0; e < NE; ++e) { pst[e] = run; run += ((pst[32 + e] + 255) >> 8) << 8; } }
        __syncthreads();
    }
    const int rpw = nrows / NGW, row_base = gw * rpw;
    const int c0l = 4 * F.lane;
    int vcur = -1; f32x4 gt[4], st[4], g2v[4];
    if (FINAL) {
#pragma unroll
        for (int j = 0; j < 4; ++j) gt[j] = *(const GAS f32x4*)(A->in.norm_f + c0l + 256 * j);
    }
    v2u pxb[3][4]; f32x4 pxf[3][4]; int pt0[3], pt1[3]; float pw0[3], pw1[3];
#define N1_LOAD_GROUP(G0) do { _Pragma("unroll") for (int r = 0; r < 3; ++r) { const int rr = ((G0) + r < rpw) ? (G0) + r : rpw - 1; const int row = row_base + rr; \
        if (FROMIN) { const float* src = row < NX ? A->in.x + (size_t)row * D : A->in.ctx + (size_t)(row - NX) * D; _Pragma("unroll") for (int j = 0; j < 4; ++j) pxf[r][j] = *(const GAS f32x4*)(src + c0l + 256 * j); } \
        else { _Pragma("unroll") for (int j = 0; j < 4; ++j) pxb[r][j] = *(const GAS v2u*)(XB + (size_t)row * D + c0l + 256 * j); } \
        pt0[r] = 0; pt1[r] = 0; pw0[r] = 0.f; pw1[r] = 0.f; \
        if (combine) { pt0[r] = TOK[row * 2]; pt1[r] = TOK[row * 2 + 1]; pw0[r] = WTS[row * 2]; pw1[r] = WTS[row * 2 + 1]; } } } while (0)
    N1_LOAD_GROUP(0);
    for (int g0 = 0; g0 < rpw; g0 += 3) {
        int rows[3]; bool valid[3]; f32x4 x[3][4]; int t0[3], t1[3]; float w0[3], w1[3];
#pragma unroll
        for (int r = 0; r < 3; ++r) { valid[r] = g0 + r < rpw; rows[r] = row_base + (valid[r] ? g0 + r : rpw - 1); t0[r] = pt0[r]; t1[r] = pt1[r]; w0[r] = zero_w ? 0.f : pw0[r]; w1[r] = zero_w ? 0.f : pw1[r];
#pragma unroll
            for (int j = 0; j < 4; ++j) { if (FROMIN) x[r][j] = pxf[r][j]; else { const v2u a = pxb[r][j];
                x[r][j] = (f32x4){__builtin_bit_cast(float, a.x << 16), __builtin_bit_cast(float, a.x & 0xffff0000u), __builtin_bit_cast(float, a.y << 16), __builtin_bit_cast(float, a.y & 0xffff0000u)}; } } }
        v2u ya[3][4], yb[3][4];
        if (combine) {
#pragma unroll
            for (int r = 0; r < 3; ++r) { const bf16_t* y0 = YB + (size_t)(pst[t0[r] & 15] + (t0[r] >> 4)) * D; const bf16_t* y1 = YB + (size_t)(pst[t1[r] & 15] + (t1[r] >> 4)) * D;
#pragma unroll
                for (int j = 0; j < 4; ++j) { ya[r][j] = *(const GAS v2u*)(y0 + c0l + 256 * j); yb[r][j] = *(const GAS v2u*)(y1 + c0l + 256 * j); } }
        }
        if (g0 + 3 < rpw) N1_LOAD_GROUP(g0 + 3);
#pragma unroll
        for (int r = 0; r < 3; ++r) { const int row = rows[r]; const int v = variant_of_row(row);
            if (!FINAL && v != vcur) {
                vcur = v; const float* m = MOD + ((size_t)l * 9 + v) * 6144; f32x4 gn[4], scl[4];
#pragma unroll
                for (int j = 0; j < 4; ++j) { gn[j] = *(const GAS f32x4*)(A->in.norm1 + l * D + c0l + 256 * j); scl[j] = *(const GAS f32x4*)(m + D + c0l + 256 * j); st[j] = *(const GAS f32x4*)(m + c0l + 256 * j); }
#pragma unroll
                for (int j = 0; j < 4; ++j) gt[j] = gn[j] * (scl[j] + 1.f);
                if (combine) {
#pragma unroll
                    for (int j = 0; j < 4; ++j) g2v[j] = *(const GAS f32x4*)(MOD + ((size_t)(l - 1) * 9 + v) * 6144 + 5 * D + c0l + 256 * j); }
            }
            if (FINAL && combine && v != vcur) { vcur = v;
#pragma unroll
                for (int j = 0; j < 4; ++j) g2v[j] = *(const GAS f32x4*)(MOD + ((size_t)(l - 1) * 9 + v) * 6144 + 5 * D + c0l + 256 * j); }
            if (combine) {
#pragma unroll
                for (int j = 0; j < 4; ++j) { const v2u a = ya[r][j], b = yb[r][j];
                    const f32x4 fa = {__builtin_bit_cast(float, a.x << 16), __builtin_bit_cast(float, a.x & 0xffff0000u), __builtin_bit_cast(float, a.y << 16), __builtin_bit_cast(float, a.y & 0xffff0000u)};
                    const f32x4 fb = {__builtin_bit_cast(float, b.x << 16), __builtin_bit_cast(float, b.x & 0xffff0000u), __builtin_bit_cast(float, b.y << 16), __builtin_bit_cast(float, b.y & 0xffff0000u)};
                    x[r][j] = x[r][j] + g2v[j] * (fa * w0[r] + fb * w1[r]); } }
            if (!FINAL && (combine || FROMIN) && valid[r]) {
#pragma unroll
                for (int j = 0; j < 4; ++j) { v2u o; o.x = pk2(x[r][j].x, x[r][j].y); o.y = pk2(x[r][j].z, x[r][j].w); *(GAS v2u*)(XB + (size_t)row * D + c0l + 256 * j) = o; }
            }
            float ss = 0.f;
#pragma unroll
            for (int j = 0; j < 4; ++j) ss += (x[r][j].x * x[r][j].x + x[r][j].y * x[r][j].y) + (x[r][j].z * x[r][j].z + x[r][j].w * x[r][j].w);
            const float rinv = rsqrtf(wave_sum(ss) * (1.f / D) + 1e-6f);
            if (valid[r]) {
                if (FINAL) { float* dst = outp + (size_t)row * D;
#pragma unroll
                    for (int j = 0; j < 4; ++j) *(GAS f32x4*)(dst + c0l + 256 * j) = x[r][j] * rinv * gt[j];
                } else {
#pragma unroll
                    for (int j = 0; j < 4; ++j) { const f32x4 h = x[r][j] * rinv * gt[j] + st[j];
                        v2u o; o.x = pk2(h.x, h.y); o.y = pk2(h.z, h.w); *(GAS v2u*)(H + (size_t)row * D + c0l + 256 * j) = o; }
                }
            }
        }
    }
#undef N1_LOAD_GROUP
}
#define HAVE_GLA 1
constexpr int G_LG = 0;
constexpr int G_TMP = 32768;
constexpr int G_AO = 51200;
constexpr int G_VN = 76800;
constexpr int G_BS = 94208;
constexpr int G_OUT = 0;
__device__ __forceinline__ f32x16 mfma32(bf16x8 a, bf16x8 b, f32x16 c) { return __builtin_amdgcn_mfma_f32_32x32x16_bf16(a, b, c, 0, 0, 0); }
__device__ __forceinline__ float fast_logsigmoid(float x) { return fminf(x, 0.f) - __logf(1.f + __expf(-fabsf(x))); }
__device__ __forceinline__ void unpack8(const v4u w, float (&f)[8]) {
    f[0] = __builtin_bit_cast(float, w.x << 16); f[1] = __builtin_bit_cast(float, w.x & 0xffff0000u); f[2] = __builtin_bit_cast(float, w.y << 16); f[3] = __builtin_bit_cast(float, w.y & 0xffff0000u);
    f[4] = __builtin_bit_cast(float, w.z << 16); f[5] = __builtin_bit_cast(float, w.z & 0xffff0000u); f[6] = __builtin_bit_cast(float, w.w << 16); f[7] = __builtin_bit_cast(float, w.w & 0xffff0000u);
}
__device__ __forceinline__ v4u pack8(const float (&f)[8]) { v4u w; w.x = pk2(f[0], f[1]); w.y = pk2(f[2], f[3]); w.z = pk2(f[4], f[5]); w.w = pk2(f[6], f[7]); return w; }

typedef short v4i16_t __attribute__((ext_vector_type(4)));
__device__ __forceinline__ bf16x8 tr_frag(const LAS bf16_t* T, int ld, int k0, int n0, int lane) {
    const int hh = lane >> 5, blk = (lane >> 4) & 1, q = (lane & 15) >> 2, p = lane & 3;
    const LAS bf16_t* a0 = T + (k0 + 8 * hh + q) * ld + n0 + 16 * blk + 4 * p;
    const v4i16_t lo = __builtin_amdgcn_ds_read_tr16_b64_v4i16((LAS v4i16_t*)a0), hi = __builtin_amdgcn_ds_read_tr16_b64_v4i16((LAS v4i16_t*)(a0 + 4 * ld));
    bf16x8 r; r[0] = lo[0]; r[1] = lo[1]; r[2] = lo[2]; r[3] = lo[3]; r[4] = hi[0]; r[5] = hi[1]; r[6] = hi[2]; r[7] = hi[3]; return r;
}
struct DecPre { v4u a, bhi, blo; float bias; };
__device__ __forceinline__ void decays_load(DecPre& p, const Ctx& F, const bf16_t* P, const bf16_t* WGPl, const float* b_gkl, int r0, int h) {
    const int n = F.wave >> 2, tt = (F.wave >> 1) & 1, dt = F.wave & 1, r = F.lane & 31, hh = F.lane >> 5;
    p.a = *(const GAS v4u*)(P + (size_t)(r0 + 32 * tt + r) * PLD + 2048 + n * 16 + 8 * hh);
    const bf16_t* wg = WGPl + ((size_t)(n * 4 + h) * 64 + 32 * dt + r) * 16 + 8 * hh;
    p.bhi = *(const GAS v4u*)wg; p.blo = *(const GAS v4u*)(wg + 2 * 4 * 64 * 16);
    p.bias = b_gkl[n * 256 + h * 64 + 32 * dt + r];
}
__device__ __forceinline__ void chunk_decays(const Ctx& F, const DecPre& p) {
    LAS float* LG = (LAS float*)(F.lds + G_LG); LAS float* TT = (LAS float*)(F.lds + G_TMP);
    const int n = F.wave >> 2, tt = (F.wave >> 1) & 1, dt = F.wave & 1, r = F.lane & 31, hh = F.lane >> 5;
    f32x16 acc = {0.f, 0.f, 0.f, 0.f, 0.f, 0.f, 0.f, 0.f, 0.f, 0.f, 0.f, 0.f, 0.f, 0.f, 0.f, 0.f};
    acc = mfma32(__builtin_bit_cast(bf16x8, p.a), __builtin_bit_cast(bf16x8, p.bhi), acc);
    acc = mfma32(__builtin_bit_cast(bf16x8, p.a), __builtin_bit_cast(bf16x8, p.blo), acc);
    float v[16];
#pragma unroll
    for (int g = 0; g < 16; ++g) v[g] = fast_logsigmoid(acc[g] + p.bias) * (1.f / 16.f);
    float T[4], Pq[4];
    if (n == 0) {
#pragma unroll
        for (int q = 0; q < 4; ++q) { v[4 * q + 1] += v[4 * q]; v[4 * q + 2] += v[4 * q + 1]; v[4 * q + 3] += v[4 * q + 2]; T[q] = v[4 * q + 3]; }
    } else {
#pragma unroll
        for (int q = 0; q < 4; ++q) { v[4 * q + 2] += v[4 * q + 3]; v[4 * q + 1] += v[4 * q + 2]; v[4 * q] += v[4 * q + 1]; T[q] = v[4 * q]; }
    }
#pragma unroll
    for (int q = 0; q < 4; ++q) Pq[q] = __shfl_xor(T[q], 32);
    const float tot = ((T[0] + Pq[0]) + (T[1] + Pq[1])) + ((T[2] + Pq[2]) + (T[3] + Pq[3]));
    if (hh == 0) TT[(n * 2 + tt) * 64 + 32 * dt + r] = tot;
    float off[4];
    if (n == 0) { float run = 0.f;
#pragma unroll
        for (int q = 0; q < 4; ++q) { off[q] = run + (hh ? Pq[q] : 0.f); run += T[q] + Pq[q]; }
    } else { float run = 0.f;
#pragma unroll
        for (int q = 3; q >= 0; --q) { off[q] = run + (hh ? 0.f : Pq[q]); run += T[q] + Pq[q]; }
    }
    __syncthreads();
    const float xo = (n == 0) ? (tt == 1 ? TT[(0 * 2 + 0) * 64 + 32 * dt + r] : 0.f) : (tt == 0 ? TT[(1 * 2 + 1) * 64 + 32 * dt + r] : 0.f);
#pragma unroll
    for (int g = 0; g < 16; ++g) { const int t = 32 * tt + (g & 3) + 8 * (g >> 2) + 4 * hh; LG[(n * 64 + t) * 64 + 32 * dt + r] = v[g] + off[g >> 2] + xo; }
    __syncthreads();
}

struct KvPre { DecPre dec; v4u k, v0, v1; };
__device__ __forceinline__ void kv_decode(int job, int& b, int& h, int& j) { b = job / 144; const int rem = job % 144; h = rem / NCH; j = rem % NCH; }
__device__ __forceinline__ void kv_load(KvPre& p, const Ctx& F, KArgs A, int l, int job) {
    int b, h, j; kv_decode(job, b, h, j); const bf16_t* P = (const bf16_t*)(A->ws + WS_P); const int r0 = chunk_row0(b, j);
    decays_load(p.dec, F, P, (const bf16_t*)(A->ws + WS_WGP) + (size_t)l * 2 * 2 * 4 * 64 * 16, A->in.b_gk + (size_t)l * 2 * 256, r0, h);
    const int t = F.tid >> 3, dg = F.tid & 7; const bf16_t* pr = P + (size_t)(r0 + t) * PLD;
    p.k = *(const GAS v4u*)(pr + 768 + h * 64 + 8 * dg); p.v0 = *(const GAS v4u*)(pr + 1024 + h * 128 + 16 * dg); p.v1 = *(const GAS v4u*)(pr + 1024 + h * 128 + 16 * dg + 8);
}
__device__ __forceinline__ void kv_compute(const KvPre& p, const Ctx& F, unsigned char* ws, int job) {
    int b, h, j; kv_decode(job, b, h, j);
    chunk_decays(F, p.dec);
    LAS float* LG = (LAS float*)(F.lds + G_LG);
    LAS bf16_t* KEF = (LAS bf16_t*)(F.lds + G_AO); LAS bf16_t* KEB = KEF + 64 * 72; LAS bf16_t* VN = (LAS bf16_t*)(F.lds + G_VN);
    { const int t = F.tid >> 3, dg = F.tid & 7;
      float k[8]; unpack8(p.k, k); float kf[8], kb[8];
#pragma unroll
      for (int i = 0; i < 8; ++i) { const int d = 8 * dg + i;
          kf[i] = k[i] * __expf(LG[63 * 64 + d] - LG[t * 64 + d]); kb[i] = k[i] * __expf(LG[64 * 64 + d] - LG[(64 + t) * 64 + d]); }
      *(LAS v4u*)(KEF + t * 72 + 8 * dg) = pack8(kf); *(LAS v4u*)(KEB + t * 72 + 8 * dg) = pack8(kb);
      *(LAS v4u*)(VN + t * 136 + 16 * dg) = p.v0; *(LAS v4u*)(VN + t * 136 + 16 * dg + 8) = p.v1; }
    const int seq0 = (b * 4 + h) * 2;
    if (F.tid < 128) { const int n = F.tid >> 6, d = F.tid & 63; float* ADEC = (float*)(ws + WS_ADEC);
        ADEC[((size_t)(seq0 + n) * NCH + j) * 64 + d] = __expf(n == 0 ? LG[63 * 64 + d] : LG[64 * 64 + d]); }
    __syncthreads();
    { const int dir = F.wave >> 2, et = F.wave & 3, r = F.lane & 31, hh = F.lane >> 5;
      const LAS bf16_t* KE = dir ? KEB : KEF;
      f32x16 a0 = {0.f, 0.f, 0.f, 0.f, 0.f, 0.f, 0.f, 0.f, 0.f, 0.f, 0.f, 0.f, 0.f, 0.f, 0.f, 0.f}, a1 = a0;
#pragma unroll
      for (int ks = 0; ks < 4; ++ks) { const bf16x8 av = tr_frag(VN, 136, 16 * ks, 32 * et, F.lane);
          const bf16x8 b0 = tr_frag(KE, 72, 16 * ks, 0, F.lane), b1 = tr_frag(KE, 72, 16 * ks, 32, F.lane);
          a0 = mfma32(av, b0, a0); a1 = mfma32(av, b1, a1); }
      bf16_t* KVS = (bf16_t*)(ws + WS_KVS) + ((size_t)(seq0 + dir) * NCH + j) * 8192;
#pragma unroll
      for (int g = 0; g < 16; ++g) { const int e = 32 * et + (g & 3) + 8 * (g >> 2) + 4 * hh; KVS[e * 64 + r] = (bf16_t)pk2(a0[g], 0.f); KVS[e * 64 + 32 + r] = (bf16_t)pk2(a1[g], 0.f); } }
    __syncthreads();
}

template <int HW>
__device__ __forceinline__ void pool_job_t(int l, int pj, int g) {
    const Ctx F = mkctx(); KArgs A = kargs(); unsigned char* const ws = A->ws;
    const bf16_t* P = (const bf16_t*)(ws + WS_P);
    LAS float* VS = (LAS float*)(F.lds);
    LAS bf16_t* PD = (LAS bf16_t*)(F.lds + 33792);
    LAS bf16_t* WP = (LAS bf16_t*)(F.lds + 33792 + 17408);
    const bool latent = pj < 1024;
    int b, i64; if (latent) { b = pj >> 7; i64 = (pj >> 2) & 31; } else { const int q = pj - 1024; b = q >> 4; i64 = (q >> 2) & 3; }
    const int row0 = latent ? b * SEQ + i64 * 64 : NX + b * CTXL + i64 * 64;
    v4u wpre[4];
    { const bf16_t* wsrc = (const bf16_t*)(ws + WS_WPOOL) + (size_t)(l * 4 + g) * 128 * 128;
#pragma unroll
      for (int c = 0; c < 4; ++c) { const int u = F.tid + NTHR * c, d = u >> 4, q = u & 15; wpre[c] = *(const GAS v4u*)(wsrc + d * 128 + 8 * q); } }
    const float psc = A->in.pool_scale[l * 512 + g * 128 + 32 * (F.wave & 3) + (F.lane & 31)];
    v4u upre[2];
#pragma unroll
    for (int c = 0; c < 2; ++c) { const int u = F.tid + NTHR * c, jc = u >> 4, cg = u & 15; upre[c] = *(const GAS v4u*)(P + (size_t)(row0 + jc) * PLD + g * 128 + 8 * cg); }
    if (latent) {
        const int rlo = max(i64 - HW, 0), rhi = min(i64 + HW, 32); const float rc = 1.f / (float)(rhi - rlo);
#pragma unroll
        for (int c = 0; c < 2; ++c) { const int u = F.tid + NTHR * c, jc = u >> 4, cg = u & 15; float s[8];
#pragma unroll
            for (int i = 0; i < 8; ++i) s[i] = 0.f;
            v4u ld[2 * HW];
#pragma unroll
            for (int k = 0; k < 2 * HW; ++k) { const int r2 = min(max(i64 - HW + k, 0), 31); ld[k] = *(const GAS v4u*)(P + (size_t)(b * SEQ + r2 * 64 + jc) * PLD + g * 128 + 8 * cg); }
#pragma unroll
            for (int k = 0; k < 2 * HW; ++k) { const int r2 = i64 - HW + k; const float wt = (r2 >= 0 && r2 < 32) ? 1.f : 0.f; float f[8]; unpack8(ld[k], f);
#pragma unroll
                for (int i = 0; i < 8; ++i) s[i] += wt * f[i]; }
#pragma unroll
            for (int i = 0; i < 8; ++i) VS[jc * 132 + 8 * cg + i] = s[i] * rc; }
    }
#pragma unroll
    for (int c = 0; c < 4; ++c) { const int u = F.tid + NTHR * c, d = u >> 4, q = u & 15; *(LAS v4u*)(WP + d * 136 + 8 * q) = wpre[c]; }
    if (latent) __syncthreads();
#pragma unroll
    for (int c = 0; c < 2; ++c) { const int u = F.tid + NTHR * c, jc = u >> 4, cg = u & 15; float s[8];
#pragma unroll
        for (int i = 0; i < 8; ++i) s[i] = 0.f;
        float cnt;
        if (latent) { const int clo = max(jc - HW, 0), chi = min(jc + HW, 64); cnt = (float)(chi - clo);
#pragma unroll
            for (int k = 0; k < 2 * HW; ++k) { const int j2 = jc - HW + k; const float wt = (j2 >= 0 && j2 < 64) ? 1.f : 0.f; const int j2c = min(max(j2, 0), 63);
                const f32x4 v0 = *(const LAS f32x4*)(VS + j2c * 132 + 8 * cg), v1 = *(const LAS f32x4*)(VS + j2c * 132 + 8 * cg + 4);
                s[0] += wt * v0.x; s[1] += wt * v0.y; s[2] += wt * v0.z; s[3] += wt * v0.w; s[4] += wt * v1.x; s[5] += wt * v1.y; s[6] += wt * v1.z; s[7] += wt * v1.w; } }
        else { const int t = i64 * 64 + jc; const int lo = max(t - HW, 0), hi = min(t + HW, CTXL); cnt = (float)(hi - lo);
            v4u ld[2 * HW];
#pragma unroll
            for (int k = 0; k < 2 * HW; ++k) { const int t2 = min(max(t - HW + k, 0), CTXL - 1); ld[k] = *(const GAS v4u*)(P + (size_t)(NX + b * CTXL + t2) * PLD + g * 128 + 8 * cg); }
#pragma unroll
            for (int k = 0; k < 2 * HW; ++k) { const int t2 = t - HW + k; const float wt = (t2 >= 0 && t2 < CTXL) ? 1.f : 0.f; float f[8]; unpack8(ld[k], f);
#pragma unroll
                for (int i = 0; i < 8; ++i) s[i] += wt * f[i]; } }
        float uv[8]; unpack8(upre[c], uv);
        const float ic = 1.f / cnt; float pd[8];
#pragma unroll
        for (int i = 0; i < 8; ++i) pd[i] = s[i] * ic - uv[i];
        *(LAS v4u*)(PD + jc * 136 + 8 * cg) = pack8(pd); }
    __syncthreads();
    { const int mt = F.wave >> 2, nt = F.wave & 3, r = F.lane & 31, hh = F.lane >> 5;
      f32x16 acc = {0.f, 0.f, 0.f, 0.f, 0.f, 0.f, 0.f, 0.f, 0.f, 0.f, 0.f, 0.f, 0.f, 0.f, 0.f, 0.f};
#pragma unroll
      for (int ks = 0; ks < 8; ++ks) { const bf16x8 av = *(const LAS bf16x8*)(PD + (32 * mt + r) * 136 + 16 * ks + 8 * hh), bv = *(const LAS bf16x8*)(WP + (32 * nt + r) * 136 + 16 * ks + 8 * hh);
          acc = mfma32(av, bv, acc); }
      const int dcol = g * 128 + 32 * nt + r;
      bf16_t* MIX = (bf16_t*)(ws + WS_HB);
#pragma unroll
      for (int q = 0; q < 16; ++q) { const int jc = 32 * mt + (q & 3) + 8 * (q >> 2) + 4 * hh; MIX[(size_t)(row0 + jc) * D + dcol] = (bf16_t)pk2(acc[q] * psc, 0.f); } }
    __syncthreads();
}
__device__ __forceinline__ void pool_job(int l, int pj) {
    const int g = ((pj & 3) + (pj >> 8)) & 3;
    if (g == 0) pool_job_t<1>(l, pj, 0); else if (g == 1) pool_job_t<2>(l, pj, 1); else if (g == 2) pool_job_t<4>(l, pj, 2); else pool_job_t<8>(l, pj, 3);
}

__device__ __forceinline__ void gla_phase1(int l) {
    const int npool = (l < DEPTH - 1) ? 1152 : 1024;
    const int pflags = kargs()->flags;
    if (!(pflags & 4)) {
        const Ctx F = mkctx(); KArgs A = kargs(); unsigned char* const ws = A->ws;
        int job = blockIdx.x; KvPre pre;
        if (job < 1152) kv_load(pre, F, A, l, job);
        while (job < 1152) {
            const KvPre cur = pre; const int nj = job + gridDim.x;
            if (nj < 1152) kv_load(pre, F, A, l, nj);
            kv_compute(cur, F, ws, job);
            job = nj;
        }
    }
    if (!(pflags & 2)) for (int J = blockIdx.x; J < 1152 + npool; J += gridDim.x) if (J >= 1152) pool_job(l, J - 1152);
}

__device__ __forceinline__ void gla_phase2(int l) {
    const Ctx F = mkctx(); KArgs A = kargs(); unsigned char* const ws = A->ws;
    const int gid = F.bid * NTHR + F.tid; if (gid >= 64 * 2048) return;
    const int seq = gid >> 11, rem = gid & 2047, e = rem >> 4, dq = rem & 15, dir = seq & 1;
    bf16_t* base = (bf16_t*)(ws + WS_KVS) + (size_t)seq * NCH * 8192 + e * 64 + 4 * dq;
    const float* adec = (const float*)(ws + WS_ADEC) + (size_t)seq * NCH * 64 + 4 * dq;
    f32x4 S = {0.f, 0.f, 0.f, 0.f};
    for (int bt = 0; bt < 3; ++bt) {
        v2u kv[12]; f32x4 av[12];
#pragma unroll
        for (int i = 0; i < 12; ++i) { const int s = bt * 12 + i; const int jj = dir == 0 ? s : (s < 4 ? 3 - s : 39 - s);
            kv[i] = *(const GAS v2u*)(base + (size_t)jj * 8192); av[i] = *(const GAS f32x4*)(adec + jj * 64); }
#pragma unroll
        for (int i = 0; i < 12; ++i) { const int s = bt * 12 + i; const int jj = dir == 0 ? s : (s < 4 ? 3 - s : 39 - s);
            v2u o; o.x = pk2(S.x, S.y); o.y = pk2(S.z, S.w); *(GAS v2u*)(base + (size_t)jj * 8192) = o;
            const f32x4 k4 = {__builtin_bit_cast(float, kv[i].x << 16), __builtin_bit_cast(float, kv[i].x & 0xffff0000u), __builtin_bit_cast(float, kv[i].y << 16), __builtin_bit_cast(float, kv[i].y & 0xffff0000u)};
            S = av[i] * S + k4; }
    }
}

struct OutPre { DecPre dec; v4u q, k, v0, v1, g0, g1, sf0, sf1, sb0, sb1; f32x4 gg[4]; };
__device__ __forceinline__ void out_load(OutPre& p, const Ctx& F, KArgs A, int l, int job) {
    int b, h, j; kv_decode(job, b, h, j); const bf16_t* P = (const bf16_t*)(A->ws + WS_P); const int r0 = chunk_row0(b, j);
    decays_load(p.dec, F, P, (const bf16_t*)(A->ws + WS_WGP) + (size_t)l * 2 * 2 * 4 * 64 * 16, A->in.b_gk + (size_t)l * 2 * 256, r0, h);
    const int t = F.tid >> 3, dg = F.tid & 7; const bf16_t* pr = P + (size_t)(r0 + t) * PLD;
    p.q = *(const GAS v4u*)(pr + 512 + h * 64 + 8 * dg); p.k = *(const GAS v4u*)(pr + 768 + h * 64 + 8 * dg);
    p.v0 = *(const GAS v4u*)(pr + 1024 + h * 128 + 16 * dg); p.v1 = *(const GAS v4u*)(pr + 1024 + h * 128 + 16 * dg + 8);
    p.g0 = *(const GAS v4u*)(pr + 1536 + h * 128 + 16 * dg); p.g1 = *(const GAS v4u*)(pr + 1536 + h * 128 + 16 * dg + 8);
#pragma unroll
    for (int c = 0; c < 4; ++c) p.gg[c] = *(const GAS f32x4*)(A->in.gla_gain + l * 128 + 16 * dg + 4 * c);
    const int e = F.tid >> 2, q4 = F.tid & 3; const bf16_t* sf = (const bf16_t*)(A->ws + WS_KVS) + ((size_t)((b * 4 + h) * 2) * NCH + j) * 8192 + e * 64 + 16 * q4;
    p.sf0 = *(const GAS v4u*)sf; p.sf1 = *(const GAS v4u*)(sf + 8); p.sb0 = *(const GAS v4u*)(sf + (size_t)NCH * 8192); p.sb1 = *(const GAS v4u*)(sf + (size_t)NCH * 8192 + 8);
}
__device__ __forceinline__ void out_compute(const OutPre& p, const Ctx& F, KArgs A, int l, int job) {
    int b, h, j; kv_decode(job, b, h, j); unsigned char* const ws = A->ws; const int r0 = chunk_row0(b, j);
    chunk_decays(F, p.dec);
    LAS float* LG = (LAS float*)(F.lds + G_LG);
    LAS bf16_t* KTF = (LAS bf16_t*)(F.lds + G_TMP); LAS bf16_t* KTB = KTF + 64 * 72;
    LAS bf16_t* AO = (LAS bf16_t*)(F.lds + G_AO); LAS bf16_t* VN = (LAS bf16_t*)(F.lds + G_VN); LAS bf16_t* BS = (LAS bf16_t*)(F.lds + G_BS);
    { const int t = F.tid >> 3, dg = F.tid & 7;
      float q[8], k[8]; unpack8(p.q, q); unpack8(p.k, k);
      float qf[8], qb[8], kf[8], kb[8];
#pragma unroll
      for (int i = 0; i < 8; ++i) { const int d = 8 * dg + i; const float bf = LG[t * 64 + d], bb = LG[(64 + t) * 64 + d];
          qf[i] = q[i] * __expf(bf); kf[i] = k[i] * __expf(-bf); qb[i] = q[i] * __expf(bb); kb[i] = k[i] * __expf(-bb); }
      *(LAS v4u*)(AO + t * 200 + 64 + 8 * dg) = pack8(qf); *(LAS v4u*)(AO + t * 200 + 128 + 8 * dg) = pack8(qb);
      *(LAS v4u*)(KTF + t * 72 + 8 * dg) = pack8(kf); *(LAS v4u*)(KTB + t * 72 + 8 * dg) = pack8(kb);
      *(LAS v4u*)(VN + t * 136 + 16 * dg) = p.v0; *(LAS v4u*)(VN + t * 136 + 16 * dg + 8) = p.v1; }
    { const int e = F.tid >> 2, q4 = F.tid & 3;
      *(LAS v4u*)(BS + e * 136 + 16 * q4) = p.sf0; *(LAS v4u*)(BS + e * 136 + 16 * q4 + 8) = p.sf1; *(LAS v4u*)(BS + e * 136 + 64 + 16 * q4) = p.sb0; *(LAS v4u*)(BS + e * 136 + 64 + 16 * q4 + 8) = p.sb1; }
    __syncthreads();
    const int mt = F.wave >> 2, nt = F.wave & 3, r = F.lane & 31, hh = F.lane >> 5;
    f32x16 acc = {0.f, 0.f, 0.f, 0.f, 0.f, 0.f, 0.f, 0.f, 0.f, 0.f, 0.f, 0.f, 0.f, 0.f, 0.f, 0.f};
    if (F.wave < 4) {
        const int tt = F.wave == 0 ? 0 : (F.wave == 1 ? 1 : (F.wave == 2 ? 1 : 0)), st = F.wave == 0 ? 0 : (F.wave == 1 ? 1 : (F.wave == 2 ? 0 : 1));
        const bool dof = F.wave != 3, dob = F.wave != 2;
        f32x16 af = {0.f, 0.f, 0.f, 0.f, 0.f, 0.f, 0.f, 0.f, 0.f, 0.f, 0.f, 0.f, 0.f, 0.f, 0.f, 0.f}, ab = af;
        if (dof) {
#pragma unroll
            for (int ks = 0; ks < 4; ++ks) af = mfma32(*(const LAS bf16x8*)(AO + (32 * tt + r) * 200 + 64 + 16 * ks + 8 * hh), *(const LAS bf16x8*)(KTF + (32 * st + r) * 72 + 16 * ks + 8 * hh), af); }
        if (dob) {
#pragma unroll
            for (int ks = 0; ks < 4; ++ks) ab = mfma32(*(const LAS bf16x8*)(AO + (32 * tt + r) * 200 + 128 + 16 * ks + 8 * hh), *(const LAS bf16x8*)(KTB + (32 * st + r) * 72 + 16 * ks + 8 * hh), ab); }
        const bool diag = tt == st;
#pragma unroll
        for (int g = 0; g < 16; ++g) { const int trow = (g & 3) + 8 * (g >> 2) + 4 * hh;
            float v = af[g] + ab[g];
            if (diag) v = (r <= trow ? af[g] : 0.f) + (r >= trow ? ab[g] : 0.f);
            AO[(32 * tt + trow) * 200 + 32 * st + r] = (bf16_t)pk2(v, 0.f); }
    }
#pragma unroll
    for (int ks = 4; ks < 12; ++ks) acc = mfma32(*(const LAS bf16x8*)(AO + (32 * mt + r) * 200 + 16 * ks + 8 * hh), *(const LAS bf16x8*)(BS + (32 * nt + r) * 136 + 16 * (ks - 4) + 8 * hh), acc);
    __syncthreads();
    {
#pragma unroll
      for (int ks = 0; ks < 4; ++ks) acc = mfma32(*(const LAS bf16x8*)(AO + (32 * mt + r) * 200 + 16 * ks + 8 * hh), tr_frag(VN, 136, 16 * ks, 32 * nt, F.lane), acc);
      LAS float* OUT = (LAS float*)(F.lds + G_OUT);
#pragma unroll
      for (int g = 0; g < 16; ++g) { const int trow = 32 * mt + (g & 3) + 8 * (g >> 2) + 4 * hh; OUT[trow * 132 + 32 * nt + r] = acc[g]; } }
    __syncthreads();
    { const int t = F.tid >> 3, eg = F.tid & 7; const LAS float* o = (const LAS float*)(F.lds + G_OUT) + t * 132 + 16 * eg;
      float ov[16]; float ss = 0.f;
#pragma unroll
      for (int i = 0; i < 4; ++i) { const f32x4 x4 = *(const LAS f32x4*)(o + 4 * i); ov[4 * i] = x4.x; ov[4 * i + 1] = x4.y; ov[4 * i + 2] = x4.z; ov[4 * i + 3] = x4.w; ss += (x4.x * x4.x + x4.y * x4.y) + (x4.z * x4.z + x4.w * x4.w); }
      ss += __shfl_xor(ss, 1); ss += __shfl_xor(ss, 2); ss += __shfl_xor(ss, 4);
      const float rinv = rsqrtf(ss * (1.f / 128.f) + 1e-6f);
      float gg[16];
#pragma unroll
      for (int c = 0; c < 4; ++c) { gg[4 * c] = p.gg[c].x; gg[4 * c + 1] = p.gg[c].y; gg[4 * c + 2] = p.gg[c].z; gg[4 * c + 3] = p.gg[c].w; }
      bf16_t* mp = (bf16_t*)(ws + WS_HB) + (size_t)(r0 + t) * D + 512 + h * 128 + 16 * eg;
#pragma unroll
      for (int c = 0; c < 2; ++c) { float gv[8]; unpack8(c ? p.g1 : p.g0, gv); float y[8];
#pragma unroll
          for (int i = 0; i < 8; ++i) { const float gx = gv[i]; y[i] = ov[8 * c + i] * rinv * gg[8 * c + i] * gx * __builtin_amdgcn_rcpf(1.f + __expf(-gx)); }
          *(GAS v4u*)(mp + 8 * c) = pack8(y); } }
    __syncthreads();
}
__device__ __forceinline__ int out_next(int l, int job, int G) { job += G; if (l == DEPTH - 1) while (job < 1152 && (job % 144) % NCH < 4) job += G; return job; }
__device__ __forceinline__ void gla_phase3(int l) {
    const Ctx F = mkctx(); KArgs A = kargs();
    const int G = gridDim.x; int job = out_next(l, (int)blockIdx.x - G, G); OutPre pre;
    if (job < 1152) out_load(pre, F, A, l, job);
    while (job < 1152) {
        const OutPre cur = pre; const int nj = out_next(l, job, G);
        if (nj < 1152) out_load(pre, F, A, l, nj);
        out_compute(cur, F, A, l, job);
        job = nj;
    }
}
#define HAVE_MOE 1
#define DPPF(x, ctrl) __builtin_bit_cast(float, __builtin_amdgcn_update_dpp(0, __builtin_bit_cast(int, (x)), (ctrl), 0xF, 0xF, true))
__device__ __forceinline__ float reduce16(const float (&a)[16], int lane) {
    float b8[8], b4[4], b2[2];
    bool h = (lane & 8) != 0;
#pragma unroll
    for (int i = 0; i < 8; ++i) { const float keep = h ? a[8 + i] : a[i], send = h ? a[i] : a[8 + i]; b8[i] = keep + DPPF(send, 0x140); }
    h = (lane & 4) != 0;
#pragma unroll
    for (int i = 0; i < 4; ++i) { const float keep = h ? b8[4 + i] : b8[i], send = h ? b8[i] : b8[4 + i]; b4[i] = keep + DPPF(send, 0x141); }
    h = (lane & 2) != 0;
#pragma unroll
    for (int i = 0; i < 2; ++i) { const float keep = h ? b4[2 + i] : b4[i], send = h ? b4[i] : b4[2 + i]; b2[i] = keep + DPPF(send, 0x4E); }
    h = (lane & 1) != 0;
    float r; { const float keep = h ? b2[1] : b2[0], send = h ? b2[0] : b2[1]; r = keep + DPPF(send, 0xB1); }
    r += __shfl_xor(r, 16); r += __shfl_xor(r, 32);
    return r;
}

__device__ __forceinline__ void router_phase(int l, int nrows) {
    const Ctx F = mkctx(); KArgs A = kargs(); unsigned char* const ws = A->ws;
    constexpr int WRS = D + 4;
    LAS float* WRT = (LAS float*)F.lds;
    LAS float* LGS = (LAS float*)(F.lds + 69632);
    LAS int* CNT = (LAS int*)(F.lds + 69632 + 2048);
    LAS int* BASE = CNT + 16;
    LAS int* ASG = (LAS int*)(F.lds + 69632 + 4096);
    { const float* wr = A->in.w_router;
      float wl[32];
#pragma unroll
      for (int c = 0; c < 32; ++c) wl[c] = wr[F.tid + NTHR * c];
#pragma unroll
      for (int c = 0; c < 32; ++c) { const int i = F.tid + NTHR * c; WRT[(i & 15) * WRS + (i >> 4)] = wl[c]; } }
    if (F.tid < 32) CNT[F.tid] = 0;
    __syncthreads();
    const bf16_t* XB = (const bf16_t*)(ws + WS_XB);
    const float* MODl = (const float*)(ws + WS_MOD) + (size_t)l * 9 * 6144;
    bf16_t* H = (bf16_t*)(ws + WS_HB);
    float* WTS = (float*)(ws + WS_WTS);
    const float rb_lane = A->in.router_bias[F.lane & 15];
    const int rpb = nrows / F.G, rpw = rpb / NWAVES;
    const int row_base = F.bid * rpb + F.wave * rpw;
    LAS float* GT = (LAS float*)(F.lds + 77824); LAS float* ST = GT + 2048;
    const int v0 = variant_of_row(F.bid * rpb), v1 = variant_of_row(F.bid * rpb + rpb - 1);
    { float tn[4], tsc[4], tsh[4];
#pragma unroll
      for (int c = 0; c < 4; ++c) { const int i = F.tid + NTHR * c, ti = i >> 10, k = i & 1023; const float* m = MODl + (size_t)(ti ? v1 : v0) * 6144;
          tn[c] = A->in.norm2[l * D + k]; tsc[c] = m[4 * D + k]; tsh[c] = m[3 * D + k]; }
#pragma unroll
      for (int c = 0; c < 4; ++c) { const int i = F.tid + NTHR * c; GT[i] = tn[c] * (1.f + tsc[c]); ST[i] = tsh[c]; } }
    v2u xq[3][4];
#pragma unroll
    for (int r = 0; r < 3; ++r) { const int rr = (r < rpw) ? r : rpw - 1;
#pragma unroll
        for (int j = 0; j < 4; ++j) xq[r][j] = *(const GAS v2u*)(XB + (size_t)(row_base + rr) * D + 4 * F.lane + 256 * j); }
    __syncthreads();
    for (int g0 = 0; g0 < rpw; g0 += 3) {
        int lane_ = F.lane; asm volatile("" : "+v"(lane_));
        const int lane = lane_;
        f32x4 hx[3][4]; int rws[3]; bool vld[3];
#pragma unroll
        for (int r = 0; r < 3; ++r) {
            const int rr = (g0 + r < rpw) ? g0 + r : rpw - 1; rws[r] = row_base + rr; vld[r] = (g0 + r < rpw);
#pragma unroll
            for (int j = 0; j < 4; ++j) { const v2u a = xq[r][j];
                hx[r][j] = (f32x4){__builtin_bit_cast(float, a.x << 16), __builtin_bit_cast(float, a.x & 0xffff0000u), __builtin_bit_cast(float, a.y << 16), __builtin_bit_cast(float, a.y & 0xffff0000u)}; } }
        if (g0 + 3 < rpw) {
#pragma unroll
            for (int r = 0; r < 3; ++r) { const int rr = (g0 + 3 + r < rpw) ? g0 + 3 + r : rpw - 1;
#pragma unroll
                for (int j = 0; j < 4; ++j) xq[r][j] = *(const GAS v2u*)(XB + (size_t)(row_base + rr) * D + 4 * lane + 256 * j); } }
#pragma unroll
        for (int r = 0; r < 3; ++r) { const int row = rws[r]; float ss = 0.f;
#pragma unroll
            for (int j = 0; j < 4; ++j) ss += (hx[r][j].x * hx[r][j].x + hx[r][j].y * hx[r][j].y) + (hx[r][j].z * hx[r][j].z + hx[r][j].w * hx[r][j].w);
            const float rinv = rsqrtf(wave_sum(ss) * (1.f / D) + 1e-6f);
            const int ti = variant_of_row(row) == v0 ? 0 : 1024;
#pragma unroll
            for (int j = 0; j < 4; ++j) { const int c0 = 4 * lane + 256 * j;
                const f32x4 gt = *(const LAS f32x4*)(GT + ti + c0), sh = *(const LAS f32x4*)(ST + ti + c0);
                const f32x4 h = hx[r][j] * rinv * gt + sh; hx[r][j] = h;
                if (vld[r]) { v2u o; o.x = pk2(h.x, h.y); o.y = pk2(h.z, h.w); *(GAS v2u*)(H + (size_t)row * D + c0) = o; } }
        }
#pragma unroll
        for (int r = 0; r < 3; ++r)
#pragma unroll
            for (int j = 0; j < 4; ++j) asm volatile("" : "+v"(hx[r][j]));
        typedef float f32x2 __attribute__((ext_vector_type(2)));
        float acc[3][16];
#pragma unroll
        for (int e = 0; e < 16; ++e) {
            f32x2 a2[3] = {{0.f, 0.f}, {0.f, 0.f}, {0.f, 0.f}};
#pragma unroll
            for (int j = 0; j < 4; ++j) { const f32x4 w = *(const LAS f32x4*)(WRT + e * WRS + 4 * lane + 256 * j); const f32x2 wl = {w.x, w.y}, wh = {w.z, w.w};
#pragma unroll
                for (int r = 0; r < 3; ++r) { const f32x2 xl = {hx[r][j].x, hx[r][j].y}, xh = {hx[r][j].z, hx[r][j].w}; a2[r] = __builtin_elementwise_fma(xl, wl, a2[r]); a2[r] = __builtin_elementwise_fma(xh, wh, a2[r]); } }
#pragma unroll
            for (int r = 0; r < 3; ++r) acc[r][e] = a2[r].x + a2[r].y;
            asm volatile("" : "+v"(acc[0][e]), "+v"(acc[1][e]), "+v"(acc[2][e]) :: "memory");
        }
        float tot3[3];
#pragma unroll
        for (int r = 0; r < 3; ++r) tot3[r] = reduce16(acc[r], lane);
        { const int q = lane >> 4, e = lane & 15, g = e >> 2, jp = e & 3;
          const float val = q == 0 ? tot3[0] : (q == 1 ? tot3[1] : tot3[2]);
          const float sg = sigmoid_f(val), sb = sg + rb_lane;
          const float va = DPPF(sb, 0x4E), vb = DPPF(sb, 0xB1), vc = DPPF(sb, 0x1B);
          const float hi1 = fmaxf(sb, va), lo1 = fminf(sb, va), hi2 = fmaxf(vb, vc), lo2 = fminf(vb, vc);
          const float gs = fmaxf(hi1, hi2) + fmaxf(fminf(hi1, hi2), fmaxf(lo1, lo2));
          const float gb = DPPF(gs, 0x141), gc = DPPF(gs, 0x140), ga = DPPF(gb, 0x140);
          float bestv = gs; int bestg = g;
          { const int ia = g ^ 2; if (ga > bestv || (ga == bestv && ia < bestg)) { bestv = ga; bestg = ia; } }
          { const int ib = g ^ 1; if (gb > bestv || (gb == bestv && ib < bestg)) { bestv = gb; bestg = ib; } }
          { const int ic = g ^ 3; if (gc > bestv || (gc == bestv && ic < bestg)) { bestv = gc; bestg = ic; } }
          const int rank = ((va > sb || (va == sb && (jp ^ 2) < jp)) ? 1 : 0) + ((vb > sb || (vb == sb && (jp ^ 1) < jp)) ? 1 : 0) + ((vc > sb || (vc == sb && (jp ^ 3) < jp)) ? 1 : 0);
          if (q < 3 && g == bestg && rank < 2) { LGS[((F.wave * 3 + q) * 2 + rank) * 2] = __builtin_bit_cast(float, e); LGS[((F.wave * 3 + q) * 2 + rank) * 2 + 1] = sg; } }
        LDS_WAIT(); asm volatile("" ::: "memory");
        if ((lane & 15) == 0 && (lane >> 4) < 3 && g0 + (lane >> 4) < rpw) { const int q = lane >> 4;
            const LAS float* sl = LGS + (F.wave * 3 + q) * 4;
            const int e0 = __builtin_bit_cast(int, sl[0]), e1 = __builtin_bit_cast(int, sl[2]); const float s0 = sl[1], s1 = sl[3];
            const int rl = F.wave * rpw + g0 + q, row = F.bid * rpb + rl;
            const float wsum = s0 + s1;
            WTS[row * 2] = s0 / wsum; WTS[row * 2 + 1] = s1 / wsum;
            const int p0 = __hip_atomic_fetch_add(CNT + e0, 1, __ATOMIC_RELAXED, __HIP_MEMORY_SCOPE_WORKGROUP);
            const int p1 = __hip_atomic_fetch_add(CNT + e1, 1, __ATOMIC_RELAXED, __HIP_MEMORY_SCOPE_WORKGROUP);
            ASG[rl * 4 + 0] = e0; ASG[rl * 4 + 1] = p0; ASG[rl * 4 + 2] = e1; ASG[rl * 4 + 3] = p1;
        }
        LDS_WAIT(); asm volatile("" ::: "memory");
    }
    __syncthreads();
    gu32* ecnt = (gu32*)(ws + WS_CTL) + CW_ECNT + l * NE * 64;
    if (F.tid < NE) BASE[F.tid] = (int)__hip_atomic_fetch_add(ecnt + F.tid * 64, (unsigned)CNT[F.tid], __ATOMIC_RELAXED, __HIP_MEMORY_SCOPE_AGENT);
    __syncthreads();
    int* LIST = (int*)(ws + WS_LIST); int* TOK = (int*)(ws + WS_TOK);
    if (F.tid < rpb) { const int row = F.bid * rpb + F.tid;
#pragma unroll
        for (int k = 0; k < 2; ++k) { const int e = ASG[F.tid * 4 + 2 * k], p = ASG[F.tid * 4 + 2 * k + 1] + BASE[e]; LIST[e * NT + p] = row; TOK[row * 2 + k] = e | (p << 4); } }
}
enum { PH_PRO = 0, PH_N1 = 0, PH_GIN = 1, PH_G1 = 2, PH_G2 = 3, PH_G3 = 4, PH_GOUT = 5, PH_R2 = 6, PH_GUP = 7, PH_GDN = 8, PH_PER_LAYER = 9, PH_FINAL = 1 + 9 * DEPTH, PH_END = PH_FINAL + 1 };

__global__ void __launch_bounds__(NTHR, 2) mega_fwd(Args args_unused) {
    LAS unsigned char* const lds = (LAS unsigned char*)lds_raw;
    volatile LAS unsigned* MISC = (volatile LAS unsigned*)(lds + MISC_OFF);
    for (int u = threadIdx.x; u < (LDS_BYTES - LDSCTL_OFF) / 4; u += NTHR) ((LAS unsigned*)(lds + LDSCTL_OFF))[u] = 0u;
    __syncthreads();
    int lo, hi; bool comb_en; unsigned* barw;
    bool probe16;
    { KArgs A = kargs(); lo = A->ph_lo; hi = A->ph_hi; comb_en = (A->flags & 1) != 0; probe16 = (A->flags & 16) != 0; if (probe16) comb_en = true; barw = (unsigned*)(A->ws + WS_CTL) + CW_BAR; }
    const bool multi = (hi - lo) > 1;
    XcdBarrier bar; bar.bar = barw; bar.x = 0; bar.st = nullptr;
    if (multi) bar = xcd_barrier_post(barw, MISC + 8);
    for (int ph = lo; ph < hi; ++ph) {
        if (ph == PH_PRO) {
            p0_prologue();
        } else if (ph == PH_FINAL) {
            rowpass_n1<true, false>(DEPTH, comb_en, NX, false);
        } else {
            const int l = (ph - 1) / PH_PER_LAYER, s = (ph - 1) % PH_PER_LAYER;
            const bool keep = l < DEPTH - 1;
            if (s == PH_N1) {
                if (l > 0) convert_from_cursor(l, -1);
                if (l == 0 && !probe16) rowpass_n1<false, true>(l, false, NT, false); else rowpass_n1<false, false>(l, comb_en && l > 0, NT, probe16);
            } else if (s == PH_GIN || s == PH_GOUT || s == PH_GUP || s == PH_GDN) {
                KArgs A = kargs(); unsigned char* const ws = A->ws;
                const LAS int* tab = (const LAS int*)(lds + LDSCTL_OFF);
                pg8::GCfg S; S.list = (const int*)(ws + WS_LIST); S.tab = tab; S.amode = 0; S.bmode = 0; S.bexp = 0; S.K = D; S.Abase = (const char*)(ws + WS_HB);
                S.O = nullptr; S.ldc = 0; S.xl = nullptr; S.xc = nullptr; S.MODl = nullptr; S.gidx = 0; S.gscale = (A->flags & 8) ? 0.f : 1.f;
                int nM, nN;
                if (s == PH_GIN) { nM = NT / 256; nN = PLD / 256; S.Bbase = (const char*)(ws + WS_WIN) + (size_t)l * PLD * D * 2; S.emode = 0; S.O = (bf16_t*)(ws + WS_P); S.ldc = PLD; }
                else if (s == PH_GOUT) { nM = (keep ? NT : NX) / 256; nN = D / 256; S.Bbase = (const char*)(ws + WS_WOUT) + (size_t)l * D * D * 2; S.emode = 1;
                    S.O = (bf16_t*)(ws + WS_XB); S.MODl = (const float*)(ws + WS_MOD) + (size_t)l * 9 * 6144; S.gidx = 2; }
                else {
                    { LAS int* t = (LAS int*)(lds + LDSCTL_OFF); const gu32* ec = (const gu32*)(ws + WS_CTL) + CW_ECNT + l * NE * 64;
                      if (threadIdx.x < NE) t[32 + threadIdx.x] = (int)__hip_atomic_load(ec + threadIdx.x * 64, RLX_AGENT);
                      __syncthreads();
                      if (threadIdx.x == 0) { int run = 0; for (int e = 0; e < NE; ++e) { t[e] = run; run += (t[32 + e] + 255) >> 8; } t[16] = run; }
                      __syncthreads(); }
                    nM = tab[16]; nN = 4; S.bmode = 1;
                    if (s == PH_GUP) { S.amode = 1; S.Bbase = (const char*)(ws + WS_W13) + (size_t)l * NE * 1024 * D * 2; S.bexp = (size_t)1024 * D * 2; S.emode = 2; S.O = (bf16_t*)(ws + WS_HID); S.ldc = DE; }
                    else { S.K = DE; S.Abase = (const char*)(ws + WS_HID); S.Bbase = (const char*)(ws + WS_W2) + (size_t)l * NE * D * DE * 2; S.bexp = (size_t)D * DE * 2; S.emode = 0; S.O = (bf16_t*)(ws + WS_P); S.ldc = D; }
                }
                S.T.init(nM, nN, gridDim.x, blockIdx.x);
                pg8::gemm_phase(lds, S);
                if (keep) {
                    const int nwg = nM * nN, G = (int)gridDim.x, c = (int)blockIdx.x;
                    const int rounds = (nwg + G - 1) / G, mine = c < nwg ? (nwg - c + G - 1) / G : 0;
                    if (mine < rounds) convert_from_cursor(l + 1, s == PH_GDN ? 2 : 3);
                }
            }
#ifdef HAVE_GLA
            else if (s == PH_G1) { gla_phase1(l); }
            else if (s == PH_G2) { gla_phase2(l); }
            else if (s == PH_G3) { gla_phase3(l); }
#endif
#ifdef HAVE_MOE
            else if (s == PH_R2) { router_phase(l, keep ? NT : NX); }
#endif
        }
        if (ph + 1 < hi) {
            xcd_barrier(bar);
#ifdef PROBE_BAR2
            xcd_barrier(bar);
#endif
        }
    }
}

static bool g_init_done = false;
static void launch_mega(const In& I, float* out, unsigned char* ws, int lo, int hi, int flags, hipStream_t st) {
    if (!g_init_done) { (void)hipFuncSetAttribute((const void*)mega_fwd, hipFuncAttributeMaxDynamicSharedMemorySize, LDS_BYTES); g_init_done = true; }
    Args a{}; a.in = I; a.out = out; a.ws = ws; a.ph_lo = lo; a.ph_hi = hi; a.flags = flags; a.pad = 0;
    hipLaunchKernelGGL(mega_fwd, dim3(256), dim3(NTHR), LDS_BYTES, st, a);
}

#ifndef FUSED
#ifndef OPT_PRO
#define OPT_PRO 1
#endif
#ifndef OPT_A
#define OPT_A 1
#endif
#ifndef OPT_B
#define OPT_B 0
#endif
#ifndef OPT_C
#define OPT_C 1
#endif
#ifndef OPT_D
#define OPT_D 0
#endif
static void run_hybrid(const In& I, float* out, unsigned char* ws, hipStream_t st) {
    float* xc = (float*)(ws + WS_XC); float* MOD = (float*)(ws + WS_MOD); bf16_t* HB = (bf16_t*)(ws + WS_HB); bf16_t* P = (bf16_t*)(ws + WS_P);
    float* OF = (float*)(ws + WS_KVS); float* OB = (float*)(ws + WS_HID); float* HIDN = (float*)(ws + WS_P);
    int* EIDX = (int*)(ws + WS_NEIDX); float* WTSN = (float*)(ws + WS_NWTS);
    (void)hipMemsetAsync(ws + WS_CTL, 0, CTL_BYTES, st);
    const int flags = OPT_D ? 1 : 0;
    if (OPT_PRO) launch_mega(I, out, ws, PH_PRO, PH_PRO + 1, flags, st);
    else nv::k_mod<<<(DEPTH * 6144 + 255) / 256, 256, 0, st>>>(I.c, I.c_ctx, I.w_mod, I.b_mod, MOD);
    if (!OPT_A) { (void)hipMemcpyAsync(out, I.x, (size_t)NX * D * 4, hipMemcpyDeviceToDevice, st); (void)hipMemcpyAsync(xc, I.ctx, (size_t)NC * D * 4, hipMemcpyDeviceToDevice, st); }
    for (int l = 0; l < DEPTH; ++l) {
        const bool keep = l < DEPTH - 1; const int Mo = keep ? NT : NX;
        const float* MODl = MOD + (size_t)l * 9 * 6144;
        const int pb = 1 + l * PH_PER_LAYER;
        if (OPT_A) { launch_mega(I, out, ws, pb + PH_N1, pb + PH_N1 + 1, flags, st); launch_mega(I, out, ws, pb + PH_GIN, pb + PH_GIN + 1, flags, st); }
        else {
            if (OPT_D && l > 0) launch_mega(I, out, ws, pb + PH_N1, pb + PH_N1 + 1, flags, st);
            nv::k_normmod<<<NT, 256, 0, st>>>(out, xc, I.norm1 + l * D, MODl, 0, 1, HB, NT);
            nv::k_gemm<<<dim3((INW + 63) / 64, NT / 64), 256, 0, st>>>(HB, D, I.w_in + (size_t)l * D * INW, INW, P, PLD, NT, INW, D, 0, nullptr, 0, nullptr, nullptr, 512, 768);
        }
        if (OPT_B) { for (int s = PH_G1; s <= PH_G3; ++s) launch_mega(I, out, ws, pb + s, pb + s + 1, flags, st); }
        else {
            nv::k_gla<<<NB * 4, 256, 0, st>>>(P, I.w_gk2 + (size_t)l * 2 * 16 * 256, I.b_gk + (size_t)l * 2 * 256, OF, OB);
            nv::k_pool<<<NT, 512, 0, st>>>(P, I.w_pool + (size_t)l * 4 * 128 * 128, I.pool_scale + l * 512, HB);
            nv::k_glaout<<<NT, 512, 0, st>>>(P, OF, OB, I.gla_gain + l * 128, HB);
        }
        if (OPT_C) launch_mega(I, out, ws, pb + PH_GOUT, pb + PH_GOUT + 1, flags, st);
        else nv::k_gemm<<<dim3(D / 64, Mo / 64), 256, 0, st>>>(HB, D, I.w_out + (size_t)l * D * D, D, nullptr, 0, Mo, D, D, 1, MODl, 2, out, xc, 0, 0);
        if (OPT_D) { for (int s = PH_R2; s <= PH_GDN; ++s) launch_mega(I, out, ws, pb + s, pb + s + 1, flags, st); }
        else {
            nv::k_normmod<<<Mo, 256, 0, st>>>(out, xc, I.norm2 + l * D, MODl, 3, 4, HB, Mo);
            nv::k_router<<<Mo, 64, 0, st>>>(out, xc, I.norm2 + l * D, MODl, I.w_router, I.router_bias, EIDX, WTSN, Mo);
            nv::k_moe_up<<<Mo * 2, 512, 0, st>>>(HB, EIDX, I.w1 + (size_t)l * NE * D * DE, I.w3 + (size_t)l * NE * D * DE, HIDN);
            nv::k_moe_down_combine<<<Mo, 256, 0, st>>>(HIDN, EIDX, WTSN, I.w2 + (size_t)l * NE * DE * D, MODl, out, xc);
        }
    }
    if (OPT_D) launch_mega(I, out, ws, PH_FINAL, PH_FINAL + 1, flags, st);
    else nv::k_final<<<NX, 256, 0, st>>>(out, I.norm_f);
}

#endif
extern "C" void kernel_launch(void* const* d_in, const int* in_sizes, int n_in, void* d_out, int out_size, void* d_ws, size_t ws_size, hipStream_t stream) {
    In I;
    const float** f = (const float**)&I;
    for (int i = 0; i < 21; ++i) f[i] = (const float*)d_in[i];
    if (ws_size < WS_END) { fprintf(stderr, "ws too small: %zu < %zu\n", ws_size, (size_t)WS_END); return; }
#ifdef FUSED
    (void)hipMemsetAsync((unsigned char*)d_ws + WS_CTL, 0, CTL_BYTES, stream);
    launch_mega(I, (float*)d_out, (unsigned char*)d_ws, 0, PH_END, 1, stream);
#ifndef PROBE_FLAGS
#define PROBE_FLAGS 0
#endif
#ifdef PROBE_KIND
    if (PROBE_KIND < 0) launch_mega(I, (float*)d_out, (unsigned char*)d_ws, PH_PRO, PH_PRO + 1, 0, stream);
    else for (int l = 0; l < DEPTH; ++l) launch_mega(I, (float*)d_out, (unsigned char*)d_ws, 1 + l * PH_PER_LAYER + PROBE_KIND, 1 + l * PH_PER_LAYER + PROBE_KIND + 1, PROBE_FLAGS, stream);
#endif
#else
    run_hybrid(I, (float*)d_out, (unsigned char*)d_ws, stream);
#endif
}
```

```cpp
#define FUSED 1
#include <hip/hip_runtime.h>
#include <cstdio>
#include <cstdint>
typedef unsigned short bf16_t;
constexpr int D = 1024, NB = 8, SEQ = 2048, DEPTH = 4, CTXL = 256;
constexpr int NX = NB * SEQ, NC = NB * CTXL, NT = NX + NC;
constexpr int INW = 2080, PLD = 2304, NE = 16, DE = 512;
constexpr int NCH = 36;
constexpr int MAXSLOT = 41216;
constexpr size_t MiB = 1u << 20;
constexpr size_t WS_CTL = 0, CTL_BYTES = 1 * MiB;
constexpr size_t WS_MOD = 1 * MiB;
constexpr size_t WS_WPOOL = 2 * MiB;
constexpr size_t WS_WGP = 2 * MiB + 512 * 1024;
constexpr size_t WS_WRP = 2 * MiB + 640 * 1024;
constexpr size_t WS_TOK = 3 * MiB;
constexpr size_t WS_WTS = 3 * MiB + 256 * 1024;
constexpr size_t WS_NEIDX = 3 * MiB + 512 * 1024;
constexpr size_t WS_NWTS = 3 * MiB + 768 * 1024;
constexpr size_t WS_LIST = 4 * MiB;
constexpr size_t WS_WIN = 6 * MiB;
constexpr size_t WS_WOUT = 24 * MiB;
constexpr size_t WS_W13 = 32 * MiB;
constexpr size_t WS_W2 = 160 * MiB;
constexpr size_t WS_XC = 224 * MiB;
constexpr size_t WS_HB = 232 * MiB;
constexpr size_t WS_P = 268 * MiB;
constexpr size_t WS_KVS = 349 * MiB;
constexpr size_t WS_ADEC = 385 * MiB;
constexpr size_t WS_HID = 386 * MiB;
constexpr size_t WS_XB = 427 * MiB;
constexpr size_t WS_END = 463 * MiB;

struct In {
    const float *x, *c, *ctx, *c_ctx, *w_mod, *b_mod, *norm1, *norm2, *w_in, *w_gk2, *b_gk, *w_pool, *pool_scale, *gla_gain, *w_out, *w_router, *router_bias, *w1, *w3, *w2, *norm_f;
};

__host__ __device__ __forceinline__ unsigned f2bf(float f) { unsigned u = __builtin_bit_cast(unsigned, f); return (u + 0x7fffu + ((u >> 16) & 1u)) >> 16; }
__host__ __device__ __forceinline__ float bf2f(bf16_t h) { return __builtin_bit_cast(float, (unsigned)h << 16); }
typedef float pk2_f32x2 __attribute__((ext_vector_type(2)));
typedef __bf16 pk2_bf16x2 __attribute__((ext_vector_type(2)));
__device__ __forceinline__ unsigned pk2(float lo, float hi) { const pk2_f32x2 v = {lo, hi}; return __builtin_bit_cast(unsigned, __builtin_convertvector(v, pk2_bf16x2)); }
__device__ __forceinline__ float silu_f(float x) { return x / (1.f + expf(-x)); }
__device__ __forceinline__ float sigmoid_f(float x) { return 1.f / (1.f + expf(-x)); }
__device__ __forceinline__ float logsigmoid_f(float x) { return fminf(x, 0.f) - log1pf(expf(-fabsf(x))); }
__device__ __forceinline__ int variant_of_row(int row) { return row < NX ? (row >> 11) : 8; }
__device__ __forceinline__ float* resid_row(float* xl, float* xc, int row) { return row < NX ? xl + (size_t)row * D : xc + (size_t)(row - NX) * D; }
__device__ __forceinline__ int chunk_row0(int b, int j) { return j < 4 ? NX + b * CTXL + j * 64 : b * SEQ + (j - 4) * 64; }
#define GAS __attribute__((address_space(1)))
#define LAS __attribute__((address_space(3)))
typedef unsigned v4u __attribute__((ext_vector_type(4)));
typedef unsigned v2u __attribute__((ext_vector_type(2)));
typedef float f32x4 __attribute__((ext_vector_type(4)));
typedef float f32x16 __attribute__((ext_vector_type(16)));
typedef short bf16x8 __attribute__((ext_vector_type(8)));
typedef GAS unsigned gu32;
#define RLX_AGENT __ATOMIC_RELAXED, __HIP_MEMORY_SCOPE_AGENT
#define LDS_WAIT() asm volatile("s_waitcnt lgkmcnt(0)" ::: "memory")
#define VM_WAIT() asm volatile("s_waitcnt vmcnt(0)" ::: "memory")
constexpr int NWAVES = 8, NTHR = 512;
constexpr int RING_BYTES = 131072;
constexpr int LDSCTL_OFF = RING_BYTES, MISC_OFF = LDSCTL_OFF + 320;
constexpr int LDS_BYTES = 147456;
constexpr int CW_BAR = 4096;
constexpr int CW_ECNT = 8192;
constexpr int CW_CVT = 16384;

__device__ __forceinline__ float wave_sum(float v) {
    v += __builtin_bit_cast(float, __builtin_amdgcn_update_dpp(0, __builtin_bit_cast(int, v), 0xB1, 0xF, 0xF, true));
    v += __builtin_bit_cast(float, __builtin_amdgcn_update_dpp(0, __builtin_bit_cast(int, v), 0x4E, 0xF, 0xF, true));
    v += __builtin_bit_cast(float, __builtin_amdgcn_update_dpp(0, __builtin_bit_cast(int, v), 0x141, 0xF, 0xF, true));
    v += __builtin_bit_cast(float, __builtin_amdgcn_update_dpp(0, __builtin_bit_cast(int, v), 0x140, 0xF, 0xF, true));
    const int iv = __builtin_bit_cast(int, v);
    const float r0 = __builtin_bit_cast(float, __builtin_amdgcn_readlane(iv, 0)), r1 = __builtin_bit_cast(float, __builtin_amdgcn_readlane(iv, 16));
    const float r2 = __builtin_bit_cast(float, __builtin_amdgcn_readlane(iv, 32)), r3 = __builtin_bit_cast(float, __builtin_amdgcn_readlane(iv, 48));
    return (r0 + r1) + (r2 + r3);
}

#define XB_TMO      128
#define XB_XCNT(j)  (256  + 64 * (j))
#define XB_XSUB(j)  (1280 + 64 * (j))
#define XB_XGEN(j)  (2304 + 64 * (j))
#define XB_TOP      3328
#define XB_TOPGEN   3392
#define XCD_BAR_WORDS 3456
#define XB_SPIN_CAP (1u << 18)
__device__ __forceinline__ unsigned xb_ld(unsigned* p)              { return __hip_atomic_load(p, __ATOMIC_RELAXED, __HIP_MEMORY_SCOPE_AGENT); }
__device__ __forceinline__ unsigned xb_add(unsigned* p, unsigned v) { return __hip_atomic_fetch_add(p, v, __ATOMIC_RELAXED, __HIP_MEMORY_SCOPE_AGENT); }
__device__ __forceinline__ unsigned xb_xcc_id() { return (unsigned)__builtin_amdgcn_s_getreg((3 << 11) | 20) & 0xFu; }
#define XB_SPIN(cond, bar) do { unsigned _sp = 0; while (cond) { __builtin_amdgcn_s_sleep(1); \
    if ((++_sp & 255u) == 0u) { if (xb_ld(&(bar)[XB_TMO])) break; if (_sp > XB_SPIN_CAP) { atomicAdd(&(bar)[XB_TMO], 1u); break; } } } } while (0)
struct XcdBarrier { unsigned* bar; unsigned x; volatile LAS unsigned* st; };
__device__ __forceinline__ XcdBarrier xcd_barrier_post(unsigned* bar, volatile LAS unsigned* st) {
    XcdBarrier b; b.bar = bar; b.x = xb_xcc_id(); b.st = st;
    if (threadIdx.x == 0) (void)xb_add(&bar[XB_XCNT(b.x)], 1u);
    return b;
}
__device__ __forceinline__ void xcd_barrier(const XcdBarrier& b) {
    asm volatile("s_waitcnt vmcnt(0)" ::: "memory");
    __syncthreads();
    if (threadIdx.x < 64 && b.st[0] == 0u) {
        unsigned* bar = b.bar; const unsigned G = gridDim.x * gridDim.y * gridDim.z; const int lane = threadIdx.x; unsigned sp = 0u, c, sum, cnt;
        for (;;) {
            c = lane < 16 ? xb_ld(&bar[XB_XCNT(lane)]) : 0u; sum = c; cnt = c > 0u ? 1u : 0u;
#pragma unroll
            for (int o = 1; o < 16; o <<= 1) { sum += __shfl_xor(sum, o); cnt += __shfl_xor(cnt, o); }
            sum = __builtin_amdgcn_readfirstlane(sum); cnt = __builtin_amdgcn_readfirstlane(cnt);
            if (sum == G) break;
            __builtin_amdgcn_s_sleep(1);
            if ((++sp & 255u) == 0u) { if (__builtin_amdgcn_readfirstlane(xb_ld(&bar[XB_TMO]))) break; if (sp > XB_SPIN_CAP) { if (lane == 0) atomicAdd(&bar[XB_TMO], 1u); break; } }
        }
        const unsigned mine = __builtin_amdgcn_readlane(c, b.x);
        if (lane == 0) { b.st[0] = mine > 0u ? mine : 1u; b.st[1] = cnt > 0u ? cnt : 1u; }
        asm volatile("s_waitcnt lgkmcnt(0)" ::: "memory");
    }
    if (threadIdx.x == 0) {
        unsigned* bar = b.bar;
        __builtin_amdgcn_s_waitcnt(0);
        const unsigned nloc = b.st[0], nx = b.st[1];
        const unsigned old = xb_add(&bar[XB_XSUB(b.x)], 1u);
        const unsigned gen = old / nloc;
        if (old + 1u == (gen + 1u) * nloc) {
            __builtin_amdgcn_fence(__ATOMIC_RELEASE, "agent");
            asm volatile("s_waitcnt vmcnt(0)" ::: "memory");
            const unsigned og = xb_add(&bar[XB_TOP], 1u);
            const unsigned tg = og / nx;
            if (og + 1u == (tg + 1u) * nx) xb_add(&bar[XB_TOPGEN], 1u);
            else XB_SPIN(xb_ld(&bar[XB_TOPGEN]) == tg, bar);
            __builtin_amdgcn_fence(__ATOMIC_ACQUIRE, "agent");
            xb_add(&bar[XB_XGEN(b.x)], 1u);
            asm volatile("s_waitcnt vmcnt(0)" ::: "memory");
        } else {
            XB_SPIN(xb_ld(&bar[XB_XGEN(b.x)]) == gen, bar);
            __builtin_amdgcn_fence(__ATOMIC_ACQUIRE, "agent");
            asm volatile("s_waitcnt vmcnt(0)" ::: "memory");
        }
    }
    __syncthreads();
}

namespace pg8 {
constexpr int BM = 256, BK = 64, HALF = 128, HTB = HALF * BK * 2, STAGE_BYTES = 8 * HTB, NXCD = 8, WGM = 8;
__host__ __device__ __forceinline__ int lds_byte(int r, int c) { const int st = (r >> 4) * 2 + (c >> 5), rr = r & 15, cc = c & 31, ob = rr * 64 + cc * 2; return st * 1024 + (ob ^ (((ob >> 9) & 1) << 5)); }
__host__ __device__ __forceinline__ void stage_rc(int b, int& R, int& C) { const int st = b / 1024, sb = b % 1024, swz = sb ^ (((sb >> 9) & 1) << 5); R = (st >> 1) * 16 + swz / 64; C = (st & 1) * 32 + (swz % 64) / 2; }
__host__ __device__ __forceinline__ int perm32(int rho) { const int n = rho >> 4, i = rho & 15; return 8 * (i >> 2) + 4 * n + (i & 3); }

struct Unit { int pm, pn, e, ti; };

struct TileOrder {
    int nM, nN, nwg, G, c;
    __device__ void init(int nM_, int nN_, int G_, int c_) { nM = nM_; nN = nN_; nwg = nM * nN; G = G_; c = c_; }
    __device__ bool tile(int i, int& pm, int& pn) const {
        const long L = (long)i * G + c; if (L >= nwg) return false;
        int wgid = (int)L; { const int q = nwg / NXCD, r = nwg % NXCD, xcd = wgid % NXCD, off = wgid / NXCD; wgid = (xcd < r ? xcd * (q + 1) : r * (q + 1) + (xcd - r) * q) + off; }
        const int nig = WGM * nN, gid = wgid / nig, fm = gid * WGM, gsz = (nM - fm) < WGM ? (nM - fm) : WGM;
        pm = fm + ((wgid % nig) % gsz); pn = (wgid % nig) / gsz; return true;
    }
};
struct GCfg {
    TileOrder T; const char* Abase; const char* Bbase; int K; int amode, bmode; size_t bexp; const int* list; const LAS int* tab;
    int emode;
    bf16_t* O; int ldc;
    float* xl; float* xc; const float* MODl; int gidx; float gscale;
    __device__ __forceinline__ bool next(int i, Unit& u) const {
        u.e = 0; u.ti = 0; if (!T.tile(i, u.pm, u.pn)) return false;
        if (bmode) { int e = 0;
#pragma unroll
            for (int j = 1; j < 16; ++j) e += (u.pm >= tab[j]) ? 1 : 0;
            u.e = e; u.ti = u.pm - tab[e]; }
        return true; }
    __device__ __forceinline__ const char* b_base(const Unit& u) const { return Bbase + (size_t)u.e * bexp + (size_t)u.pn * BM * K * 2; }
    __device__ __forceinline__ void a_rows_to_lds(const Unit& u, int R0, int R1, LAS unsigned* slot, int lane) const {
        if (amode) { const int cnt = tab[32 + u.e]; const int* lp = list + u.e * NT; const int base = u.ti * BM;
            int p00 = base + R0, p01 = base + R1, p10 = base + HALF + R0, p11 = base + HALF + R1;
            p00 = p00 < cnt ? p00 : cnt - 1; p01 = p01 < cnt ? p01 : cnt - 1; p10 = p10 < cnt ? p10 : cnt - 1; p11 = p11 < cnt ? p11 : cnt - 1;
            __builtin_amdgcn_global_load_lds((const unsigned*)(lp + p00), slot, 4, 0, 0); __builtin_amdgcn_global_load_lds((const unsigned*)(lp + p01), slot + 64, 4, 0, 0);
            __builtin_amdgcn_global_load_lds((const unsigned*)(lp + p10), slot + 128, 4, 0, 0); __builtin_amdgcn_global_load_lds((const unsigned*)(lp + p11), slot + 192, 4, 0, 0);
        } else { const unsigned r = (unsigned)(u.pm * BM); slot[lane] = r + R0; slot[64 + lane] = r + R1; slot[128 + lane] = r + HALF + R0; slot[192 + lane] = r + HALF + R1; }
    }
    __device__ __forceinline__ unsigned a_off(const Unit& u, int h, int R, int C) const {
        if (amode) { const int cnt = tab[32 + u.e]; int pos = u.ti * BM + h * HALF + R; pos = pos < cnt ? pos : cnt - 1; const int src = list[u.e * NT + pos]; return (unsigned)((src * K + C) * 2); }
        return (unsigned)(((u.pm * BM + h * HALF + R) * K + C) * 2); }
    __device__ __forceinline__ bool perm() const { return emode != 2; }
    __device__ __forceinline__ void epi(const f32x4 (&acc)[2][2][4][2], const Unit& u, int wr, int wc, int fr, int fq) const {
        if (emode == 0) {
            const int row0 = u.pm * BM + wr * 64 + fr; const int col0 = u.pn * BM + wc * 32 + 8 * fq;
#pragma unroll
            for (int ai = 0; ai < 2; ++ai)
#pragma unroll
                for (int m = 0; m < 4; ++m) { bf16_t* rowp = O + (size_t)(row0 + ai * HALF + m * 16) * ldc + col0;
#pragma unroll
                    for (int bj = 0; bj < 2; ++bj) { const f32x4 v0 = acc[ai][bj][m][0], v1 = acc[ai][bj][m][1];
                        v4u w; w.x = pk2(v0[0], v0[1]); w.y = pk2(v0[2], v0[3]); w.z = pk2(v1[0], v1[1]); w.w = pk2(v1[2], v1[3]);
                        *(v4u*)(rowp + bj * HALF) = w; } }
        } else if (emode == 1) {
            const int rowt = u.pm * BM; const int v = rowt < NX ? (rowt >> 11) : 8;
            const float* gate = MODl + (size_t)v * 6144 + gidx * D; const float gsc = gscale;
            const int row0 = rowt + wr * 64 + fr; const int col0 = u.pn * BM + wc * 32 + 8 * fq;
            f32x4 gv[2][2];
#pragma unroll
            for (int bj = 0; bj < 2; ++bj)
#pragma unroll
                for (int n = 0; n < 2; ++n) gv[bj][n] = *(const f32x4*)(gate + col0 + bj * HALF + 4 * n) * gsc;
#pragma unroll
            for (int ai = 0; ai < 2; ++ai) {
                v4u xw[4][2];
#pragma unroll
                for (int m = 0; m < 4; ++m)
#pragma unroll
                    for (int bj = 0; bj < 2; ++bj) xw[m][bj] = *(const v4u*)(O + (size_t)(row0 + ai * HALF + m * 16) * D + col0 + bj * HALF);
#pragma unroll
                for (int m = 0; m < 4; ++m) { bf16_t* rowp = O + (size_t)(row0 + ai * HALF + m * 16) * D + col0;
#pragma unroll
                    for (int bj = 0; bj < 2; ++bj) { v4u* p = (v4u*)(rowp + bj * HALF); const v4u w = xw[m][bj];
                        const f32x4 x0 = {__builtin_bit_cast(float, w.x << 16), __builtin_bit_cast(float, w.x & 0xffff0000u), __builtin_bit_cast(float, w.y << 16), __builtin_bit_cast(float, w.y & 0xffff0000u)};
                        const f32x4 x1 = {__builtin_bit_cast(float, w.z << 16), __builtin_bit_cast(float, w.z & 0xffff0000u), __builtin_bit_cast(float, w.w << 16), __builtin_bit_cast(float, w.w & 0xffff0000u)};
                        const f32x4 y0 = x0 + gv[bj][0] * acc[ai][bj][m][0], y1 = x1 + gv[bj][1] * acc[ai][bj][m][1];
                        v4u o; o.x = pk2(y0[0], y0[1]); o.y = pk2(y0[2], y0[3]); o.z = pk2(y1[0], y1[1]); o.w = pk2(y1[2], y1[3]); *p = o; } }
            }
        } else {
            const int row0 = u.pm * BM + wr * 64 + fr; const int j0 = u.pn * 128 + wc * 32 + 8 * fq;
#pragma unroll
            for (int ai = 0; ai < 2; ++ai)
#pragma unroll
                for (int m = 0; m < 4; ++m) { float hv[8];
#pragma unroll
                    for (int bj = 0; bj < 2; ++bj)
#pragma unroll
                        for (int i = 0; i < 4; ++i) { const float a = acc[ai][bj][m][0][i], b = acc[ai][bj][m][1][i]; hv[bj * 4 + i] = a * b * __builtin_amdgcn_rcpf(1.f + __expf(-a)); }
                    v4u w; w.x = pk2(hv[0], hv[1]); w.y = pk2(hv[2], hv[3]); w.z = pk2(hv[4], hv[5]); w.w = pk2(hv[6], hv[7]);
                    *(v4u*)(O + (size_t)(row0 + ai * HALF + m * 16) * DE + j0) = w; }
        }
    }
};

__device__ __forceinline__ void gemm_phase(LAS unsigned char* lds, const GCfg& S) {
    const char* const Abase = S.Abase; const int K = S.K; const bool PERMB = S.perm();
    int tid_ = threadIdx.x; asm volatile("" : "+v"(tid_));
    const int tid = tid_, wid = __builtin_amdgcn_readfirstlane(tid >> 6), lane = tid & 63, wr = wid >> 2, wc = wid & 3, fr = lane & 15, fq = lane >> 4;
    const int nt = K / BK;
    int sR[2], sC[2]; unsigned voffB[2];
#pragma unroll
    for (int i = 0; i < 2; ++i) { stage_rc(tid * 16 + i * 8192, sR[i], sC[i]); const int Rb = PERMB ? ((sR[i] & ~31) + perm32(sR[i] & 31)) : sR[i]; voffB[i] = (unsigned)(Rb * K + sC[i]) * 2u; }
    const unsigned kstep = (unsigned)(BK * 2);
    const size_t hstepB = (size_t)HALF * K * 2;
    const unsigned ldsw = (unsigned)wid * 1024u;
    const int aoff = lds_byte(wr * 64 + fr, fq * 8), boff = lds_byte(wc * 32 + fr, fq * 8);
#define PG8_SA(b, h) (((b) * 2 + (h)) * HTB)
#define PG8_SB(b, h) ((4 + (b) * 2 + (h)) * HTB)
#define PG8_STAGE_B(bufoff, gbase) do { _Pragma("unroll") for (int _i = 0; _i < 2; ++_i) \
        __builtin_amdgcn_global_load_lds((const unsigned*)((const char*)(gbase) + voffB[_i]), (LAS unsigned*)(lds + (bufoff) + ldsw + _i * 8192), 16, 0, 0); } while (0)
#define PG8_STAGE_A(bufoff, o0, o1, kb) do { \
        __builtin_amdgcn_global_load_lds((const unsigned*)(Abase + (size_t)((o0) + (kb))), (LAS unsigned*)(lds + (bufoff) + ldsw), 16, 0, 0); \
        __builtin_amdgcn_global_load_lds((const unsigned*)(Abase + (size_t)((o1) + (kb))), (LAS unsigned*)(lds + (bufoff) + ldsw + 8192), 16, 0, 0); } while (0)
#define PG8_LDA(dst, b, h) do { _Pragma("unroll") for (int m = 0; m < 4; ++m) _Pragma("unroll") for (int k = 0; k < 2; ++k) dst[m][k] = *(const LAS bf16x8*)(lds + PG8_SA(b, h) + aoff + m * 2048 + k * 1024); } while (0)
#define PG8_LDB(dst, b, h) do { _Pragma("unroll") for (int n = 0; n < 2; ++n) _Pragma("unroll") for (int k = 0; k < 2; ++k) dst[n][k] = *(const LAS bf16x8*)(lds + PG8_SB(b, h) + boff + n * 2048 + k * 1024); } while (0)
#define PG8_MMA(ai, bj, At, Bt) do { __builtin_amdgcn_s_setprio(1); _Pragma("unroll") for (int m = 0; m < 4; ++m) _Pragma("unroll") for (int n = 0; n < 2; ++n) _Pragma("unroll") for (int k = 0; k < 2; ++k) \
        acc[ai][bj][m][n] = __builtin_amdgcn_mfma_f32_16x16x32_bf16(Bt[n][k], At[m][k], acc[ai][bj][m][n], 0, 0, 0); __builtin_amdgcn_s_setprio(0); } while (0)
#define PG8_WAIT_V(n) asm volatile("s_waitcnt vmcnt(" #n ")" ::: "memory")
#define PG8_WAIT_L(n) asm volatile("s_waitcnt lgkmcnt(" #n ")" ::: "memory")
#define PG8_BAR __builtin_amdgcn_s_barrier()
#define PG8_SCHED __builtin_amdgcn_sched_barrier(0)
    Unit cur, nxt; int ui = 0;
    if (!S.next(0, cur)) return;
    f32x4 acc[2][2][4][2];
#pragma unroll
    for (int a = 0; a < 2; ++a)
#pragma unroll
        for (int b = 0; b < 2; ++b)
#pragma unroll
            for (int m = 0; m < 4; ++m)
#pragma unroll
                for (int n = 0; n < 2; ++n) acc[a][b][m][n] = (f32x4){0.f, 0.f, 0.f, 0.f};
    bf16x8 At[4][2], B0[2][2], B1[2][2];
    unsigned c00 = S.a_off(cur, 0, sR[0], sC[0]), c01 = S.a_off(cur, 0, sR[1], sC[1]), c10 = S.a_off(cur, 1, sR[0], sC[0]), c11 = S.a_off(cur, 1, sR[1], sC[1]);
    const char* cB = S.b_base(cur);
    PG8_STAGE_B(PG8_SB(0, 0), cB); PG8_STAGE_B(PG8_SB(0, 1), cB + hstepB); PG8_STAGE_A(PG8_SA(0, 0), c00, c01, 0u); PG8_STAGE_A(PG8_SA(0, 1), c10, c11, 0u);
    if (wr == 1) PG8_BAR;
    PG8_WAIT_V(2); PG8_BAR;
    PG8_STAGE_B(PG8_SB(1, 0), cB + kstep); PG8_STAGE_A(PG8_SA(1, 0), c00, c01, kstep); PG8_STAGE_B(PG8_SB(1, 1), cB + hstepB + kstep);
    PG8_WAIT_V(6); PG8_BAR;
    LAS unsigned* const nslot = (LAS unsigned*)(lds + LDSCTL_OFF + 1024) + wid * 256;
    for (;;) {
        const bool has_next = S.next(ui + 1, nxt);
        const char* nB = cB;
        if (has_next) {
            int t2 = tid; asm volatile("" : "+v"(t2)); int r0_, c0_, r1_, c1_; stage_rc(t2 * 16, r0_, c0_); stage_rc(t2 * 16 + 8192, r1_, c1_);
            S.a_rows_to_lds(nxt, r0_, r1_, nslot, lane); nB = S.b_base(nxt); }
        for (int t = 0; t < nt; t += 2) {
            const bool last = (t == nt - 2);
            const unsigned k1 = (unsigned)(t + 1) * kstep;
            const unsigned k2 = last ? 0u : (unsigned)(t + 2) * kstep, k3 = k2 + kstep;
            unsigned s00 = c00, s01 = c01, s10 = c10, s11 = c11;
            if (last && has_next) { int t3 = tid; asm volatile("" : "+v"(t3)); int r0_, c0_, r1_, c1_; stage_rc(t3 * 16, r0_, c0_); stage_rc(t3 * 16 + 8192, r1_, c1_);
                s00 = (nslot[lane] * (unsigned)K + c0_) * 2u; s01 = (nslot[64 + lane] * (unsigned)K + c1_) * 2u; s10 = (nslot[128 + lane] * (unsigned)K + c0_) * 2u; s11 = (nslot[192 + lane] * (unsigned)K + c1_) * 2u; }
            const char* b2 = last ? nB : cB + (size_t)(t + 2) * kstep; const char* b3 = b2 + kstep;
            const bool relax = (t == 0 && ui > 0);
            PG8_LDB(B0, 0, 0); PG8_LDB(B1, 0, 1); PG8_SCHED; PG8_LDA(At, 0, 0); PG8_STAGE_A(PG8_SA(1, 1), c10, c11, k1);
            if (relax) { if (S.emode == 2) PG8_WAIT_V(16); else PG8_WAIT_V(24); } else PG8_WAIT_V(8);
            PG8_WAIT_L(0); PG8_BAR; PG8_MMA(0, 0, At, B0); PG8_MMA(0, 1, At, B1); PG8_BAR; PG8_SCHED;
            PG8_LDA(At, 0, 1); PG8_STAGE_B(PG8_SB(0, 0), b2); PG8_STAGE_B(PG8_SB(0, 1), b2 + hstepB); PG8_STAGE_A(PG8_SA(0, 0), s00, s01, k2);
            if (relax) { if (S.emode == 2) PG8_WAIT_V(16); else PG8_WAIT_V(24); } else PG8_WAIT_V(8);
            PG8_WAIT_L(0); PG8_BAR; PG8_MMA(1, 0, At, B0); PG8_MMA(1, 1, At, B1); PG8_BAR; PG8_SCHED;
            PG8_LDB(B0, 1, 0); PG8_LDB(B1, 1, 1); PG8_SCHED; PG8_LDA(At, 1, 0); PG8_STAGE_A(PG8_SA(0, 1), s10, s11, k2);
            PG8_WAIT_V(8); PG8_WAIT_L(0); PG8_BAR; PG8_MMA(0, 0, At, B0); PG8_MMA(0, 1, At, B1); PG8_BAR; PG8_SCHED;
            PG8_LDA(At, 1, 1); PG8_STAGE_B(PG8_SB(1, 0), b3); PG8_STAGE_B(PG8_SB(1, 1), b3 + hstepB); PG8_STAGE_A(PG8_SA(1, 0), s00, s01, k3);
            PG8_WAIT_V(8); PG8_WAIT_L(0); PG8_BAR; PG8_MMA(1, 0, At, B0); PG8_MMA(1, 1, At, B1); PG8_BAR; PG8_SCHED;
        }
        if (wr == 0) PG8_BAR;
        S.epi(acc, cur, wr, wc, fr, fq);
        if (!has_next) break;
#pragma unroll
        for (int a = 0; a < 2; ++a)
#pragma unroll
            for (int b = 0; b < 2; ++b)
#pragma unroll
                for (int m = 0; m < 4; ++m)
#pragma unroll
                    for (int n = 0; n < 2; ++n) acc[a][b][m][n] = (f32x4){0.f, 0.f, 0.f, 0.f};
        { int t4 = tid; asm volatile("" : "+v"(t4)); int r0_, c0_, r1_, c1_; stage_rc(t4 * 16, r0_, c0_); stage_rc(t4 * 16 + 8192, r1_, c1_);
          c00 = (nslot[lane] * (unsigned)K + c0_) * 2u; c01 = (nslot[64 + lane] * (unsigned)K + c1_) * 2u; c10 = (nslot[128 + lane] * (unsigned)K + c0_) * 2u; c11 = (nslot[192 + lane] * (unsigned)K + c1_) * 2u; }
        cur = nxt; cB = nB; ++ui;
        if (wr == 1) PG8_BAR;
    }
    PG8_WAIT_V(0);
    PG8_BAR;
#undef PG8_SA
#undef PG8_SB
#undef PG8_STAGE_A
#undef PG8_STAGE_B
#undef PG8_LDA
#undef PG8_LDB
#undef PG8_MMA
#undef PG8_WAIT_V
#undef PG8_WAIT_L
#undef PG8_BAR
#undef PG8_SCHED
}
}
struct Args { In in; float* out; unsigned char* ws; int ph_lo, ph_hi, flags, pad; };
typedef const __attribute__((address_space(4))) Args* KArgs;
__device__ __forceinline__ KArgs kargs() { KArgs a = (KArgs)__builtin_amdgcn_kernarg_segment_ptr(); asm volatile("" : "+s"(a)); return a; }
struct Ctx {
    LAS unsigned char* lds; int tid, lane, wave, G, bid;
};
extern __shared__ __attribute__((aligned(16))) unsigned char lds_raw[];
__device__ __forceinline__ Ctx mkctx() { Ctx F; int t = threadIdx.x; asm volatile("" : "+v"(t)); F.lds = (LAS unsigned char*)lds_raw; F.tid = t; F.lane = t & 63; F.wave = __builtin_amdgcn_readfirstlane(t >> 6); F.G = gridDim.x; F.bid = blockIdx.x; return F; }

struct MapIdent { float qs; int qlo, qhi; __device__ __forceinline__ int row(int n) const { return n; } __device__ __forceinline__ float scale(int n) const { return (n >= qlo && n < qhi) ? qs : 1.f; } };
struct MapW13 { int sel; __device__ __forceinline__ int row(int j) const { return 256 * (j >> 7) + 128 * ((j >> 2) & 1) + 32 * ((j >> 5) & 3) + 16 * sel + 4 * ((j >> 3) & 3) + (j & 3); } __device__ __forceinline__ float scale(int) const { return 1.f; } };
template <bool DEEP, class Map>
__device__ __forceinline__ void transpose_item(const float* W, int ldn, int k0, int n0, bf16_t* WT, int ldk, LAS float* scr, int lane, const Map& map) {
    if (DEEP) {
        float ld[32];
#pragma unroll
        for (int i = 0; i < 32; ++i) ld[i] = W[(size_t)(k0 + 2 * i + (lane >> 5)) * ldn + n0 + (lane & 31)];
#pragma unroll
        for (int i = 0; i < 32; ++i) scr[(2 * i + (lane >> 5)) * 33 + (lane & 31)] = ld[i];
    } else {
#pragma unroll 8
        for (int i = 0; i < 32; ++i) { const int kk = 2 * i + (lane >> 5); scr[kk * 33 + (lane & 31)] = W[(size_t)(k0 + kk) * ldn + n0 + (lane & 31)]; }
    }
    LDS_WAIT(); asm volatile("" ::: "memory");
    const int c = lane & 7;
#pragma unroll
    for (int j = 0; j < 4; ++j) { const int n = (lane >> 3) + 8 * j; const LAS float* s = scr + (8 * c) * 33 + n; const float sc = map.scale(n0 + n);
        v4u o; o.x = pk2(s[0 * 33] * sc, s[1 * 33] * sc); o.y = pk2(s[2 * 33] * sc, s[3 * 33] * sc); o.z = pk2(s[4 * 33] * sc, s[5 * 33] * sc); o.w = pk2(s[6 * 33] * sc, s[7 * 33] * sc);
        *(GAS v4u*)(WT + (size_t)map.row(n0 + n) * ldk + k0 + 8 * c) = o; }
    LDS_WAIT(); asm volatile("" ::: "memory");
}

template <bool DEEP>
__device__ __forceinline__ void convert_layer_items(const Ctx& F, KArgs A, int l, int widx, int nw) {
    unsigned char* const ws = A->ws;
    LAS float* scr = (LAS float*)(F.lds + F.wave * 16384);
    bf16_t* WIN = (bf16_t*)(ws + WS_WIN) + (size_t)l * PLD * D; bf16_t* WOUT = (bf16_t*)(ws + WS_WOUT) + (size_t)l * D * D;
    bf16_t* W13 = (bf16_t*)(ws + WS_W13) + (size_t)l * NE * 1024 * D; bf16_t* W2 = (bf16_t*)(ws + WS_W2) + (size_t)l * NE * D * DE; bf16_t* WPL = (bf16_t*)(ws + WS_WPOOL) + (size_t)l * 4 * 128 * 128;
    constexpr int I_IN = 16 * 65, I_OUT = 16 * 32, I_W1 = NE * 256, I_W2 = NE * 256, I_PL = 4 * 8, I_Z = 224;
    constexpr int NITEMS = I_IN + I_OUT + 2 * I_W1 + I_W2 + I_PL + I_Z;
    for (int it = widx; it < NITEMS; it += nw) {
        int r = it;
        if (r < I_IN) { const int kb = r / 65, nb = r % 65;
            transpose_item<DEEP>(A->in.w_in + (size_t)l * D * INW, INW, kb * 64, nb * 32, WIN, D, scr, F.lane, MapIdent{0.125f, 512, 768}); continue; } r -= I_IN;
        if (r < I_OUT) { const int kb = r / 32, nb = r % 32;
            transpose_item<DEEP>(A->in.w_out + (size_t)l * D * D, D, kb * 64, nb * 32, WOUT, D, scr, F.lane, MapIdent{1.f, 0, 0}); continue; } r -= I_OUT;
        if (r < 2 * I_W1) { const int sel = r >= I_W1; if (sel) r -= I_W1; const int e = r / 256, q = r % 256, kb = q / 16, nb = q % 16;
            transpose_item<DEEP>((sel ? A->in.w3 : A->in.w1) + ((size_t)l * NE + e) * D * DE, DE, kb * 64, nb * 32, W13 + (size_t)e * 1024 * D, D, scr, F.lane, MapW13{sel}); continue; } r -= 2 * I_W1;
        if (r < I_W2) { const int e = r / 256, q = r % 256, kb = q / 32, nb = q % 32;
            transpose_item<DEEP>(A->in.w2 + ((size_t)l * NE + e) * DE * D, D, kb * 64, nb * 32, W2 + (size_t)e * D * DE, DE, scr, F.lane, MapIdent{1.f, 0, 0}); continue; } r -= I_W2;
        if (r < I_PL) { const int g = r / 8, q = r % 8, kb = q / 4, nb = q % 4;
            transpose_item<DEEP>(A->in.w_pool + ((size_t)l * 4 + g) * 128 * 128, 128, kb * 64, nb * 32, WPL + (size_t)g * 128 * 128, 128, scr, F.lane, MapIdent{1.f, 0, 0}); continue; } r -= I_PL;
        { const int row = INW + r; v4u z = {0u, 0u, 0u, 0u}; GAS v4u* p = (GAS v4u*)(WIN + (size_t)row * D) + F.lane; p[0] = z; p[64] = z; }
    }
}

__device__ __forceinline__ void convert_from_cursor(int l, int max_rounds) {
    const Ctx F = mkctx(); KArgs A = kargs();
    gu32* cur = (gu32*)(A->ws + WS_CTL) + CW_CVT + l * 64;
    volatile LAS unsigned* slot = (volatile LAS unsigned*)(F.lds + LDSCTL_OFF + 256);
    constexpr int NITEMS = 16 * 65 + 16 * 32 + 3 * NE * 256 + 4 * 8 + 224;
    for (int r = 0; max_rounds < 0 || r < max_rounds; ++r) {
        if (F.tid == 0) *slot = __hip_atomic_fetch_add(cur, 8u, RLX_AGENT);
        __syncthreads();
        const int start = (int)*slot;
        __syncthreads();
        if (start >= NITEMS) break;
        convert_layer_items<true>(F, A, l, start + F.wave, NITEMS + 8);
    }
}

__device__ __forceinline__ void p0_prologue() {
    const Ctx F = mkctx(); KArgs A = kargs(); unsigned char* const ws = A->ws;
    {
        LAS float* sc = (LAS float*)F.lds;
        LAS float* red = (LAS float*)(F.lds + 9 * 1024 * 4);
        for (int i = F.tid; i < 9 * 1024; i += NTHR) { const int v = i >> 10, k = i & 1023; const float cv = v < 8 ? A->in.c[v * D + k] : A->in.c_ctx[k]; sc[i] = silu_f(cv); }
        __syncthreads();
        float* MOD = (float*)(ws + WS_MOD);
        for (int it = F.bid; it < DEPTH * 96; it += F.G) {
            const int l = it / 96, j0 = (it % 96) * 64;
            const float* w = A->in.w_mod + ((size_t)l * D + F.wave * 128) * 6144 + j0 + F.lane;
            float acc[9];
#pragma unroll
            for (int v = 0; v < 9; ++v) acc[v] = 0.f;
            for (int k0 = 0; k0 < 128; k0 += 32) { float wv[32];
#pragma unroll
                for (int kk = 0; kk < 32; ++kk) wv[kk] = w[(size_t)(k0 + kk) * 6144];
#pragma unroll
                for (int kk = 0; kk < 32; ++kk) {
#pragma unroll
                    for (int v = 0; v < 9; ++v) acc[v] += sc[v * 1024 + F.wave * 128 + k0 + kk] * wv[kk]; } }
#pragma unroll
            for (int v = 0; v < 9; ++v) red[(F.wave * 9 + v) * 64 + F.lane] = acc[v];
            __syncthreads();
            for (int o = F.tid; o < 9 * 64; o += NTHR) { const int v = o >> 6, jj = o & 63; float s = 0.f;
#pragma unroll
                for (int wv = 0; wv < 8; ++wv) s += red[(wv * 9 + v) * 64 + jj];
                MOD[((size_t)l * 9 + v) * 6144 + j0 + jj] = s + A->in.b_mod[l * 6144 + j0 + jj]; }
            __syncthreads();
        }
    }
    { bf16_t* WGP = (bf16_t*)(ws + WS_WGP);
      for (int i = F.bid * NTHR + F.tid; i < DEPTH * 2 * 4 * 64 * 16; i += F.G * NTHR) { const int r = i & 15, d = (i >> 4) & 63, h = (i >> 10) & 3, n = (i >> 12) & 1, l = i >> 13;
          const float w = A->in.w_gk2[((size_t)(l * 2 + n) * 16 + r) * 256 + h * 64 + d]; const unsigned hi = f2bf(w); const float rem = w - __builtin_bit_cast(float, hi << 16);
          bf16_t* o = WGP + (size_t)l * 2 * 2 * 4 * 64 * 16 + ((size_t)(n * 4 + h) * 64 + d) * 16 + r; o[0] = (bf16_t)hi; o[2 * 4 * 64 * 16] = (bf16_t)f2bf(rem); } }
    { bf16_t* WRP = (bf16_t*)(ws + WS_WRP);
      for (int i = F.bid * NTHR + F.tid; i < NE * D; i += F.G * NTHR) { const int e = i & 15, k = i >> 4; const float w = A->in.w_router[i]; const unsigned hi = f2bf(w); const float rem = w - __builtin_bit_cast(float, hi << 16);
          WRP[(size_t)e * D + k] = (bf16_t)hi; WRP[(size_t)NE * D + (size_t)e * D + k] = (bf16_t)f2bf(rem); } }
    convert_layer_items<false>(F, A, 0, F.bid * NWAVES + F.wave, F.G * NWAVES);
}

template <bool FINAL, bool FROMIN>
__device__ __forceinline__ void rowpass_n1(int l, bool combine, int nrows, bool zero_w) {
    const Ctx F = mkctx(); KArgs A = kargs(); unsigned char* const ws = A->ws; float* const outp = A->out; gu32* const ctl = (gu32*)(ws + WS_CTL);
    const int gw = F.bid * NWAVES + F.wave, NGW = F.G * NWAVES;
    bf16_t* XB = (bf16_t*)(ws + WS_XB);
    const float* MOD = (const float*)(ws + WS_MOD);
    bf16_t* H = (bf16_t*)(ws + WS_HB);
    const bf16_t* YB = (const bf16_t*)(ws + WS_P);
    const int* TOK = (const int*)(ws + WS_TOK); const float* WTS = (const float*)(ws + WS_WTS);
    LAS int* pst = (LAS int*)(F.lds);
    if (combine) {
        if (F.tid < NE) pst[32 + F.tid] = (int)__hip_atomic_load(ctl + CW_ECNT + ((l - 1) * NE + F.tid) * 64, RLX_AGENT);
        __syncthreads();
        if (F.tid == 0) { int run = 0; for (int e = 0; e < NE; ++e) { pst[e] = run; run += ((pst[32 + e] + 255) >> 8) << 8; } }
        __syncthreads();
    }
    const int rpw = nrows / NGW, row_base = gw * rpw;
    const int c0l = 4 * F.lane;
    int vcur = -1; f32x4 gt[4], st[4], g2v[4];
    if (FINAL) {
#pragma unroll
        for (int j = 0; j < 4; ++j) gt[j] = *(const GAS f32x4*)(A->in.norm_f + c0l + 256 * j);
    }
    v2u pxb[3][4]; f32x4 pxf[3][4]; int pt0[3], pt1[3]; float pw0[3], pw1[3];
#define N1_LOAD_GROUP(G0) do { _Pragma("unroll") for (int r = 0; r < 3; ++r) { const int rr = ((G0) + r < rpw) ? (G0) + r : rpw - 1; const int row = row_base + rr; \
        if (FROMIN) { const float* src = row < NX ? A->in.x + (size_t)row * D : A->in.ctx + (size_t)(row - NX) * D; _Pragma("unroll") for (int j = 0; j < 4; ++j) pxf[r][j] = *(const GAS f32x4*)(src + c0l + 256 * j); } \
        else { _Pragma("unroll") for (int j = 0; j < 4; ++j) pxb[r][j] = *(const GAS v2u*)(XB + (size_t)row * D + c0l + 256 * j); } \
        pt0[r] = 0; pt1[r] = 0; pw0[r] = 0.f; pw1[r] = 0.f; \
        if (combine) { pt0[r] = TOK[row * 2]; pt1[r] = TOK[row * 2 + 1]; pw0[r] = WTS[row * 2]; pw1[r] = WTS[row * 2 + 1]; } } } while (0)
    N1_LOAD_GROUP(0);
    for (int g0 = 0; g0 < rpw; g0 += 3) {
        int rows[3]; bool valid[3]; f32x4 x[3][4]; int t0[3], t1[3]; float w0[3], w1[3];
#pragma unroll
        for (int r = 0; r < 3; ++r) { valid[r] = g0 + r < rpw; rows[r] = row_base + (valid[r] ? g0 + r : rpw - 1); t0[r] = pt0[r]; t1[r] = pt1[r]; w0[r] = zero_w ? 0.f : pw0[r]; w1[r] = zero_w ? 0.f : pw1[r];
#pragma unroll
            for (int j = 0; j < 4; ++j) { if (FROMIN) x[r][j] = pxf[r][j]; else { const v2u a = pxb[r][j];
                x[r][j] = (f32x4){__builtin_bit_cast(float, a.x << 16), __builtin_bit_cast(float, a.x & 0xffff0000u), __builtin_bit_cast(float, a.y << 16), __builtin_bit_cast(float, a.y & 0xffff0000u)}; } } }
        v2u ya[3][4], yb[3][4];
        if (combine) {
#pragma unroll
            for (int r = 0; r < 3; ++r) { const bf16_t* y0 = YB + (size_t)(pst[t0[r] & 15] + (t0[r] >> 4)) * D; const bf16_t* y1 = YB + (size_t)(pst[t1[r] & 15] + (t1[r] >> 4)) * D;
#pragma unroll
                for (int j = 0; j < 4; ++j) { ya[r][j] = *(const GAS v2u*)(y0 + c0l + 256 * j); yb[r][j] = *(const GAS v2u*)(y1 + c0l + 256 * j); } }
        }
        if (g0 + 3 < rpw) N1_LOAD_GROUP(g0 + 3);
#pragma unroll
        for (int r = 0; r < 3; ++r) { const int row = rows[r]; const int v = variant_of_row(row);
            if (!FINAL && v != vcur) {
                vcur = v; const float* m = MOD + ((size_t)l * 9 + v) * 6144; f32x4 gn[4], scl[4];
#pragma unroll
                for (int j = 0; j < 4; ++j) { gn[j] = *(const GAS f32x4*)(A->in.norm1 + l * D + c0l + 256 * j); scl[j] = *(const GAS f32x4*)(m + D + c0l + 256 * j); st[j] = *(const GAS f32x4*)(m + c0l + 256 * j); }
#pragma unroll
                for (int j = 0; j < 4; ++j) gt[j] = gn[j] * (scl[j] + 1.f);
                if (combine) {
#pragma unroll
                    for (int j = 0; j < 4; ++j) g2v[j] = *(const GAS f32x4*)(MOD + ((size_t)(l - 1) * 9 + v) * 6144 + 5 * D + c0l + 256 * j); }
            }
            if (FINAL && combine && v != vcur) { vcur = v;
#pragma unroll
                for (int j = 0; j < 4; ++j) g2v[j] = *(const GAS f32x4*)(MOD + ((size_t)(l - 1) * 9 + v) * 6144 + 5 * D + c0l + 256 * j); }
            if (combine) {
#pragma unroll
                for (int j = 0; j < 4; ++j) { const v2u a = ya[r][j], b = yb[r][j];
                    const f32x4 fa = {__builtin_bit_cast(float, a.x << 16), __builtin_bit_cast(float, a.x & 0xffff0000u), __builtin_bit_cast(float, a.y << 16), __builtin_bit_cast(float, a.y & 0xffff0000u)};
                    const f32x4 fb = {__builtin_bit_cast(float, b.x << 16), __builtin_bit_cast(float, b.x & 0xffff0000u), __builtin_bit_cast(float, b.y << 16), __builtin_bit_cast(float, b.y & 0xffff0000u)};
                    x[r][j] = x[r][j] + g2v[j] * (fa * w0[r] + fb * w1[r]); } }
            if (!FINAL && (combine || FROMIN) && valid[r]) {
#pragma unroll
                for (int j = 0; j < 4; ++j) { v2u o; o.x = pk2(x[r][j].x, x[r][j].y); o.y = pk2(x[r][j].z, x[r][j].w); *(GAS v2u*)(XB + (size_t)row * D + c0l + 256 * j) = o; }
            }
            float ss = 0.f;
#pragma unroll
            for (int j = 0; j < 4; ++j) ss += (x[r][j].x * x[r][j].x + x[r][j].y * x[r][j].y) + (x[r][j].z * x[r][j].z + x[r][j].w * x[r][j].w);
            const float rinv = rsqrtf(wave_sum(ss) * (1.f / D) + 1e-6f);
            if (valid[r]) {
                if (FINAL) { float* dst = outp + (size_t)row * D;
#pragma unroll
                    for (int j = 0; j < 4; ++j) *(GAS f32x4*)(dst + c0l + 256 * j) = x[r][j] * rinv * gt[j];
                } else {
#pragma unroll
                    for (int j = 0; j < 4; ++j) { const f32x4 h = x[r][j] * rinv * gt[j] + st[j];
                        v2u o; o.x = pk2(h.x, h.y); o.y = pk2(h.z, h.w); *(GAS v2u*)(H + (size_t)row * D + c0l + 256 * j) = o; }
                }
            }
        }
    }
#undef N1_LOAD_GROUP
}
#define HAVE_GLA 1
constexpr int G_LG = 0;
constexpr int G_TMP = 32768;
constexpr int G_AO = 51200;
constexpr int G_VN = 76800;
constexpr int G_BS = 94208;
constexpr int G_OUT = 0;
__device__ __forceinline__ f32x16 mfma32(bf16x8 a, bf16x8 b, f32x16 c) { return __builtin_amdgcn_mfma_f32_32x32x16_bf16(a, b, c, 0, 0, 0); }
__device__ __forceinline__ float fast_logsigmoid(float x) { return fminf(x, 0.f) - __logf(1.f + __expf(-fabsf(x))); }
__device__ __forceinline__ void unpack8(const v4u w, float (&f)[8]) {
    f[0] = __builtin_bit_cast(float, w.x << 16); f[1] = __builtin_bit_cast(float, w.x & 0xffff0000u); f[2] = __builtin_bit_cast(float, w.y << 16); f[3] = __builtin_bit_cast(float, w.y & 0xffff0000u);
    f[4] = __builtin_bit_cast(float, w.z << 16); f[5] = __builtin_bit_cast(float, w.z & 0xffff0000u); f[6] = __builtin_bit_cast(float, w.w << 16); f[7] = __builtin_bit_cast(float, w.w & 0xffff0000u);
}
__device__ __forceinline__ v4u pack8(const float (&f)[8]) { v4u w; w.x = pk2(f[0], f[1]); w.y = pk2(f[2], f[3]); w.z = pk2(f[4], f[5]); w.w = pk2(f[6], f[7]); return w; }

typedef short v4i16_t __attribute__((ext_vector_type(4)));
__device__ __forceinline__ bf16x8 tr_frag(const LAS bf16_t* T, int ld, int k0, int n0, int lane) {
    const int hh = lane >> 5, blk = (lane >> 4) & 1, q = (lane & 15) >> 2, p = lane & 3;
    const LAS bf16_t* a0 = T + (k0 + 8 * hh + q) * ld + n0 + 16 * blk + 4 * p;
    const v4i16_t lo = __builtin_amdgcn_ds_read_tr16_b64_v4i16((LAS v4i16_t*)a0), hi = __builtin_amdgcn_ds_read_tr16_b64_v4i16((LAS v4i16_t*)(a0 + 4 * ld));
    bf16x8 r; r[0] = lo[0]; r[1] = lo[1]; r[2] = lo[2]; r[3] = lo[3]; r[4] = hi[0]; r[5] = hi[1]; r[6] = hi[2]; r[7] = hi[3]; return r;
}
struct DecPre { v4u a, bhi, blo; float bias; };
__device__ __forceinline__ void decays_load(DecPre& p, const Ctx& F, const bf16_t* P, const bf16_t* WGPl, const float* b_gkl, int r0, int h) {
    const int n = F.wave >> 2, tt = (F.wave >> 1) & 1, dt = F.wave & 1, r = F.lane & 31, hh = F.lane >> 5;
    p.a = *(const GAS v4u*)(P + (size_t)(r0 + 32 * tt + r) * PLD + 2048 + n * 16 + 8 * hh);
    const bf16_t* wg = WGPl + ((size_t)(n * 4 + h) * 64 + 32 * dt + r) * 16 + 8 * hh;
    p.bhi = *(const GAS v4u*)wg; p.blo = *(const GAS v4u*)(wg + 2 * 4 * 64 * 16);
    p.bias = b_gkl[n * 256 + h * 64 + 32 * dt + r];
}
__device__ __forceinline__ void chunk_decays(const Ctx& F, const DecPre& p) {
    LAS float* LG = (LAS float*)(F.lds + G_LG); LAS float* TT = (LAS float*)(F.lds + G_TMP);
    const int n = F.wave >> 2, tt = (F.wave >> 1) & 1, dt = F.wave & 1, r = F.lane & 31, hh = F.lane >> 5;
    f32x16 acc = {0.f, 0.f, 0.f, 0.f, 0.f, 0.f, 0.f, 0.f, 0.f, 0.f, 0.f, 0.f, 0.f, 0.f, 0.f, 0.f};
    acc = mfma32(__builtin_bit_cast(bf16x8, p.a), __builtin_bit_cast(bf16x8, p.bhi), acc);
    acc = mfma32(__builtin_bit_cast(bf16x8, p.a), __builtin_bit_cast(bf16x8, p.blo), acc);
    float v[16];
#pragma unroll
    for (int g = 0; g < 16; ++g) v[g] = fast_logsigmoid(acc[g] + p.bias) * (1.f / 16.f);
    float T[4], Pq[4];
    if (n == 0) {
#pragma unroll
        for (int q = 0; q < 4; ++q) { v[4 * q + 1] += v[4 * q]; v[4 * q + 2] += v[4 * q + 1]; v[4 * q + 3] += v[4 * q + 2]; T[q] = v[4 * q + 3]; }
    } else {
#pragma unroll
        for (int q = 0; q < 4; ++q) { v[4 * q + 2] += v[4 * q + 3]; v[4 * q + 1] += v[4 * q + 2]; v[4 * q] += v[4 * q + 1]; T[q] = v[4 * q]; }
    }
#pragma unroll
    for (int q = 0; q < 4; ++q) Pq[q] = __shfl_xor(T[q], 32);
    const float tot = ((T[0] + Pq[0]) + (T[1] + Pq[1])) + ((T[2] + Pq[2]) + (T[3] + Pq[3]));
    if (hh == 0) TT[(n * 2 + tt) * 64 + 32 * dt + r] = tot;
    float off[4];
    if (n == 0) { float run = 0.f;
#pragma unroll
        for (int q = 0; q < 4; ++q) { off[q] = run + (hh ? Pq[q] : 0.f); run += T[q] + Pq[q]; }
    } else { float run = 0.f;
#pragma unroll
        for (int q = 3; q >= 0; --q) { off[q] = run + (hh ? 0.f : Pq[q]); run += T[q] + Pq[q]; }
    }
    __syncthreads();
    const float xo = (n == 0) ? (tt == 1 ? TT[(0 * 2 + 0) * 64 + 32 * dt + r] : 0.f) : (tt == 0 ? TT[(1 * 2 + 1) * 64 + 32 * dt + r] : 0.f);
#pragma unroll
    for (int g = 0; g < 16; ++g) { const int t = 32 * tt + (g & 3) + 8 * (g >> 2) + 4 * hh; LG[(n * 64 + t) * 64 + 32 * dt + r] = v[g] + off[g >> 2] + xo; }
    __syncthreads();
}

struct KvPre { DecPre dec; v4u k, v0, v1; };
__device__ __forceinline__ void kv_decode(int job, int& b, int& h, int& j) { b = job / 144; const int rem = job % 144; h = rem / NCH; j = rem % NCH; }
__device__ __forceinline__ void kv_load(KvPre& p, const Ctx& F, KArgs A, int l, int job) {
    int b, h, j; kv_decode(job, b, h, j); const bf16_t* P = (const bf16_t*)(A->ws + WS_P); const int r0 = chunk_row0(b, j);
    decays_load(p.dec, F, P, (const bf16_t*)(A->ws + WS_WGP) + (size_t)l * 2 * 2 * 4 * 64 * 16, A->in.b_gk + (size_t)l * 2 * 256, r0, h);
    const int t = F.tid >> 3, dg = F.tid & 7; const bf16_t* pr = P + (size_t)(r0 + t) * PLD;
    p.k = *(const GAS v4u*)(pr + 768 + h * 64 + 8 * dg); p.v0 = *(const GAS v4u*)(pr + 1024 + h * 128 + 16 * dg); p.v1 = *(const GAS v4u*)(pr + 1024 + h * 128 + 16 * dg + 8);
}
__device__ __forceinline__ void kv_compute(const KvPre& p, const Ctx& F, unsigned char* ws, int job) {
    int b, h, j; kv_decode(job, b, h, j);
    chunk_decays(F, p.dec);
    LAS float* LG = (LAS float*)(F.lds + G_LG);
    LAS bf16_t* KEF = (LAS bf16_t*)(F.lds + G_AO); LAS bf16_t* KEB = KEF + 64 * 72; LAS bf16_t* VN = (LAS bf16_t*)(F.lds + G_VN);
    { const int t = F.tid >> 3, dg = F.tid & 7;
      float k[8]; unpack8(p.k, k); float kf[8], kb[8];
#pragma unroll
      for (int i = 0; i < 8; ++i) { const int d = 8 * dg + i;
          kf[i] = k[i] * __expf(LG[63 * 64 + d] - LG[t * 64 + d]); kb[i] = k[i] * __expf(LG[64 * 64 + d] - LG[(64 + t) * 64 + d]); }
      *(LAS v4u*)(KEF + t * 72 + 8 * dg) = pack8(kf); *(LAS v4u*)(KEB + t * 72 + 8 * dg) = pack8(kb);
      *(LAS v4u*)(VN + t * 136 + 16 * dg) = p.v0; *(LAS v4u*)(VN + t * 136 + 16 * dg + 8) = p.v1; }
    const int seq0 = (b * 4 + h) * 2;
    if (F.tid < 128) { const int n = F.tid >> 6, d = F.tid & 63; float* ADEC = (float*)(ws + WS_ADEC);
        ADEC[((size_t)(seq0 + n) * NCH + j) * 64 + d] = __expf(n == 0 ? LG[63 * 64 + d] : LG[64 * 64 + d]); }
    __syncthreads();
    { const int dir = F.wave >> 2, et = F.wave & 3, r = F.lane & 31, hh = F.lane >> 5;
      const LAS bf16_t* KE = dir ? KEB : KEF;
      f32x16 a0 = {0.f, 0.f, 0.f, 0.f, 0.f, 0.f, 0.f, 0.f, 0.f, 0.f, 0.f, 0.f, 0.f, 0.f, 0.f, 0.f}, a1 = a0;
#pragma unroll
      for (int ks = 0; ks < 4; ++ks) { const bf16x8 av = tr_frag(VN, 136, 16 * ks, 32 * et, F.lane);
          const bf16x8 b0 = tr_frag(KE, 72, 16 * ks, 0, F.lane), b1 = tr_frag(KE, 72, 16 * ks, 32, F.lane);
          a0 = mfma32(av, b0, a0); a1 = mfma32(av, b1, a1); }
      bf16_t* KVS = (bf16_t*)(ws + WS_KVS) + ((size_t)(seq0 + dir) * NCH + j) * 8192;
#pragma unroll
      for (int g = 0; g < 16; ++g) { const int e = 32 * et + (g & 3) + 8 * (g >> 2) + 4 * hh; KVS[e * 64 + r] = (bf16_t)pk2(a0[g], 0.f); KVS[e * 64 + 32 + r] = (bf16_t)pk2(a1[g], 0.f); } }
    __syncthreads();
}

template <int HW>
__device__ __forceinline__ void pool_job_t(int l, int pj, int g) {
    const Ctx F = mkctx(); KArgs A = kargs(); unsigned char* const ws = A->ws;
    const bf16_t* P = (const bf16_t*)(ws + WS_P);
    LAS float* VS = (LAS float*)(F.lds);
    LAS bf16_t* PD = (LAS bf16_t*)(F.lds + 33792);
    LAS bf16_t* WP = (LAS bf16_t*)(F.lds + 33792 + 17408);
    const bool latent = pj < 1024;
    int b, i64; if (latent) { b = pj >> 7; i64 = (pj >> 2) & 31; } else { const int q = pj - 1024; b = q >> 4; i64 = (q >> 2) & 3; }
    const int row0 = latent ? b * SEQ + i64 * 64 : NX + b * CTXL + i64 * 64;
    v4u wpre[4];
    { const bf16_t* wsrc = (const bf16_t*)(ws + WS_WPOOL) + (size_t)(l * 4 + g) * 128 * 128;
#pragma unroll
      for (int c = 0; c < 4; ++c) { const int u = F.tid + NTHR * c, d = u >> 4, q = u & 15; wpre[c] = *(const GAS v4u*)(wsrc + d * 128 + 8 * q); } }
    const float psc = A->in.pool_scale[l * 512 + g * 128 + 32 * (F.wave & 3) + (F.lane & 31)];
    v4u upre[2];
#pragma unroll
    for (int c = 0; c < 2; ++c) { const int u = F.tid + NTHR * c, jc = u >> 4, cg = u & 15; upre[c] = *(const GAS v4u*)(P + (size_t)(row0 + jc) * PLD + g * 128 + 8 * cg); }
    if (latent) {
        const int rlo = max(i64 - HW, 0), rhi = min(i64 + HW, 32); const float rc = 1.f / (float)(rhi - rlo);
#pragma unroll
        for (int c = 0; c < 2; ++c) { const int u = F.tid + NTHR * c, jc = u >> 4, cg = u & 15; float s[8];
#pragma unroll
            for (int i = 0; i < 8; ++i) s[i] = 0.f;
            v4u ld[2 * HW];
#pragma unroll
            for (int k = 0; k < 2 * HW; ++k) { const int r2 = min(max(i64 - HW + k, 0), 31); ld[k] = *(const GAS v4u*)(P + (size_t)(b * SEQ + r2 * 64 + jc) * PLD + g * 128 + 8 * cg); }
#pragma unroll
            for (int k = 0; k < 2 * HW; ++k) { const int r2 = i64 - HW + k; const float wt = (r2 >= 0 && r2 < 32) ? 1.f : 0.f; float f[8]; unpack8(ld[k], f);
#pragma unroll
                for (int i = 0; i < 8; ++i) s[i] += wt * f[i]; }
#pragma unroll
            for (int i = 0; i < 8; ++i) VS[jc * 132 + 8 * cg + i] = s[i] * rc; }
    }
#pragma unroll
    for (int c = 0; c < 4; ++c) { const int u = F.tid + NTHR * c, d = u >> 4, q = u & 15; *(LAS v4u*)(WP + d * 136 + 8 * q) = wpre[c]; }
    if (latent) __syncthreads();
#pragma unroll
    for (int c = 0; c < 2; ++c) { const int u = F.tid + NTHR * c, jc = u >> 4, cg = u & 15; float s[8];
#pragma unroll
        for (int i = 0; i < 8; ++i) s[i] = 0.f;
        float cnt;
        if (latent) { const int clo = max(jc - HW, 0), chi = min(jc + HW, 64); cnt = (float)(chi - clo);
#pragma unroll
            for (int k = 0; k < 2 * HW; ++k) { const int j2 = jc - HW + k; const float wt = (j2 >= 0 && j2 < 64) ? 1.f : 0.f; const int j2c = min(max(j2, 0), 63);
                const f32x4 v0 = *(const LAS f32x4*)(VS + j2c * 132 + 8 * cg), v1 = *(const LAS f32x4*)(VS + j2c * 132 + 8 * cg + 4);
                s[0] += wt * v0.x; s[1] += wt * v0.y; s[2] += wt * v0.z; s[3] += wt * v0.w; s[4] += wt * v1.x; s[5] += wt * v1.y; s[6] += wt * v1.z; s[7] += wt * v1.w; } }
        else { const int t = i64 * 64 + jc; const int lo = max(t - HW, 0), hi = min(t + HW, CTXL); cnt = (float)(hi - lo);
            v4u ld[2 * HW];
#pragma unroll
            for (int k = 0; k < 2 * HW; ++k) { const int t2 = min(max(t - HW + k, 0), CTXL - 1); ld[k] = *(const GAS v4u*)(P + (size_t)(NX + b * CTXL + t2) * PLD + g * 128 + 8 * cg); }
#pragma unroll
            for (int k = 0; k < 2 * HW; ++k) { const int t2 = t - HW + k; const float wt = (t2 >= 0 && t2 < CTXL) ? 1.f : 0.f; float f[8]; unpack8(ld[k], f);
#pragma unroll
                for (int i = 0; i < 8; ++i) s[i] += wt * f[i]; } }
        float uv[8]; unpack8(upre[c], uv);
        const float ic = 1.f / cnt; float pd[8];
#pragma unroll
        for (int i = 0; i < 8; ++i) pd[i] = s[i] * ic - uv[i];
        *(LAS v4u*)(PD + jc * 136 + 8 * cg) = pack8(pd); }
    __syncthreads();
    { const int mt = F.wave >> 2, nt = F.wave & 3, r = F.lane & 31, hh = F.lane >> 5;
      f32x16 acc = {0.f, 0.f, 0.f, 0.f, 0.f, 0.f, 0.f, 0.f, 0.f, 0.f, 0.f, 0.f, 0.f, 0.f, 0.f, 0.f};
#pragma unroll
      for (int ks = 0; ks < 8; ++ks) { const bf16x8 av = *(const LAS bf16x8*)(PD + (32 * mt + r) * 136 + 16 * ks + 8 * hh), bv = *(const LAS bf16x8*)(WP + (32 * nt + r) * 136 + 16 * ks + 8 * hh);
          acc = mfma32(av, bv, acc); }
      const int dcol = g * 128 + 32 * nt + r;
      bf16_t* MIX = (bf16_t*)(ws + WS_HB);
#pragma unroll
      for (int q = 0; q < 16; ++q) { const int jc = 32 * mt + (q & 3) + 8 * (q >> 2) + 4 * hh; MIX[(size_t)(row0 + jc) * D + dcol] = (bf16_t)pk2(acc[q] * psc, 0.f); } }
    __syncthreads();
}
__device__ __forceinline__ void pool_job(int l, int pj) {
    const int g = ((pj & 3) + (pj >> 8)) & 3;
    if (g == 0) pool_job_t<1>(l, pj, 0); else if (g == 1) pool_job_t<2>(l, pj, 1); else if (g == 2) pool_job_t<4>(l, pj, 2); else pool_job_t<8>(l, pj, 3);
}

__device__ __forceinline__ void gla_phase1(int l) {
    const int npool = (l < DEPTH - 1) ? 1152 : 1024;
    const int pflags = kargs()->flags;
    if (!(pflags & 4)) {
        const Ctx F = mkctx(); KArgs A = kargs(); unsigned char* const ws = A->ws;
        int job = blockIdx.x; KvPre pre;
        if (job < 1152) kv_load(pre, F, A, l, job);
        while (job < 1152) {
            const KvPre cur = pre; const int nj = job + gridDim.x;
            if (nj < 1152) kv_load(pre, F, A, l, nj);
            kv_compute(cur, F, ws, job);
            job = nj;
        }
    }
    if (!(pflags & 2)) for (int J = blockIdx.x; J < 1152 + npool; J += gridDim.x) if (J >= 1152) pool_job(l, J - 1152);
}

__device__ __forceinline__ void gla_phase2(int l) {
    const Ctx F = mkctx(); KArgs A = kargs(); unsigned char* const ws = A->ws;
    const int gid = F.bid * NTHR + F.tid; if (gid >= 64 * 2048) return;
    const int seq = gid >> 11, rem = gid & 2047, e = rem >> 4, dq = rem & 15, dir = seq & 1;
    bf16_t* base = (bf16_t*)(ws + WS_KVS) + (size_t)seq * NCH * 8192 + e * 64 + 4 * dq;
    const float* adec = (const float*)(ws + WS_ADEC) + (size_t)seq * NCH * 64 + 4 * dq;
    f32x4 S = {0.f, 0.f, 0.f, 0.f};
    for (int bt = 0; bt < 3; ++bt) {
        v2u kv[12]; f32x4 av[12];
#pragma unroll
        for (int i = 0; i < 12; ++i) { const int s = bt * 12 + i; const int jj = dir == 0 ? s : (s < 4 ? 3 - s : 39 - s);
            kv[i] = *(const GAS v2u*)(base + (size_t)jj * 8192); av[i] = *(const GAS f32x4*)(adec + jj * 64); }
#pragma unroll
        for (int i = 0; i < 12; ++i) { const int s = bt * 12 + i; const int jj = dir == 0 ? s : (s < 4 ? 3 - s : 39 - s);
            v2u o; o.x = pk2(S.x, S.y); o.y = pk2(S.z, S.w); *(GAS v2u*)(base + (size_t)jj * 8192) = o;
            const f32x4 k4 = {__builtin_bit_cast(float, kv[i].x << 16), __builtin_bit_cast(float, kv[i].x & 0xffff0000u), __builtin_bit_cast(float, kv[i].y << 16), __builtin_bit_cast(float, kv[i].y & 0xffff0000u)};
            S = av[i] * S + k4; }
    }
}

struct OutPre { DecPre dec; v4u q, k, v0, v1, g0, g1, sf0, sf1, sb0, sb1; f32x4 gg[4]; };
__device__ __forceinline__ void out_load(OutPre& p, const Ctx& F, KArgs A, int l, int job) {
    int b, h, j; kv_decode(job, b, h, j); const bf16_t* P = (const bf16_t*)(A->ws + WS_P); const int r0 = chunk_row0(b, j);
    decays_load(p.dec, F, P, (const bf16_t*)(A->ws + WS_WGP) + (size_t)l * 2 * 2 * 4 * 64 * 16, A->in.b_gk + (size_t)l * 2 * 256, r0, h);
    const int t = F.tid >> 3, dg = F.tid & 7; const bf16_t* pr = P + (size_t)(r0 + t) * PLD;
    p.q = *(const GAS v4u*)(pr + 512 + h * 64 + 8 * dg); p.k = *(const GAS v4u*)(pr + 768 + h * 64 + 8 * dg);
    p.v0 = *(const GAS v4u*)(pr + 1024 + h * 128 + 16 * dg); p.v1 = *(const GAS v4u*)(pr + 1024 + h * 128 + 16 * dg + 8);
    p.g0 = *(const GAS v4u*)(pr + 1536 + h * 128 + 16 * dg); p.g1 = *(const GAS v4u*)(pr + 1536 + h * 128 + 16 * dg + 8);
#pragma unroll
    for (int c = 0; c < 4; ++c) p.gg[c] = *(const GAS f32x4*)(A->in.gla_gain + l * 128 + 16 * dg + 4 * c);
    const int e = F.tid >> 2, q4 = F.tid & 3; const bf16_t* sf = (const bf16_t*)(A->ws + WS_KVS) + ((size_t)((b * 4 + h) * 2) * NCH + j) * 8192 + e * 64 + 16 * q4;
    p.sf0 = *(const GAS v4u*)sf; p.sf1 = *(const GAS v4u*)(sf + 8); p.sb0 = *(const GAS v4u*)(sf + (size_t)NCH * 8192); p.sb1 = *(const GAS v4u*)(sf + (size_t)NCH * 8192 + 8);
}
__device__ __forceinline__ void out_compute(const OutPre& p, const Ctx& F, KArgs A, int l, int job) {
    int b, h, j; kv_decode(job, b, h, j); unsigned char* const ws = A->ws; const int r0 = chunk_row0(b, j);
    chunk_decays(F, p.dec);
    LAS float* LG = (LAS float*)(F.lds + G_LG);
    LAS bf16_t* KTF = (LAS bf16_t*)(F.lds + G_TMP); LAS bf16_t* KTB = KTF + 64 * 72;
    LAS bf16_t* AO = (LAS bf16_t*)(F.lds + G_AO); LAS bf16_t* VN = (LAS bf16_t*)(F.lds + G_VN); LAS bf16_t* BS = (LAS bf16_t*)(F.lds + G_BS);
    { const int t = F.tid >> 3, dg = F.tid & 7;
      float q[8], k[8]; unpack8(p.q, q); unpack8(p.k, k);
      float qf[8], qb[8], kf[8], kb[8];
#pragma unroll
      for (int i = 0; i < 8; ++i) { const int d = 8 * dg + i; const float bf = LG[t * 64 + d], bb = LG[(64 + t) * 64 + d];
          qf[i] = q[i] * __expf(bf); kf[i] = k[i] * __expf(-bf); qb[i] = q[i] * __expf(bb); kb[i] = k[i] * __expf(-bb); }
      *(LAS v4u*)(AO + t * 200 + 64 + 8 * dg) = pack8(qf); *(LAS v4u*)(AO + t * 200 + 128 + 8 * dg) = pack8(qb);
      *(LAS v4u*)(KTF + t * 72 + 8 * dg) = pack8(kf); *(LAS v4u*)(KTB + t * 72 + 8 * dg) = pack8(kb);
      *(LAS v4u*)(VN + t * 136 + 16 * dg) = p.v0; *(LAS v4u*)(VN + t * 136 + 16 * dg + 8) = p.v1; }
    { const int e = F.tid >> 2, q4 = F.tid & 3;
      *(LAS v4u*)(BS + e * 136 + 16 * q4) = p.sf0; *(LAS v4u*)(BS + e * 136 + 16 * q4 + 8) = p.sf1; *(LAS v4u*)(BS + e * 136 + 64 + 16 * q4) = p.sb0; *(LAS v4u*)(BS + e * 136 + 64 + 16 * q4 + 8) = p.sb1; }
    __syncthreads();
    const int mt = F.wave >> 2, nt = F.wave & 3, r = F.lane & 31, hh = F.lane >> 5;
    f32x16 acc = {0.f, 0.f, 0.f, 0.f, 0.f, 0.f, 0.f, 0.f, 0.f, 0.f, 0.f, 0.f, 0.f, 0.f, 0.f, 0.f};
    if (F.wave < 4) {
        const int tt = F.wave == 0 ? 0 : (F.wave == 1 ? 1 : (F.wave == 2 ? 1 : 0)), st = F.wave == 0 ? 0 : (F.wave == 1 ? 1 : (F.wave == 2 ? 0 : 1));
        const bool dof = F.wave != 3, dob = F.wave != 2;
        f32x16 af = {0.f, 0.f, 0.f, 0.f, 0.f, 0.f, 0.f, 0.f, 0.f, 0.f, 0.f, 0.f, 0.f, 0.f, 0.f, 0.f}, ab = af;
        if (dof) {
#pragma unroll
            for (int ks = 0; ks < 4; ++ks) af = mfma32(*(const LAS bf16x8*)(AO + (32 * tt + r) * 200 + 64 + 16 * ks + 8 * hh), *(const LAS bf16x8*)(KTF + (32 * st + r) * 72 + 16 * ks + 8 * hh), af); }
        if (dob) {
#pragma unroll
            for (int ks = 0; ks < 4; ++ks) ab = mfma32(*(const LAS bf16x8*)(AO + (32 * tt + r) * 200 + 128 + 16 * ks + 8 * hh), *(const LAS bf16x8*)(KTB + (32 * st + r) * 72 + 16 * ks + 8 * hh), ab); }
        const bool diag = tt == st;
#pragma unroll
        for (int g = 0; g < 16; ++g) { const int trow = (g & 3) + 8 * (g >> 2) + 4 * hh;
            float v = af[g] + ab[g];
            if (diag) v = (r <= trow ? af[g] : 0.f) + (r >= trow ? ab[g] : 0.f);
            AO[(32 * tt + trow) * 200 + 32 * st + r] = (bf16_t)pk2(v, 0.f); }
    }
#pragma unroll
    for (int ks = 4; ks < 12; ++ks) acc = mfma32(*(const LAS bf16x8*)(AO + (32 * mt + r) * 200 + 16 * ks + 8 * hh), *(const LAS bf16x8*)(BS + (32 * nt + r) * 136 + 16 * (ks - 4) + 8 * hh), acc);
    __syncthreads();
    {
#pragma unroll
      for (int ks = 0; ks < 4; ++ks) acc = mfma32(*(const LAS bf16x8*)(AO + (32 * mt + r) * 200 + 16 * ks + 8 * hh), tr_frag(VN, 136, 16 * ks, 32 * nt, F.lane), acc);
      LAS float* OUT = (LAS float*)(F.lds + G_OUT);
#pragma unroll
      for (int g = 0; g < 16; ++g) { const int trow = 32 * mt + (g & 3) + 8 * (g >> 2) + 4 * hh; OUT[trow * 132 + 32 * nt + r] = acc[g]; } }
    __syncthreads();
    { const int t = F.tid >> 3, eg = F.tid & 7; const LAS float* o = (const LAS float*)(F.lds + G_OUT) + t * 132 + 16 * eg;
      float ov[16]; float ss = 0.f;
#pragma unroll
      for (int i = 0; i < 4; ++i) { const f32x4 x4 = *(const LAS f32x4*)(o + 4 * i); ov[4 * i] = x4.x; ov[4 * i + 1] = x4.y; ov[4 * i + 2] = x4.z; ov[4 * i + 3] = x4.w; ss += (x4.x * x4.x + x4.y * x4.y) + (x4.z * x4.z + x4.w * x4.w); }
      ss += __shfl_xor(ss, 1); ss += __shfl_xor(ss, 2); ss += __shfl_xor(ss, 4);
      const float rinv = rsqrtf(ss * (1.f / 128.f) + 1e-6f);
      float gg[16];
#pragma unroll
      for (int c = 0; c < 4; ++c) { gg[4 * c] = p.gg[c].x; gg[4 * c + 1] = p.gg[c].y; gg[4 * c + 2] = p.gg[c].z; gg[4 * c + 3] = p.gg[c].w; }
      bf16_t* mp = (bf16_t*)(ws + WS_HB) + (size_t)(r0 + t) * D + 512 + h * 128 + 16 * eg;
#pragma unroll
      for (int c = 0; c < 2; ++c) { float gv[8]; unpack8(c ? p.g1 : p.g0, gv); float y[8];
#pragma unroll
          for (int i = 0; i < 8; ++i) { const float gx = gv[i]; y[i] = ov[8 * c + i] * rinv * gg[8 * c + i] * gx * __builtin_amdgcn_rcpf(1.f + __expf(-gx)); }
          *(GAS v4u*)(mp + 8 * c) = pack8(y); } }
    __syncthreads();
}
__device__ __forceinline__ int out_next(int l, int job, int G) { job += G; if (l == DEPTH - 1) while (job < 1152 && (job % 144) % NCH < 4) job += G; return job; }
__device__ __forceinline__ void gla_phase3(int l) {
    const Ctx F = mkctx(); KArgs A = kargs();
    const int G = gridDim.x; int job = out_next(l, (int)blockIdx.x - G, G); OutPre pre;
    if (job < 1152) out_load(pre, F, A, l, job);
    while (job < 1152) {
        const OutPre cur = pre; const int nj = out_next(l, job, G);
        if (nj < 1152) out_load(pre, F, A, l, nj);
        out_compute(cur, F, A, l, job);
        job = nj;
    }
}
#define HAVE_MOE 1
#define DPPF(x, ctrl) __builtin_bit_cast(float, __builtin_amdgcn_update_dpp(0, __builtin_bit_cast(int, (x)), (ctrl), 0xF, 0xF, true))
__device__ __forceinline__ float reduce16(const float (&a)[16], int lane) {
    float b8[8], b4[4], b2[2];
    bool h = (lane & 8) != 0;
#pragma unroll
    for (int i = 0; i < 8; ++i) { const float keep = h ? a[8 + i] : a[i], send = h ? a[i] : a[8 + i]; b8[i] = keep + DPPF(send, 0x140); }
    h = (lane & 4) != 0;
#pragma unroll
    for (int i = 0; i < 4; ++i) { const float keep = h ? b8[4 + i] : b8[i], send = h ? b8[i] : b8[4 + i]; b4[i] = keep + DPPF(send, 0x141); }
    h = (lane & 2) != 0;
#pragma unroll
    for (int i = 0; i < 2; ++i) { const float keep = h ? b4[2 + i] : b4[i], send = h ? b4[i] : b4[2 + i]; b2[i] = keep + DPPF(send, 0x4E); }
    h = (lane & 1) != 0;
    float r; { const float keep = h ? b2[1] : b2[0], send = h ? b2[0] : b2[1]; r = keep + DPPF(send, 0xB1); }
    r += __shfl_xor(r, 16); r += __shfl_xor(r, 32);
    return r;
}

__device__ __forceinline__ void router_phase(int l, int nrows) {
    const Ctx F = mkctx(); KArgs A = kargs(); unsigned char* const ws = A->ws;
    constexpr int WRS = D + 4;
    LAS float* WRT = (LAS float*)F.lds;
    LAS float* LGS = (LAS float*)(F.lds + 69632);
    LAS int* CNT = (LAS int*)(F.lds + 69632 + 2048);
    LAS int* BASE = CNT + 16;
    LAS int* ASG = (LAS int*)(F.lds + 69632 + 4096);
    { const float* wr = A->in.w_router;
      float wl[32];
#pragma unroll
      for (int c = 0; c < 32; ++c) wl[c] = wr[F.tid + NTHR * c];
#pragma unroll
      for (int c = 0; c < 32; ++c) { const int i = F.tid + NTHR * c; WRT[(i & 15) * WRS + (i >> 4)] = wl[c]; } }
    if (F.tid < 32) CNT[F.tid] = 0;
    __syncthreads();
    const bf16_t* XB = (const bf16_t*)(ws + WS_XB);
    const float* MODl = (const float*)(ws + WS_MOD) + (size_t)l * 9 * 6144;
    bf16_t* H = (bf16_t*)(ws + WS_HB);
    float* WTS = (float*)(ws + WS_WTS);
    const float rb_lane = A->in.router_bias[F.lane & 15];
    const int rpb = nrows / F.G, rpw = rpb / NWAVES;
    const int row_base = F.bid * rpb + F.wave * rpw;
    LAS float* GT = (LAS float*)(F.lds + 77824); LAS float* ST = GT + 2048;
    const int v0 = variant_of_row(F.bid * rpb), v1 = variant_of_row(F.bid * rpb + rpb - 1);
    { float tn[4], tsc[4], tsh[4];
#pragma unroll
      for (int c = 0; c < 4; ++c) { const int i = F.tid + NTHR * c, ti = i >> 10, k = i & 1023; const float* m = MODl + (size_t)(ti ? v1 : v0) * 6144;
          tn[c] = A->in.norm2[l * D + k]; tsc[c] = m[4 * D + k]; tsh[c] = m[3 * D + k]; }
#pragma unroll
      for (int c = 0; c < 4; ++c) { const int i = F.tid + NTHR * c; GT[i] = tn[c] * (1.f + tsc[c]); ST[i] = tsh[c]; } }
    v2u xq[3][4];
#pragma unroll
    for (int r = 0; r < 3; ++r) { const int rr = (r < rpw) ? r : rpw - 1;
#pragma unroll
        for (int j = 0; j < 4; ++j) xq[r][j] = *(const GAS v2u*)(XB + (size_t)(row_base + rr) * D + 4 * F.lane + 256 * j); }
    __syncthreads();
    for (int g0 = 0; g0 < rpw; g0 += 3) {
        int lane_ = F.lane; asm volatile("" : "+v"(lane_));
        const int lane = lane_;
        f32x4 hx[3][4]; int rws[3]; bool vld[3];
#pragma unroll
        for (int r = 0; r < 3; ++r) {
            const int rr = (g0 + r < rpw) ? g0 + r : rpw - 1; rws[r] = row_base + rr; vld[r] = (g0 + r < rpw);
#pragma unroll
            for (int j = 0; j < 4; ++j) { const v2u a = xq[r][j];
                hx[r][j] = (f32x4){__builtin_bit_cast(float, a.x << 16), __builtin_bit_cast(float, a.x & 0xffff0000u), __builtin_bit_cast(float, a.y << 16), __builtin_bit_cast(float, a.y & 0xffff0000u)}; } }
        if (g0 + 3 < rpw) {
#pragma unroll
            for (int r = 0; r < 3; ++r) { const int rr = (g0 + 3 + r < rpw) ? g0 + 3 + r : rpw - 1;
#pragma unroll
                for (int j = 0; j < 4; ++j) xq[r][j] = *(const GAS v2u*)(XB + (size_t)(row_base + rr) * D + 4 * lane + 256 * j); } }
#pragma unroll
        for (int r = 0; r < 3; ++r) { const int row = rws[r]; float ss = 0.f;
#pragma unroll
            for (int j = 0; j < 4; ++j) ss += (hx[r][j].x * hx[r][j].x + hx[r][j].y * hx[r][j].y) + (hx[r][j].z * hx[r][j].z + hx[r][j].w * hx[r][j].w);
            const float rinv = rsqrtf(wave_sum(ss) * (1.f / D) + 1e-6f);
            const int ti = variant_of_row(row) == v0 ? 0 : 1024;
#pragma unroll
            for (int j = 0; j < 4; ++j) { const int c0 = 4 * lane + 256 * j;
                const f32x4 gt = *(const LAS f32x4*)(GT + ti + c0), sh = *(const LAS f32x4*)(ST + ti + c0);
                const f32x4 h = hx[r][j] * rinv * gt + sh; hx[r][j] = h;
                if (vld[r]) { v2u o; o.x = pk2(h.x, h.y); o.y = pk2(h.z, h.w); *(GAS v2u*)(H + (size_t)row * D + c0) = o; } }
        }
#pragma unroll
        for (int r = 0; r < 3; ++r)
#pragma unroll
            for (int j = 0; j < 4; ++j) asm volatile("" : "+v"(hx[r][j]));
        typedef float f32x2 __attribute__((ext_vector_type(2)));
        float acc[3][16];
#pragma unroll
        for (int e = 0; e < 16; ++e) {
            f32x2 a2[3] = {{0.f, 0.f}, {0.f, 0.f}, {0.f, 0.f}};
#pragma unroll
            for (int j = 0; j < 4; ++j) { const f32x4 w = *(const LAS f32x4*)(WRT + e * WRS + 4 * lane + 256 * j); const f32x2 wl = {w.x, w.y}, wh = {w.z, w.w};
#pragma unroll
                for (int r = 0; r < 3; ++r) { const f32x2 xl = {hx[r][j].x, hx[r][j].y}, xh = {hx[r][j].z, hx[r][j].w}; a2[r] = __builtin_elementwise_fma(xl, wl, a2[r]); a2[r] = __builtin_elementwise_fma(xh, wh, a2[r]); } }
#pragma unroll
            for (int r = 0; r < 3; ++r) acc[r][e] = a2[r].x + a2[r].y;
            asm volatile("" : "+v"(acc[0][e]), "+v"(acc[1][e]), "+v"(acc[2][e]) :: "memory");
        }
        float tot3[3];
#pragma unroll
        for (int r = 0; r < 3; ++r) tot3[r] = reduce16(acc[r], lane);
        { const int q = lane >> 4, e = lane & 15, g = e >> 2, jp = e & 3;
          const float val = q == 0 ? tot3[0] : (q == 1 ? tot3[1] : tot3[2]);
          const float sg = sigmoid_f(val), sb = sg + rb_lane;
          const float va = DPPF(sb, 0x4E), vb = DPPF(sb, 0xB1), vc = DPPF(sb, 0x1B);
          const float hi1 = fmaxf(sb, va), lo1 = fminf(sb, va), hi2 = fmaxf(vb, vc), lo2 = fminf(vb, vc);
          const float gs = fmaxf(hi1, hi2) + fmaxf(fminf(hi1, hi2), fmaxf(lo1, lo2));
          const float gb = DPPF(gs, 0x141), gc = DPPF(gs, 0x140), ga = DPPF(gb, 0x140);
          float bestv = gs; int bestg = g;
          { const int ia = g ^ 2; if (ga > bestv || (ga == bestv && ia < bestg)) { bestv = ga; bestg = ia; } }
          { const int ib = g ^ 1; if (gb > bestv || (gb == bestv && ib < bestg)) { bestv = gb; bestg = ib; } }
          { const int ic = g ^ 3; if (gc > bestv || (gc == bestv && ic < bestg)) { bestv = gc; bestg = ic; } }
          const int rank = ((va > sb || (va == sb && (jp ^ 2) < jp)) ? 1 : 0) + ((vb > sb || (vb == sb && (jp ^ 1) < jp)) ? 1 : 0) + ((vc > sb || (vc == sb && (jp ^ 3) < jp)) ? 1 : 0);
          if (q < 3 && g == bestg && rank < 2) { LGS[((F.wave * 3 + q) * 2 + rank) * 2] = __builtin_bit_cast(float, e); LGS[((F.wave * 3 + q) * 2 + rank) * 2 + 1] = sg; } }
        LDS_WAIT(); asm volatile("" ::: "memory");
        if ((lane & 15) == 0 && (lane >> 4) < 3 && g0 + (lane >> 4) < rpw) { const int q = lane >> 4;
            const LAS float* sl = LGS + (F.wave * 3 + q) * 4;
            const int e0 = __builtin_bit_cast(int, sl[0]), e1 = __builtin_bit_cast(int, sl[2]); const float s0 = sl[1], s1 = sl[3];
            const int rl = F.wave * rpw + g0 + q, row = F.bid * rpb + rl;
            const float wsum = s0 + s1;
            WTS[row * 2] = s0 / wsum; WTS[row * 2 + 1] = s1 / wsum;
            const int p0 = __hip_atomic_fetch_add(CNT + e0, 1, __ATOMIC_RELAXED, __HIP_MEMORY_SCOPE_WORKGROUP);
            const int p1 = __hip_atomic_fetch_add(CNT + e1, 1, __ATOMIC_RELAXED, __HIP_MEMORY_SCOPE_WORKGROUP);
            ASG[rl * 4 + 0] = e0; ASG[rl * 4 + 1] = p0; ASG[rl * 4 + 2] = e1; ASG[rl * 4 + 3] = p1;
        }
        LDS_WAIT(); asm volatile("" ::: "memory");
    }
    __syncthreads();
    gu32* ecnt = (gu32*)(ws + WS_CTL) + CW_ECNT + l * NE * 64;
    if (F.tid < NE) BASE[F.tid] = (int)__hip_atomic_fetch_add(ecnt + F.tid * 64, (unsigned)CNT[F.tid], __ATOMIC_RELAXED, __HIP_MEMORY_SCOPE_AGENT);
    __syncthreads();
    int* LIST = (int*)(ws + WS_LIST); int* TOK = (int*)(ws + WS_TOK);
    if (F.tid < rpb) { const int row = F.bid * rpb + F.tid;
#pragma unroll
        for (int k = 0; k < 2; ++k) { const int e = ASG[F.tid * 4 + 2 * k], p = ASG[F.tid * 4 + 2 * k + 1] + BASE[e]; LIST[e * NT + p] = row; TOK[row * 2 + k] = e | (p << 4); } }
}
enum { PH_PRO = 0, PH_N1 = 0, PH_GIN = 1, PH_G1 = 2, PH_G2 = 3, PH_G3 = 4, PH_GOUT = 5, PH_R2 = 6, PH_GUP = 7, PH_GDN = 8, PH_PER_LAYER = 9, PH_FINAL = 1 + 9 * DEPTH, PH_END = PH_FINAL + 1 };

__global__ void __launch_bounds__(NTHR, 2) mega_fwd(Args args_unused) {
    LAS unsigned char* const lds = (LAS unsigned char*)lds_raw;
    volatile LAS unsigned* MISC = (volatile LAS unsigned*)(lds + MISC_OFF);
    for (int u = threadIdx.x; u < (LDS_BYTES - LDSCTL_OFF) / 4; u += NTHR) ((LAS unsigned*)(lds + LDSCTL_OFF))[u] = 0u;
    __syncthreads();
    int lo, hi; bool comb_en; unsigned* barw;
    bool probe16;
    { KArgs A = kargs(); lo = A->ph_lo; hi = A->ph_hi; comb_en = (A->flags & 1) != 0; probe16 = (A->flags & 16) != 0; if (probe16) comb_en = true; barw = (unsigned*)(A->ws + WS_CTL) + CW_BAR; }
    const bool multi = (hi - lo) > 1;
    XcdBarrier bar; bar.bar = barw; bar.x = 0; bar.st = nullptr;
    if (multi) bar = xcd_barrier_post(barw, MISC + 8);
    for (int ph = lo; ph < hi; ++ph) {
        if (ph == PH_PRO) {
            p0_prologue();
        } else if (ph == PH_FINAL) {
            rowpass_n1<true, false>(DEPTH, comb_en, NX, false);
        } else {
            const int l = (ph - 1) / PH_PER_LAYER, s = (ph - 1) % PH_PER_LAYER;
            const bool keep = l < DEPTH - 1;
            if (s == PH_N1) {
                if (l > 0) convert_from_cursor(l, -1);
                if (l == 0 && !probe16) rowpass_n1<false, true>(l, false, NT, false); else rowpass_n1<false, false>(l, comb_en && l > 0, NT, probe16);
            } else if (s == PH_GIN || s == PH_GOUT || s == PH_GUP || s == PH_GDN) {
                KArgs A = kargs(); unsigned char* const ws = A->ws;
                const LAS int* tab = (const LAS int*)(lds + LDSCTL_OFF);
                pg8::GCfg S; S.list = (const int*)(ws + WS_LIST); S.tab = tab; S.amode = 0; S.bmode = 0; S.bexp = 0; S.K = D; S.Abase = (const char*)(ws + WS_HB);
                S.O = nullptr; S.ldc = 0; S.xl = nullptr; S.xc = nullptr; S.MODl = nullptr; S.gidx = 0; S.gscale = (A->flags & 8) ? 0.f : 1.f;
                int nM, nN;
                if (s == PH_GIN) { nM = NT / 256; nN = PLD / 256; S.Bbase = (const char*)(ws + WS_WIN) + (size_t)l * PLD * D * 2; S.emode = 0; S.O = (bf16_t*)(ws + WS_P); S.ldc = PLD; }
                else if (s == PH_GOUT) { nM = (keep ? NT : NX) / 256; nN = D / 256; S.Bbase = (const char*)(ws + WS_WOUT) + (size_t)l * D * D * 2; S.emode = 1;
                    S.O = (bf16_t*)(ws + WS_XB); S.MODl = (const float*)(ws + WS_MOD) + (size_t)l * 9 * 6144; S.gidx = 2; }
                else {
                    { LAS int* t = (LAS int*)(lds + LDSCTL_OFF); const gu32* ec = (const gu32*)(ws + WS_CTL) + CW_ECNT + l * NE * 64;
                      if (threadIdx.x < NE) t[32 + threadIdx.x] = (int)__hip_atomic_load(ec + threadIdx.x * 64, RLX_AGENT);
                      __syncthreads();
                      if (threadIdx.x == 0) { int run = 0; for (int e = 0; e < NE; ++e) { t[e] = run; run += (t[32 + e] + 255) >> 8; } t[16] = run; }
                      __syncthreads(); }
                    nM = tab[16]; nN = 4; S.bmode = 1;
                    if (s == PH_GUP) { S.amode = 1; S.Bbase = (const char*)(ws + WS_W13) + (size_t)l * NE * 1024 * D * 2; S.bexp = (size_t)1024 * D * 2; S.emode = 2; S.O = (bf16_t*)(ws + WS_HID); S.ldc = DE; }
                    else { S.K = DE; S.Abase = (const char*)(ws + WS_HID); S.Bbase = (const char*)(ws + WS_W2) + (size_t)l * NE * D * DE * 2; S.bexp = (size_t)D * DE * 2; S.emode = 0; S.O = (bf16_t*)(ws + WS_P); S.ldc = D; }
                }
                S.T.init(nM, nN, gridDim.x, blockIdx.x);
                pg8::gemm_phase(lds, S);
                if (keep) {
                    const int nwg = nM * nN, G = (int)gridDim.x, c = (int)blockIdx.x;
                    const int rounds = (nwg + G - 1) / G, mine = c < nwg ? (nwg - c + G - 1) / G : 0;
                    if (mine < rounds) convert_from_cursor(l + 1, s == PH_GDN ? 2 : 3);
                }
            }
#ifdef HAVE_GLA
            else if (s == PH_G1) { gla_phase1(l); }
            else if (s == PH_G2) { gla_phase2(l); }
            else if (s == PH_G3) { gla_phase3(l); }
#endif
#ifdef HAVE_MOE
            else if (s == PH_R2) { router_phase(l, keep ? NT : NX); }
#endif
        }
        if (ph + 1 < hi) {
            xcd_barrier(bar);
#ifdef PROBE_BAR2
            xcd_barrier(bar);
#endif
        }
    }
}

static bool g_init_done = false;
static void launch_mega(const In& I, float* out, unsigned char* ws, int lo, int hi, int flags, hipStream_t st) {
    if (!g_init_done) { (void)hipFuncSetAttribute((const void*)mega_fwd, hipFuncAttributeMaxDynamicSharedMemorySize, LDS_BYTES); g_init_done = true; }
    Args a{}; a.in = I; a.out = out; a.ws = ws; a.ph_lo = lo; a.ph_hi = hi; a.flags = flags; a.pad = 0;
    hipLaunchKernelGGL(mega_fwd, dim3(256), dim3(NTHR), LDS_BYTES, st, a);
}

#ifndef FUSED
#ifndef OPT_PRO
#define OPT_PRO 1
#endif
#ifndef OPT_A
#define OPT_A 1
#endif
#ifndef OPT_B
#define OPT_B 0
#endif
#ifndef OPT_C
#define OPT_C 1
#endif
#ifndef OPT_D
#define OPT_D 0
#endif
static void run_hybrid(const In& I, float* out, unsigned char* ws, hipStream_t st) {
    float* xc = (float*)(ws + WS_XC); float* MOD = (float*)(ws + WS_MOD); bf16_t* HB = (bf16_t*)(ws + WS_HB); bf16_t* P = (bf16_t*)(ws + WS_P);
    float* OF = (float*)(ws + WS_KVS); float* OB = (float*)(ws + WS_HID); float* HIDN = (float*)(ws + WS_P);
    int* EIDX = (int*)(ws + WS_NEIDX); float* WTSN = (float*)(ws + WS_NWTS);
    (void)hipMemsetAsync(ws + WS_CTL, 0, CTL_BYTES, st);
    const int flags = OPT_D ? 1 : 0;
    if (OPT_PRO) launch_mega(I, out, ws, PH_PRO, PH_PRO + 1, flags, st);
    else nv::k_mod<<<(DEPTH * 6144 + 255) / 256, 256, 0, st>>>(I.c, I.c_ctx, I.w_mod, I.b_mod, MOD);
    if (!OPT_A) { (void)hipMemcpyAsync(out, I.x, (size_t)NX * D * 4, hipMemcpyDeviceToDevice, st); (void)hipMemcpyAsync(xc, I.ctx, (size_t)NC * D * 4, hipMemcpyDeviceToDevice, st); }
    for (int l = 0; l < DEPTH; ++l) {
        const bool keep = l < DEPTH - 1; const int Mo = keep ? NT : NX;
        const float* MODl = MOD + (size_t)l * 9 * 6144;
        const int pb = 1 + l * PH_PER_LAYER;
        if (OPT_A) { launch_mega(I, out, ws, pb + PH_N1, pb + PH_N1 + 1, flags, st); launch_mega(I, out, ws, pb + PH_GIN, pb + PH_GIN + 1, flags, st); }
        else {
            if (OPT_D && l > 0) launch_mega(I, out, ws, pb + PH_N1, pb + PH_N1 + 1, flags, st);
            nv::k_normmod<<<NT, 256, 0, st>>>(out, xc, I.norm1 + l * D, MODl, 0, 1, HB, NT);
            nv::k_gemm<<<dim3((INW + 63) / 64, NT / 64), 256, 0, st>>>(HB, D, I.w_in + (size_t)l * D * INW, INW, P, PLD, NT, INW, D, 0, nullptr, 0, nullptr, nullptr, 512, 768);
        }
        if (OPT_B) { for (int s = PH_G1; s <= PH_G3; ++s) launch_mega(I, out, ws, pb + s, pb + s + 1, flags, st); }
        else {
            nv::k_gla<<<NB * 4, 256, 0, st>>>(P, I.w_gk2 + (size_t)l * 2 * 16 * 256, I.b_gk + (size_t)l * 2 * 256, OF, OB);
            nv::k_pool<<<NT, 512, 0, st>>>(P, I.w_pool + (size_t)l * 4 * 128 * 128, I.pool_scale + l * 512, HB);
            nv::k_glaout<<<NT, 512, 0, st>>>(P, OF, OB, I.gla_gain + l * 128, HB);
        }
        if (OPT_C) launch_mega(I, out, ws, pb + PH_GOUT, pb + PH_GOUT + 1, flags, st);
        else nv::k_gemm<<<dim3(D / 64, Mo / 64), 256, 0, st>>>(HB, D, I.w_out + (size_t)l * D * D, D, nullptr, 0, Mo, D, D, 1, MODl, 2, out, xc, 0, 0);
        if (OPT_D) { for (int s = PH_R2; s <= PH_GDN; ++s) launch_mega(I, out, ws, pb + s, pb + s + 1, flags, st); }
        else {
            nv::k_normmod<<<Mo, 256, 0, st>>>(out, xc, I.norm2 + l * D, MODl, 3, 4, HB, Mo);
            nv::k_router<<<Mo, 64, 0, st>>>(out, xc, I.norm2 + l * D, MODl, I.w_router, I.router_bias, EIDX, WTSN, Mo);
            nv::k_moe_up<<<Mo * 2, 512, 0, st>>>(HB, EIDX, I.w1 + (size_t)l * NE * D * DE, I.w3 + (size_t)l * NE * D * DE, HIDN);
            nv::k_moe_down_combine<<<Mo, 256, 0, st>>>(HIDN, EIDX, WTSN, I.w2 + (size_t)l * NE * DE * D, MODl, out, xc);
        }
    }
    if (OPT_D) launch_mega(I, out, ws, PH_FINAL, PH_FINAL + 1, flags, st);
    else nv::k_final<<<NX, 256, 0, st>>>(out, I.norm_f);
}

#endif
extern "C" void kernel_launch(void* const* d_in, const int* in_sizes, int n_in, void* d_out, int out_size, void* d_ws, size_t ws_size, hipStream_t stream) {
    In I;
    const float** f = (const float**)&I;
    for (int i = 0; i < 21; ++i) f[i] = (const float*)d_in[i];
    if (ws_size < WS_END) { fprintf(stderr, "ws too small: %zu < %zu\n", ws_size, (size_t)WS_END); return; }
#ifdef FUSED
    (void)hipMemsetAsync((unsigned char*)d_ws + WS_CTL, 0, CTL_BYTES, stream);
    launch_mega(I, (float*)d_out, (unsigned char*)d_ws, 0, PH_END, 1, stream);
#ifndef PROBE_FLAGS
#define PROBE_FLAGS 0
#endif
#ifdef PROBE_KIND
    if (PROBE_KIND < 0) launch_mega(I, (float*)d_out, (unsigned char*)d_ws, PH_PRO, PH_PRO + 1, 0, stream);
    else for (int l = 0; l < DEPTH; ++l) launch_mega(I, (float*)d_out, (unsigned char*)d_ws, 1 + l * PH_PER_LAYER + PROBE_KIND, 1 + l * PH_PER_LAYER + PROBE_KIND + 1, PROBE_FLAGS, stream);
#endif
#else
    run_hybrid(I, (float*)d_out, (unsigned char*)d_ws, stream);
#endif
}
```

```cpp
#define FUSED 1
#include <hip/hip_runtime.h>
#include <cstdio>
#include <cstdint>
typedef unsigned short bf16_t;
constexpr int D = 1024, NB = 8, SEQ = 2048, DEPTH = 4, CTXL = 256;
constexpr int NX = NB * SEQ, NC = NB * CTXL, NT = NX + NC;
constexpr int INW = 2080, PLD = 2304, NE = 16, DE = 512;
constexpr int NCH = 36;
constexpr int MAXSLOT = 41216;
constexpr size_t MiB = 1u << 20;
constexpr size_t WS_CTL = 0, CTL_BYTES = 1 * MiB;
constexpr size_t WS_MOD = 1 * MiB;
constexpr size_t WS_WPOOL = 2 * MiB;
constexpr size_t WS_WGP = 2 * MiB + 512 * 1024;
constexpr size_t WS_WRP = 2 * MiB + 640 * 1024;
constexpr size_t WS_TOK = 3 * MiB;
constexpr size_t WS_WTS = 3 * MiB + 256 * 1024;
constexpr size_t WS_NEIDX = 3 * MiB + 512 * 1024;
constexpr size_t WS_NWTS = 3 * MiB + 768 * 1024;
constexpr size_t WS_LIST = 4 * MiB;
constexpr size_t WS_WIN = 6 * MiB;
constexpr size_t WS_WOUT = 24 * MiB;
constexpr size_t WS_W13 = 32 * MiB;
constexpr size_t WS_W2 = 160 * MiB;
constexpr size_t WS_XC = 224 * MiB;
constexpr size_t WS_HB = 232 * MiB;
constexpr size_t WS_P = 268 * MiB;
constexpr size_t WS_KVS = 349 * MiB;
constexpr size_t WS_ADEC = 385 * MiB;
constexpr size_t WS_HID = 386 * MiB;
constexpr size_t WS_XB = 427 * MiB;
constexpr size_t WS_END = 463 * MiB;

struct In {
    const float *x, *c, *ctx, *c_ctx, *w_mod, *b_mod, *norm1, *norm2, *w_in, *w_gk2, *b_gk, *w_pool, *pool_scale, *gla_gain, *w_out, *w_router, *router_bias, *w1, *w3, *w2, *norm_f;
};

__host__ __device__ __forceinline__ unsigned f2bf(float f) { unsigned u = __builtin_bit_cast(unsigned, f); return (u + 0x7fffu + ((u >> 16) & 1u)) >> 16; }
__host__ __device__ __forceinline__ float bf2f(bf16_t h) { return __builtin_bit_cast(float, (unsigned)h << 16); }
typedef float pk2_f32x2 __attribute__((ext_vector_type(2)));
typedef __bf16 pk2_bf16x2 __attribute__((ext_vector_type(2)));
__device__ __forceinline__ unsigned pk2(float lo, float hi) { const pk2_f32x2 v = {lo, hi}; return __builtin_bit_cast(unsigned, __builtin_convertvector(v, pk2_bf16x2)); }
__device__ __forceinline__ float silu_f(float x) { return x / (1.f + expf(-x)); }
__device__ __forceinline__ float sigmoid_f(float x) { return 1.f / (1.f + expf(-x)); }
__device__ __forceinline__ float logsigmoid_f(float x) { return fminf(x, 0.f) - log1pf(expf(-fabsf(x))); }
__device__ __forceinline__ int variant_of_row(int row) { return row < NX ? (row >> 11) : 8; }
__device__ __forceinline__ float* resid_row(float* xl, float* xc, int row) { return row < NX ? xl + (size_t)row * D : xc + (size_t)(row - NX) * D; }
__device__ __forceinline__ int chunk_row0(int b, int j) { return j < 4 ? NX + b * CTXL + j * 64 : b * SEQ + (j - 4) * 64; }
#define GAS __attribute__((address_space(1)))
#define LAS __attribute__((address_space(3)))
typedef unsigned v4u __attribute__((ext_vector_type(4)));
typedef unsigned v2u __attribute__((ext_vector_type(2)));
typedef float f32x4 __attribute__((ext_vector_type(4)));
typedef float f32x16 __attribute__((ext_vector_type(16)));
typedef short bf16x8 __attribute__((ext_vector_type(8)));
typedef GAS unsigned gu32;
#define RLX_AGENT __ATOMIC_RELAXED, __HIP_MEMORY_SCOPE_AGENT
#define LDS_WAIT() asm volatile("s_waitcnt lgkmcnt(0)" ::: "memory")
#define VM_WAIT() asm volatile("s_waitcnt vmcnt(0)" ::: "memory")
constexpr int NWAVES = 8, NTHR = 512;
constexpr int RING_BYTES = 131072;
constexpr int LDSCTL_OFF = RING_BYTES, MISC_OFF = LDSCTL_OFF + 320;
constexpr int LDS_BYTES = 147456;
constexpr int CW_BAR = 4096;
constexpr int CW_ECNT = 8192;
constexpr int CW_CVT = 16384;

__device__ __forceinline__ float wave_sum(float v) {
    v += __builtin_bit_cast(float, __builtin_amdgcn_update_dpp(0, __builtin_bit_cast(int, v), 0xB1, 0xF, 0xF, true));
    v += __builtin_bit_cast(float, __builtin_amdgcn_update_dpp(0, __builtin_bit_cast(int, v), 0x4E, 0xF, 0xF, true));
    v += __builtin_bit_cast(float, __builtin_amdgcn_update_dpp(0, __builtin_bit_cast(int, v), 0x141, 0xF, 0xF, true));
    v += __builtin_bit_cast(float, __builtin_amdgcn_update_dpp(0, __builtin_bit_cast(int, v), 0x140, 0xF, 0xF, true));
    const int iv = __builtin_bit_cast(int, v);
    const float r0 = __builtin_bit_cast(float, __builtin_amdgcn_readlane(iv, 0)), r1 = __builtin_bit_cast(float, __builtin_amdgcn_readlane(iv, 16));
    const float r2 = __builtin_bit_cast(float, __builtin_amdgcn_readlane(iv, 32)), r3 = __builtin_bit_cast(float, __builtin_amdgcn_readlane(iv, 48));
    return (r0 + r1) + (r2 + r3);
}

#define XB_TMO      128
#define XB_XCNT(j)  (256  + 64 * (j))
#define XB_XSUB(j)  (1280 + 64 * (j))
#define XB_XGEN(j)  (2304 + 64 * (j))
#define XB_TOP      3328
#define XB_TOPGEN   3392
#define XCD_BAR_WORDS 3456
#define XB_SPIN_CAP (1u << 18)
__device__ __forceinline__ unsigned xb_ld(unsigned* p)              { return __hip_atomic_load(p, __ATOMIC_RELAXED, __HIP_MEMORY_SCOPE_AGENT); }
__device__ __forceinline__ unsigned xb_add(unsigned* p, unsigned v) { return __hip_atomic_fetch_add(p, v, __ATOMIC_RELAXED, __HIP_MEMORY_SCOPE_AGENT); }
__device__ __forceinline__ unsigned xb_xcc_id() { return (unsigned)__builtin_amdgcn_s_getreg((3 << 11) | 20) & 0xFu; }
#define XB_SPIN(cond, bar) do { unsigned _sp = 0; while (cond) { __builtin_amdgcn_s_sleep(1); \
    if ((++_sp & 255u) == 0u) { if (xb_ld(&(bar)[XB_TMO])) break; if (_sp > XB_SPIN_CAP) { atomicAdd(&(bar)[XB_TMO], 1u); break; } } } } while (0)
struct XcdBarrier { unsigned* bar; unsigned x; volatile LAS unsigned* st; };
__device__ __forceinline__ XcdBarrier xcd_barrier_post(unsigned* bar, volatile LAS unsigned* st) {
    XcdBarrier b; b.bar = bar; b.x = xb_xcc_id(); b.st = st;
    if (threadIdx.x == 0) (void)xb_add(&bar[XB_XCNT(b.x)], 1u);
    return b;
}
__device__ __forceinline__ void xcd_barrier(const XcdBarrier& b) {
    asm volatile("s_waitcnt vmcnt(0)" ::: "memory");
    __syncthreads();
    if (threadIdx.x < 64 && b.st[0] == 0u) {
        unsigned* bar = b.bar; const unsigned G = gridDim.x * gridDim.y * gridDim.z; const int lane = threadIdx.x; unsigned sp = 0u, c, sum, cnt;
        for (;;) {
            c = lane < 16 ? xb_ld(&bar[XB_XCNT(lane)]) : 0u; sum = c; cnt = c > 0u ? 1u : 0u;
#pragma unroll
            for (int o = 1; o < 16; o <<= 1) { sum += __shfl_xor(sum, o); cnt += __shfl_xor(cnt, o); }
            sum = __builtin_amdgcn_readfirstlane(sum); cnt = __builtin_amdgcn_readfirstlane(cnt);
            if (sum == G) break;
            __builtin_amdgcn_s_sleep(1);
            if ((++sp & 255u) == 0u) { if (__builtin_amdgcn_readfirstlane(xb_ld(&bar[XB_TMO]))) break; if (sp > XB_SPIN_CAP) { if (lane == 0) atomicAdd(&bar[XB_TMO], 1u); break; } }
        }
        const unsigned mine = __builtin_amdgcn_readlane(c, b.x);
        if (lane == 0) { b.st[0] = mine > 0u ? mine : 1u; b.st[1] = cnt > 0u ? cnt : 1u; }
        asm volatile("s_waitcnt lgkmcnt(0)" ::: "memory");
    }
    if (threadIdx.x == 0) {
        unsigned* bar = b.bar;
        __builtin_amdgcn_s_waitcnt(0);
        const unsigned nloc = b.st[0], nx = b.st[1];
        const unsigned old = xb_add(&bar[XB_XSUB(b.x)], 1u);
        const unsigned gen = old / nloc;
        if (old + 1u == (gen + 1u) * nloc) {
            __builtin_amdgcn_fence(__ATOMIC_RELEASE, "agent");
            asm volatile("s_waitcnt vmcnt(0)" ::: "memory");
            const unsigned og = xb_add(&bar[XB_TOP], 1u);
            const unsigned tg = og / nx;
            if (og + 1u == (tg + 1u) * nx) xb_add(&bar[XB_TOPGEN], 1u);
            else XB_SPIN(xb_ld(&bar[XB_TOPGEN]) == tg, bar);
            __builtin_amdgcn_fence(__ATOMIC_ACQUIRE, "agent");
            xb_add(&bar[XB_XGEN(b.x)], 1u);
            asm volatile("s_waitcnt vmcnt(0)" ::: "memory");
        } else {
            XB_SPIN(xb_ld(&bar[XB_XGEN(b.x)]) == gen, bar);
            __builtin_amdgcn_fence(__ATOMIC_ACQUIRE, "agent");
            asm volatile("s_waitcnt vmcnt(0)" ::: "memory");
        }
    }
    __syncthreads();
}

namespace pg8 {
constexpr int BM = 256, BK = 64, HALF = 128, HTB = HALF * BK * 2, STAGE_BYTES = 8 * HTB, NXCD = 8, WGM = 8;
__host__ __device__ __forceinline__ int lds_byte(int r, int c) { const int st = (r >> 4) * 2 + (c >> 5), rr = r & 15, cc = c & 31, ob = rr * 64 + cc * 2; return st * 1024 + (ob ^ (((ob >> 9) & 1) << 5)); }
__host__ __device__ __forceinline__ void stage_rc(int b, int& R, int& C) { const int st = b / 1024, sb = b % 1024, swz = sb ^ (((sb >> 9) & 1) << 5); R = (st >> 1) * 16 + swz / 64; C = (st & 1) * 32 + (swz % 64) / 2; }
__host__ __device__ __forceinline__ int perm32(int rho) { const int n = rho >> 4, i = rho & 15; return 8 * (i >> 2) + 4 * n + (i & 3); }

struct Unit { int pm, pn, e, ti; };

struct TileOrder {
    int nM, nN, nwg, G, c;
    __device__ void init(int nM_, int nN_, int G_, int c_) { nM = nM_; nN = nN_; nwg = nM * nN; G = G_; c = c_; }
    __device__ bool tile(int i, int& pm, int& pn) const {
        const long L = (long)i * G + c; if (L >= nwg) return false;
        int wgid = (int)L; { const int q = nwg / NXCD, r = nwg % NXCD, xcd = wgid % NXCD, off = wgid / NXCD; wgid = (xcd < r ? xcd * (q + 1) : r * (q + 1) + (xcd - r) * q) + off; }
        const int nig = WGM * nN, gid = wgid / nig, fm = gid * WGM, gsz = (nM - fm) < WGM ? (nM - fm) : WGM;
        pm = fm + ((wgid % nig) % gsz); pn = (wgid % nig) / gsz; return true;
    }
};
struct GCfg {
    TileOrder T; const char* Abase; const char* Bbase; int K; int amode, bmode; size_t bexp; const int* list; const LAS int* tab;
    int emode;
    bf16_t* O; int ldc;
    float* xl; float* xc; const float* MODl; int gidx; float gscale;
    __device__ __forceinline__ void units_of_lane(int i, int& upk, int& epk) const {
        Unit u; u.e = 0; u.ti = 0; const bool ok = (i < 8) && T.tile(i, u.pm, u.pn);
        if (ok && bmode) { int e = 0;
#pragma unroll
            for (int j = 1; j < 16; ++j) e += (u.pm >= tab[j]) ? 1 : 0;
            u.e = e; u.ti = u.pm - tab[e]; }
        upk = ok ? (u.pm | (u.pn << 16)) : -1; epk = u.e | (u.ti << 16); }
    __device__ __forceinline__ bool next(int i, Unit& u, int upk_v, int epk_v) const {
        const int a = __builtin_amdgcn_readlane(upk_v, i), b = __builtin_amdgcn_readlane(epk_v, i);
        u.pm = a & 0xffff; u.pn = (a >> 16) & 0xffff; u.e = b & 0xffff; u.ti = (b >> 16) & 0xffff;
        return a >= 0; }
    __device__ __forceinline__ const char* b_base(const Unit& u) const { return Bbase + (size_t)u.e * bexp + (size_t)u.pn * BM * K * 2; }
    __device__ __forceinline__ void a_rows_to_lds(const Unit& u, int R0, int R1, LAS unsigned* slot, int lane) const {
        if (amode) { const int cnt = tab[32 + u.e]; const int* lp = list + u.e * NT; const int base = u.ti * BM;
            int p00 = base + R0, p01 = base + R1, p10 = base + HALF + R0, p11 = base + HALF + R1;
            p00 = p00 < cnt ? p00 : cnt - 1; p01 = p01 < cnt ? p01 : cnt - 1; p10 = p10 < cnt ? p10 : cnt - 1; p11 = p11 < cnt ? p11 : cnt - 1;
            __builtin_amdgcn_global_load_lds((const unsigned*)(lp + p00), slot, 4, 0, 0); __builtin_amdgcn_global_load_lds((const unsigned*)(lp + p01), slot + 64, 4, 0, 0);
            __builtin_amdgcn_global_load_lds((const unsigned*)(lp + p10), slot + 128, 4, 0, 0); __builtin_amdgcn_global_load_lds((const unsigned*)(lp + p11), slot + 192, 4, 0, 0);
        } else { const unsigned r = (unsigned)(u.pm * BM); slot[lane] = r + R0; slot[64 + lane] = r + R1; slot[128 + lane] = r + HALF + R0; slot[192 + lane] = r + HALF + R1; }
    }
    __device__ __forceinline__ unsigned a_off(const Unit& u, int h, int R, int C) const {
        if (amode) { const int cnt = tab[32 + u.e]; int pos = u.ti * BM + h * HALF + R; pos = pos < cnt ? pos : cnt - 1; const int src = list[u.e * NT + pos]; return (unsigned)((src * K + C) * 2); }
        return (unsigned)(((u.pm * BM + h * HALF + R) * K + C) * 2); }
    __device__ __forceinline__ bool perm() const { return emode != 2; }
    __device__ __forceinline__ void epi(const f32x4 (&acc)[2][2][4][2], const Unit& u, int wr, int wc, int fr, int fq) const {
        if (emode == 0) {
            const int row0 = u.pm * BM + wr * 64 + fr; const int col0 = u.pn * BM + wc * 32 + 8 * fq;
#pragma unroll
            for (int ai = 0; ai < 2; ++ai)
#pragma unroll
                for (int m = 0; m < 4; ++m) { bf16_t* rowp = O + (size_t)(row0 + ai * HALF + m * 16) * ldc + col0;
#pragma unroll
                    for (int bj = 0; bj < 2; ++bj) { const f32x4 v0 = acc[ai][bj][m][0], v1 = acc[ai][bj][m][1];
                        v4u w; w.x = pk2(v0[0], v0[1]); w.y = pk2(v0[2], v0[3]); w.z = pk2(v1[0], v1[1]); w.w = pk2(v1[2], v1[3]);
                        *(v4u*)(rowp + bj * HALF) = w; } }
        } else if (emode == 1) {
            const int rowt = u.pm * BM; const int v = rowt < NX ? (rowt >> 11) : 8;
            const float* gate = MODl + (size_t)v * 6144 + gidx * D; const float gsc = gscale;
            const int row0 = rowt + wr * 64 + fr; const int col0 = u.pn * BM + wc * 32 + 8 * fq;
            f32x4 gv[2][2];
#pragma unroll
            for (int bj = 0; bj < 2; ++bj)
#pragma unroll
                for (int n = 0; n < 2; ++n) gv[bj][n] = *(const f32x4*)(gate + col0 + bj * HALF + 4 * n) * gsc;
#pragma unroll
            for (int ai = 0; ai < 2; ++ai) {
                v4u xw[4][2];
#pragma unroll
                for (int m = 0; m < 4; ++m)
#pragma unroll
                    for (int bj = 0; bj < 2; ++bj) xw[m][bj] = *(const v4u*)(O + (size_t)(row0 + ai * HALF + m * 16) * D + col0 + bj * HALF);
#pragma unroll
                for (int m = 0; m < 4; ++m) { bf16_t* rowp = O + (size_t)(row0 + ai * HALF + m * 16) * D + col0;
#pragma unroll
                    for (int bj = 0; bj < 2; ++bj) { v4u* p = (v4u*)(rowp + bj * HALF); const v4u w = xw[m][bj];
                        const f32x4 x0 = {__builtin_bit_cast(float, w.x << 16), __builtin_bit_cast(float, w.x & 0xffff0000u), __builtin_bit_cast(float, w.y << 16), __builtin_bit_cast(float, w.y & 0xffff0000u)};
                        const f32x4 x1 = {__builtin_bit_cast(float, w.z << 16), __builtin_bit_cast(float, w.z & 0xffff0000u), __builtin_bit_cast(float, w.w << 16), __builtin_bit_cast(float, w.w & 0xffff0000u)};
                        const f32x4 y0 = x0 + gv[bj][0] * acc[ai][bj][m][0], y1 = x1 + gv[bj][1] * acc[ai][bj][m][1];
                        v4u o; o.x = pk2(y0[0], y0[1]); o.y = pk2(y0[2], y0[3]); o.z = pk2(y1[0], y1[1]); o.w = pk2(y1[2], y1[3]); *p = o; } }
            }
        } else {
            const int row0 = u.pm * BM + wr * 64 + fr; const int j0 = u.pn * 128 + wc * 32 + 8 * fq;
#pragma unroll
            for (int ai = 0; ai < 2; ++ai)
#pragma unroll
                for (int m = 0; m < 4; ++m) { float hv[8];
#pragma unroll
                    for (int bj = 0; bj < 2; ++bj)
#pragma unroll
                        for (int i = 0; i < 4; ++i) { const float a = acc[ai][bj][m][0][i], b = acc[ai][bj][m][1][i]; hv[bj * 4 + i] = a * b * __builtin_amdgcn_rcpf(1.f + __expf(-a)); }
                    v4u w; w.x = pk2(hv[0], hv[1]); w.y = pk2(hv[2], hv[3]); w.z = pk2(hv[4], hv[5]); w.w = pk2(hv[6], hv[7]);
                    *(v4u*)(O + (size_t)(row0 + ai * HALF + m * 16) * DE + j0) = w; }
        }
    }
};

__device__ __forceinline__ void gemm_phase(LAS unsigned char* lds, const GCfg& S) {
    const char* const Abase = S.Abase; const int K = S.K; const bool PERMB = S.perm();
    int tid_ = threadIdx.x; asm volatile("" : "+v"(tid_));
    const int tid = tid_, wid = __builtin_amdgcn_readfirstlane(tid >> 6), lane = tid & 63, wr = wid >> 2, wc = wid & 3, fr = lane & 15, fq = lane >> 4;
    const int nt = K / BK;
    int sR[2], sC[2]; unsigned voffB[2];
#pragma unroll
    for (int i = 0; i < 2; ++i) { stage_rc(tid * 16 + i * 8192, sR[i], sC[i]); const int Rb = PERMB ? ((sR[i] & ~31) + perm32(sR[i] & 31)) : sR[i]; voffB[i] = (unsigned)(Rb * K + sC[i]) * 2u; }
    const unsigned kstep = (unsigned)(BK * 2);
    const size_t hstepB = (size_t)HALF * K * 2;
    const unsigned ldsw = (unsigned)wid * 1024u;
    const int aoff = lds_byte(wr * 64 + fr, fq * 8), boff = lds_byte(wc * 32 + fr, fq * 8);
#define PG8_SA(b, h) (((b) * 2 + (h)) * HTB)
#define PG8_SB(b, h) ((4 + (b) * 2 + (h)) * HTB)
#define PG8_STAGE_B(bufoff, gbase) do { _Pragma("unroll") for (int _i = 0; _i < 2; ++_i) \
        __builtin_amdgcn_global_load_lds((const unsigned*)((const char*)(gbase) + voffB[_i]), (LAS unsigned*)(lds + (bufoff) + ldsw + _i * 8192), 16, 0, 0); } while (0)
#define PG8_STAGE_A(bufoff, o0, o1, kb) do { \
        __builtin_amdgcn_global_load_lds((const unsigned*)(Abase + (size_t)((o0) + (kb))), (LAS unsigned*)(lds + (bufoff) + ldsw), 16, 0, 0); \
        __builtin_amdgcn_global_load_lds((const unsigned*)(Abase + (size_t)((o1) + (kb))), (LAS unsigned*)(lds + (bufoff) + ldsw + 8192), 16, 0, 0); } while (0)
#define PG8_LDA(dst, b, h) do { _Pragma("unroll") for (int m = 0; m < 4; ++m) _Pragma("unroll") for (int k = 0; k < 2; ++k) dst[m][k] = *(const LAS bf16x8*)(lds + PG8_SA(b, h) + aoff + m * 2048 + k * 1024); } while (0)
#define PG8_LDB(dst, b, h) do { _Pragma("unroll") for (int n = 0; n < 2; ++n) _Pragma("unroll") for (int k = 0; k < 2; ++k) dst[n][k] = *(const LAS bf16x8*)(lds + PG8_SB(b, h) + boff + n * 2048 + k * 1024); } while (0)
#define PG8_MMA(ai, bj, At, Bt) do { __builtin_amdgcn_s_setprio(1); _Pragma("unroll") for (int m = 0; m < 4; ++m) _Pragma("unroll") for (int n = 0; n < 2; ++n) _Pragma("unroll") for (int k = 0; k < 2; ++k) \
        acc[ai][bj][m][n] = __builtin_amdgcn_mfma_f32_16x16x32_bf16(Bt[n][k], At[m][k], acc[ai][bj][m][n], 0, 0, 0); __builtin_amdgcn_s_setprio(0); } while (0)
#define PG8_WAIT_V(n) asm volatile("s_waitcnt vmcnt(" #n ")" ::: "memory")
#define PG8_WAIT_L(n) asm volatile("s_waitcnt lgkmcnt(" #n ")" ::: "memory")
#define PG8_BAR __builtin_amdgcn_s_barrier()
#define PG8_SCHED __builtin_amdgcn_sched_barrier(0)
    int upk_v, epk_v; S.units_of_lane(lane, upk_v, epk_v);
    Unit cur, nxt; int ui = 0;
    if (!S.next(0, cur, upk_v, epk_v)) return;
    f32x4 acc[2][2][4][2];
#pragma unroll
    for (int a = 0; a < 2; ++a)
#pragma unroll
        for (int b = 0; b < 2; ++b)
#pragma unroll
            for (int m = 0; m < 4; ++m)
#pragma unroll
                for (int n = 0; n < 2; ++n) acc[a][b][m][n] = (f32x4){0.f, 0.f, 0.f, 0.f};
    bf16x8 At[4][2], B0[2][2], B1[2][2];
    unsigned c00 = S.a_off(cur, 0, sR[0], sC[0]), c01 = S.a_off(cur, 0, sR[1], sC[1]), c10 = S.a_off(cur, 1, sR[0], sC[0]), c11 = S.a_off(cur, 1, sR[1], sC[1]);
    const char* cB = S.b_base(cur);
    PG8_STAGE_B(PG8_SB(0, 0), cB); PG8_STAGE_B(PG8_SB(0, 1), cB + hstepB); PG8_STAGE_A(PG8_SA(0, 0), c00, c01, 0u); PG8_STAGE_A(PG8_SA(0, 1), c10, c11, 0u);
    if (wr == 1) PG8_BAR;
    PG8_WAIT_V(2); PG8_BAR;
    PG8_STAGE_B(PG8_SB(1, 0), cB + kstep); PG8_STAGE_A(PG8_SA(1, 0), c00, c01, kstep); PG8_STAGE_B(PG8_SB(1, 1), cB + hstepB + kstep);
    PG8_WAIT_V(6); PG8_BAR;
    LAS unsigned* const nslot = (LAS unsigned*)(lds + LDSCTL_OFF + 1024) + wid * 256;
    for (;;) {
        const bool has_next = S.next(ui + 1, nxt, upk_v, epk_v);
        const char* nB = cB;
        if (has_next) {
            int t2 = tid; asm volatile("" : "+v"(t2)); int r0_, c0_, r1_, c1_; stage_rc(t2 * 16, r0_, c0_); stage_rc(t2 * 16 + 8192, r1_, c1_);
            S.a_rows_to_lds(nxt, r0_, r1_, nslot, lane); nB = S.b_base(nxt); }
        for (int t = 0; t < nt; t += 2) {
            const bool last = (t == nt - 2);
            const unsigned k1 = (unsigned)(t + 1) * kstep;
            const unsigned k2 = last ? 0u : (unsigned)(t + 2) * kstep, k3 = k2 + kstep;
            unsigned s00 = c00, s01 = c01, s10 = c10, s11 = c11;
            if (last && has_next) { int t3 = tid; asm volatile("" : "+v"(t3)); int r0_, c0_, r1_, c1_; stage_rc(t3 * 16, r0_, c0_); stage_rc(t3 * 16 + 8192, r1_, c1_);
                s00 = (nslot[lane] * (unsigned)K + c0_) * 2u; s01 = (nslot[64 + lane] * (unsigned)K + c1_) * 2u; s10 = (nslot[128 + lane] * (unsigned)K + c0_) * 2u; s11 = (nslot[192 + lane] * (unsigned)K + c1_) * 2u; }
            const char* b2 = last ? nB : cB + (size_t)(t + 2) * kstep; const char* b3 = b2 + kstep;
            const bool relax = (t == 0 && ui > 0);
            PG8_LDB(B0, 0, 0); PG8_LDB(B1, 0, 1); PG8_SCHED; PG8_LDA(At, 0, 0); PG8_STAGE_A(PG8_SA(1, 1), c10, c11, k1);
            if (relax) { if (S.emode == 2) PG8_WAIT_V(16); else PG8_WAIT_V(24); } else PG8_WAIT_V(8);
            PG8_WAIT_L(0); PG8_BAR; PG8_MMA(0, 0, At, B0); PG8_MMA(0, 1, At, B1); PG8_BAR; PG8_SCHED;
            PG8_LDA(At, 0, 1); PG8_STAGE_B(PG8_SB(0, 0), b2); PG8_STAGE_B(PG8_SB(0, 1), b2 + hstepB); PG8_STAGE_A(PG8_SA(0, 0), s00, s01, k2);
            if (relax) { if (S.emode == 2) PG8_WAIT_V(16); else PG8_WAIT_V(24); } else PG8_WAIT_V(8);
            PG8_WAIT_L(0); PG8_BAR; PG8_MMA(1, 0, At, B0); PG8_MMA(1, 1, At, B1); PG8_BAR; PG8_SCHED;
            PG8_LDB(B0, 1, 0); PG8_LDB(B1, 1, 1); PG8_SCHED; PG8_LDA(At, 1, 0); PG8_STAGE_A(PG8_SA(0, 1), s10, s11, k2);
            PG8_WAIT_V(8); PG8_WAIT_L(0); PG8_BAR; PG8_MMA(0, 0, At, B0); PG8_MMA(0, 1, At, B1); PG8_BAR; PG8_SCHED;
            PG8_LDA(At, 1, 1); PG8_STAGE_B(PG8_SB(1, 0), b3); PG8_STAGE_B(PG8_SB(1, 1), b3 + hstepB); PG8_STAGE_A(PG8_SA(1, 0), s00, s01, k3);
            PG8_WAIT_V(8); PG8_WAIT_L(0); PG8_BAR; PG8_MMA(1, 0, At, B0); PG8_MMA(1, 1, At, B1); PG8_BAR; PG8_SCHED;
        }
        if (wr == 0) PG8_BAR;
        S.epi(acc, cur, wr, wc, fr, fq);
        if (!has_next) break;
#pragma unroll
        for (int a = 0; a < 2; ++a)
#pragma unroll
            for (int b = 0; b < 2; ++b)
#pragma unroll
                for (int m = 0; m < 4; ++m)
#pragma unroll
                    for (int n = 0; n < 2; ++n) acc[a][b][m][n] = (f32x4){0.f, 0.f, 0.f, 0.f};
        { int t4 = tid; asm volatile("" : "+v"(t4)); int r0_, c0_, r1_, c1_; stage_rc(t4 * 16, r0_, c0_); stage_rc(t4 * 16 + 8192, r1_, c1_);
          c00 = (nslot[lane] * (unsigned)K + c0_) * 2u; c01 = (nslot[64 + lane] * (unsigned)K + c1_) * 2u; c10 = (nslot[128 + lane] * (unsigned)K + c0_) * 2u; c11 = (nslot[192 + lane] * (unsigned)K + c1_) * 2u; }
        cur = nxt; cB = nB; ++ui;
        if (wr == 1) PG8_BAR;
    }
    PG8_WAIT_V(0);
    PG8_BAR;
#undef PG8_SA
#undef PG8_SB
#undef PG8_STAGE_A
#undef PG8_STAGE_B
#undef PG8_LDA
#undef PG8_LDB
#undef PG8_MMA
#undef PG8_WAIT_V
#undef PG8_WAIT_L
#undef PG8_BAR
#undef PG8_SCHED
}
}
struct Args { In in; float* out; unsigned char* ws; int ph_lo, ph_hi, flags, pad; };
typedef const __attribute__((address_space(4))) Args* KArgs;
__device__ __forceinline__ KArgs kargs() { KArgs a = (KArgs)__builtin_amdgcn_kernarg_segment_ptr(); asm volatile("" : "+s"(a)); return a; }
struct Ctx {
    LAS unsigned char* lds; int tid, lane, wave, G, bid;
};
extern __shared__ __attribute__((aligned(16))) unsigned char lds_raw[];
__device__ __forceinline__ Ctx mkctx() { Ctx F; int t = threadIdx.x; asm volatile("" : "+v"(t)); F.lds = (LAS unsigned char*)lds_raw; F.tid = t; F.lane = t & 63; F.wave = __builtin_amdgcn_readfirstlane(t >> 6); F.G = gridDim.x; F.bid = blockIdx.x; return F; }

struct MapIdent { float qs; int qlo, qhi; __device__ __forceinline__ int row(int n) const { return n; } __device__ __forceinline__ float scale(int n) const { return (n >= qlo && n < qhi) ? qs : 1.f; } };
struct MapW13 { int sel; __device__ __forceinline__ int row(int j) const { return 256 * (j >> 7) + 128 * ((j >> 2) & 1) + 32 * ((j >> 5) & 3) + 16 * sel + 4 * ((j >> 3) & 3) + (j & 3); } __device__ __forceinline__ float scale(int) const { return 1.f; } };
template <bool DEEP, class Map>
__device__ __forceinline__ void transpose_item(const float* W, int ldn, int k0, int n0, bf16_t* WT, int ldk, LAS float* scr, int lane, const Map& map) {
    if (DEEP) {
        float ld[32];
#pragma unroll
        for (int i = 0; i < 32; ++i) ld[i] = W[(size_t)(k0 + 2 * i + (lane >> 5)) * ldn + n0 + (lane & 31)];
#pragma unroll
        for (int i = 0; i < 32; ++i) scr[(2 * i + (lane >> 5)) * 33 + (lane & 31)] = ld[i];
    } else {
#pragma unroll 8
        for (int i = 0; i < 32; ++i) { const int kk = 2 * i + (lane >> 5); scr[kk * 33 + (lane & 31)] = W[(size_t)(k0 + kk) * ldn + n0 + (lane & 31)]; }
    }
    LDS_WAIT(); asm volatile("" ::: "memory");
    const int c = lane & 7;
#pragma unroll
    for (int j = 0; j < 4; ++j) { const int n = (lane >> 3) + 8 * j; const LAS float* s = scr + (8 * c) * 33 + n; const float sc = map.scale(n0 + n);
        v4u o; o.x = pk2(s[0 * 33] * sc, s[1 * 33] * sc); o.y = pk2(s[2 * 33] * sc, s[3 * 33] * sc); o.z = pk2(s[4 * 33] * sc, s[5 * 33] * sc); o.w = pk2(s[6 * 33] * sc, s[7 * 33] * sc);
        *(GAS v4u*)(WT + (size_t)map.row(n0 + n) * ldk + k0 + 8 * c) = o; }
    LDS_WAIT(); asm volatile("" ::: "memory");
}

template <bool DEEP>
__device__ __forceinline__ void convert_layer_items(const Ctx& F, KArgs A, int l, int widx, int nw) {
    unsigned char* const ws = A->ws;
    LAS float* scr = (LAS float*)(F.lds + F.wave * 16384);
    bf16_t* WIN = (bf16_t*)(ws + WS_WIN) + (size_t)l * PLD * D; bf16_t* WOUT = (bf16_t*)(ws + WS_WOUT) + (size_t)l * D * D;
    bf16_t* W13 = (bf16_t*)(ws + WS_W13) + (size_t)l * NE * 1024 * D; bf16_t* W2 = (bf16_t*)(ws + WS_W2) + (size_t)l * NE * D * DE; bf16_t* WPL = (bf16_t*)(ws + WS_WPOOL) + (size_t)l * 4 * 128 * 128;
    constexpr int I_IN = 16 * 65, I_OUT = 16 * 32, I_W1 = NE * 256, I_W2 = NE * 256, I_PL = 4 * 8, I_Z = 224;
    constexpr int NITEMS = I_IN + I_OUT + 2 * I_W1 + I_W2 + I_PL + I_Z;
    for (int it = widx; it < NITEMS; it += nw) {
        int r = it;
        if (r < I_IN) { const int kb = r / 65, nb = r % 65;
            transpose_item<DEEP>(A->in.w_in + (size_t)l * D * INW, INW, kb * 64, nb * 32, WIN, D, scr, F.lane, MapIdent{0.125f, 512, 768}); continue; } r -= I_IN;
        if (r < I_OUT) { const int kb = r / 32, nb = r % 32;
            transpose_item<DEEP>(A->in.w_out + (size_t)l * D * D, D, kb * 64, nb * 32, WOUT, D, scr, F.lane, MapIdent{1.f, 0, 0}); continue; } r -= I_OUT;
        if (r < 2 * I_W1) { const int sel = r >= I_W1; if (sel) r -= I_W1; const int e = r / 256, q = r % 256, kb = q / 16, nb = q % 16;
            transpose_item<DEEP>((sel ? A->in.w3 : A->in.w1) + ((size_t)l * NE + e) * D * DE, DE, kb * 64, nb * 32, W13 + (size_t)e * 1024 * D, D, scr, F.lane, MapW13{sel}); continue; } r -= 2 * I_W1;
        if (r < I_W2) { const int e = r / 256, q = r % 256, kb = q / 32, nb = q % 32;
            transpose_item<DEEP>(A->in.w2 + ((size_t)l * NE + e) * DE * D, D, kb * 64, nb * 32, W2 + (size_t)e * D * DE, DE, scr, F.lane, MapIdent{1.f, 0, 0}); continue; } r -= I_W2;
        if (r < I_PL) { const int g = r / 8, q = r % 8, kb = q / 4, nb = q % 4;
            transpose_item<DEEP>(A->in.w_pool + ((size_t)l * 4 + g) * 128 * 128, 128, kb * 64, nb * 32, WPL + (size_t)g * 128 * 128, 128, scr, F.lane, MapIdent{1.f, 0, 0}); continue; } r -= I_PL;
        { const int row = INW + r; v4u z = {0u, 0u, 0u, 0u}; GAS v4u* p = (GAS v4u*)(WIN + (size_t)row * D) + F.lane; p[0] = z; p[64] = z; }
    }
}

__device__ __forceinline__ void convert_from_cursor(int l, int max_rounds) {
    const Ctx F = mkctx(); KArgs A = kargs();
    gu32* cur = (gu32*)(A->ws + WS_CTL) + CW_CVT + l * 64;
    volatile LAS unsigned* slot = (volatile LAS unsigned*)(F.lds + LDSCTL_OFF + 256);
    constexpr int NITEMS = 16 * 65 + 16 * 32 + 3 * NE * 256 + 4 * 8 + 224;
    for (int r = 0; max_rounds < 0 || r < max_rounds; ++r) {
        if (F.tid == 0) *slot = __hip_atomic_fetch_add(cur, 8u, RLX_AGENT);
        __syncthreads();
        const int start = (int)*slot;
        __syncthreads();
        if (start >= NITEMS) break;
        convert_layer_items<true>(F, A, l, start + F.wave, NITEMS + 8);
    }
}

__device__ __forceinline__ void p0_prologue() {
    const Ctx F = mkctx(); KArgs A = kargs(); unsigned char* const ws = A->ws;
    {
        LAS float* sc = (LAS float*)F.lds;
        LAS float* red = (LAS float*)(F.lds + 9 * 1024 * 4);
        for (int i = F.tid; i < 9 * 1024; i += NTHR) { const int v = i >> 10, k = i & 1023; const float cv = v < 8 ? A->in.c[v * D + k] : A->in.c_ctx[k]; sc[i] = silu_f(cv); }
        __syncthreads();
        float* MOD = (float*)(ws + WS_MOD);
        for (int it = F.bid; it < DEPTH * 96; it += F.G) {
            const int l = it / 96, j0 = (it % 96) * 64;
            const float* w = A->in.w_mod + ((size_t)l * D + F.wave * 128) * 6144 + j0 + F.lane;
            float acc[9];
#pragma unroll
            for (int v = 0; v < 9; ++v) acc[v] = 0.f;
            for (int k0 = 0; k0 < 128; k0 += 32) { float wv[32];
#pragma unroll
                for (int kk = 0; kk < 32; ++kk) wv[kk] = w[(size_t)(k0 + kk) * 6144];
#pragma unroll
                for (int kk = 0; kk < 32; ++kk) {
#pragma unroll
                    for (int v = 0; v < 9; ++v) acc[v] += sc[v * 1024 + F.wave * 128 + k0 + kk] * wv[kk]; } }
#pragma unroll
            for (int v = 0; v < 9; ++v) red[(F.wave * 9 + v) * 64 + F.lane] = acc[v];
            __syncthreads();
            for (int o = F.tid; o < 9 * 64; o += NTHR) { const int v = o >> 6, jj = o & 63; float s = 0.f;
#pragma unroll
                for (int wv = 0; wv < 8; ++wv) s += red[(wv * 9 + v) * 64 + jj];
                MOD[((size_t)l * 9 + v) * 6144 + j0 + jj] = s + A->in.b_mod[l * 6144 + j0 + jj]; }
            __syncthreads();
        }
    }
    { bf16_t* WGP = (bf16_t*)(ws + WS_WGP);
      for (int i = F.bid * NTHR + F.tid; i < DEPTH * 2 * 4 * 64 * 16; i += F.G * NTHR) { const int r = i & 15, d = (i >> 4) & 63, h = (i >> 10) & 3, n = (i >> 12) & 1, l = i >> 13;
          const float w = A->in.w_gk2[((size_t)(l * 2 + n) * 16 + r) * 256 + h * 64 + d]; const unsigned hi = f2bf(w); const float rem = w - __builtin_bit_cast(float, hi << 16);
          bf16_t* o = WGP + (size_t)l * 2 * 2 * 4 * 64 * 16 + ((size_t)(n * 4 + h) * 64 + d) * 16 + r; o[0] = (bf16_t)hi; o[2 * 4 * 64 * 16] = (bf16_t)f2bf(rem); } }
    { bf16_t* WRP = (bf16_t*)(ws + WS_WRP);
      for (int i = F.bid * NTHR + F.tid; i < NE * D; i += F.G * NTHR) { const int e = i & 15, k = i >> 4; const float w = A->in.w_router[i]; const unsigned hi = f2bf(w); const float rem = w - __builtin_bit_cast(float, hi << 16);
          WRP[(size_t)e * D + k] = (bf16_t)hi; WRP[(size_t)NE * D + (size_t)e * D + k] = (bf16_t)f2bf(rem); } }
    convert_layer_items<false>(F, A, 0, F.bid * NWAVES + F.wave, F.G * NWAVES);
}

template <bool FINAL, bool FROMIN>
__device__ __forceinline__ void rowpass_n1(int l, bool combine, int nrows, bool zero_w) {
    const Ctx F = mkctx(); KArgs A = kargs(); unsigned char* const ws = A->ws; float* const outp = A->out; gu32* const ctl = (gu32*)(ws + WS_CTL);
    const int gw = F.bid * NWAVES + F.wave, NGW = F.G * NWAVES;
    bf16_t* XB = (bf16_t*)(ws + WS_XB);
    const float* MOD = (const float*)(ws + WS_MOD);
    bf16_t* H = (bf16_t*)(ws + WS_HB);
    const bf16_t* YB = (const bf16_t*)(ws + WS_P);
    const int* TOK = (const int*)(ws + WS_TOK); const float* WTS = (const float*)(ws + WS_WTS);
    LAS int* pst = (LAS int*)(F.lds);
    if (combine) {
        if (F.tid < NE) pst[32 + F.tid] = (int)__hip_atomic_load(ctl + CW_ECNT + ((l - 1) * NE + F.tid) * 64, RLX_AGENT);
        __syncthreads();
        if (F.tid == 0) { int run = 0; for (int e = 0; e < NE; ++e) { pst[e] = run; run += ((pst[32 + e] + 255) >> 8) << 8; } }
        __syncthreads();
    }
    const int rpw = nrows / NGW, row_base = gw * rpw;
    const int c0l = 4 * F.lane;
    int vcur = -1; f32x4 gt[4], st[4], g2v[4];
    if (FINAL) {
#pragma unroll
        for (int j = 0; j < 4; ++j) gt[j] = *(const GAS f32x4*)(A->in.norm_f + c0l + 256 * j);
    }
    v2u pxb[3][4]; f32x4 pxf[3][4]; int pt0[3], pt1[3]; float pw0[3], pw1[3];
#define N1_LOAD_GROUP(G0) do { _Pragma("unroll") for (int r = 0; r < 3; ++r) { const int rr = ((G0) + r < rpw) ? (G0) + r : rpw - 1; const int row = row_base + rr; \
        if (FROMIN) { const float* src = row < NX ? A->in.x + (size_t)row * D : A->in.ctx + (size_t)(row - NX) * D; _Pragma("unroll") for (int j = 0; j < 4; ++j) pxf[r][j] = *(const GAS f32x4*)(src + c0l + 256 * j); } \
        else { _Pragma("unroll") for (int j = 0; j < 4; ++j) pxb[r][j] = *(const GAS v2u*)(XB + (size_t)row * D + c0l + 256 * j); } \
        pt0[r] = 0; pt1[r] = 0; pw0[r] = 0.f; pw1[r] = 0.f; \
        if (combine) { pt0[r] = TOK[row * 2]; pt1[r] = TOK[row * 2 + 1]; pw0[r] = WTS[row * 2]; pw1[r] = WTS[row * 2 + 1]; } } } while (0)
    N1_LOAD_GROUP(0);
    for (int g0 = 0; g0 < rpw; g0 += 3) {
        int rows[3]; bool valid[3]; f32x4 x[3][4]; int t0[3], t1[3]; float w0[3], w1[3];
#pragma unroll
        for (int r = 0; r < 3; ++r) { valid[r] = g0 + r < rpw; rows[r] = row_base + (valid[r] ? g0 + r : rpw - 1); t0[r] = pt0[r]; t1[r] = pt1[r]; w0[r] = zero_w ? 0.f : pw0[r]; w1[r] = zero_w ? 0.f : pw1[r];
#pragma unroll
            for (int j = 0; j < 4; ++j) { if (FROMIN) x[r][j] = pxf[r][j]; else { const v2u a = pxb[r][j];
                x[r][j] = (f32x4){__builtin_bit_cast(float, a.x << 16), __builtin_bit_cast(float, a.x & 0xffff0000u), __builtin_bit_cast(float, a.y << 16), __builtin_bit_cast(float, a.y & 0xffff0000u)}; } } }
        v2u ya[3][4], yb[3][4];
        if (combine) {
#pragma unroll
            for (int r = 0; r < 3; ++r) { const bf16_t* y0 = YB + (size_t)(pst[t0[r] & 15] + (t0[r] >> 4)) * D; const bf16_t* y1 = YB + (size_t)(pst[t1[r] & 15] + (t1[r] >> 4)) * D;
#pragma unroll
                for (int j = 0; j < 4; ++j) { ya[r][j] = *(const GAS v2u*)(y0 + c0l + 256 * j); yb[r][j] = *(const GAS v2u*)(y1 + c0l + 256 * j); } }
        }
        if (g0 + 3 < rpw) N1_LOAD_GROUP(g0 + 3);
#pragma unroll
        for (int r = 0; r < 3; ++r) { const int row = rows[r]; const int v = variant_of_row(row);
            if (!FINAL && v != vcur) {
                vcur = v; const float* m = MOD + ((size_t)l * 9 + v) * 6144; f32x4 gn[4], scl[4];
#pragma unroll
                for (int j = 0; j < 4; ++j) { gn[j] = *(const GAS f32x4*)(A->in.norm1 + l * D + c0l + 256 * j); scl[j] = *(const GAS f32x4*)(m + D + c0l + 256 * j); st[j] = *(const GAS f32x4*)(m + c0l + 256 * j); }
#pragma unroll
                for (int j = 0; j < 4; ++j) gt[j] = gn[j] * (scl[j] + 1.f);
                if (combine) {
#pragma unroll
                    for (int j = 0; j < 4; ++j) g2v[j] = *(const GAS f32x4*)(MOD + ((size_t)(l - 1) * 9 + v) * 6144 + 5 * D + c0l + 256 * j); }
            }
            if (FINAL && combine && v != vcur) { vcur = v;
#pragma unroll
                for (int j = 0; j < 4; ++j) g2v[j] = *(const GAS f32x4*)(MOD + ((size_t)(l - 1) * 9 + v) * 6144 + 5 * D + c0l + 256 * j); }
            if (combine) {
#pragma unroll
                for (int j = 0; j < 4; ++j) { const v2u a = ya[r][j], b = yb[r][j];
                    const f32x4 fa = {__builtin_bit_cast(float, a.x << 16), __builtin_bit_cast(float, a.x & 0xffff0000u), __builtin_bit_cast(float, a.y << 16), __builtin_bit_cast(float, a.y & 0xffff0000u)};
                    const f32x4 fb = {__builtin_bit_cast(float, b.x << 16), __builtin_bit_cast(float, b.x & 0xffff0000u), __builtin_bit_cast(float, b.y << 16), __builtin_bit_cast(float, b.y & 0xffff0000u)};
                    x[r][j] = x[r][j] + g2v[j] * (fa * w0[r] + fb * w1[r]); } }
            if (!FINAL && (combine || FROMIN) && valid[r]) {
#pragma unroll
                for (int j = 0; j < 4; ++j) { v2u o; o.x = pk2(x[r][j].x, x[r][j].y); o.y = pk2(x[r][j].z, x[r][j].w); *(GAS v2u*)(XB + (size_t)row * D + c0l + 256 * j) = o; }
            }
            float ss = 0.f;
#pragma unroll
            for (int j = 0; j < 4; ++j) ss += (x[r][j].x * x[r][j].x + x[r][j].y * x[r][j].y) + (x[r][j].z * x[r][j].z + x[r][j].w * x[r][j].w);
            const float rinv = rsqrtf(wave_sum(ss) * (1.f / D) + 1e-6f);
            if (valid[r]) {
                if (FINAL) { float* dst = outp + (size_t)row * D;
#pragma unroll
                    for (int j = 0; j < 4; ++j) *(GAS f32x4*)(dst + c0l + 256 * j) = x[r][j] * rinv * gt[j];
                } else {
#pragma unroll
                    for (int j = 0; j < 4; ++j) { const f32x4 h = x[r][j] * rinv * gt[j] + st[j];
                        v2u o; o.x = pk2(h.x, h.y); o.y = pk2(h.z, h.w); *(GAS v2u*)(H + (size_t)row * D + c0l + 256 * j) = o; }
                }
            }
        }
    }
#undef N1_LOAD_GROUP
}
#define HAVE_GLA 1
constexpr int G_LG = 0;
constexpr int G_TMP = 32768;
constexpr int G_AO = 51200;
constexpr int G_VN = 76800;
constexpr int G_BS = 94208;
constexpr int G_OUT = 0;
__device__ __forceinline__ f32x16 mfma32(bf16x8 a, bf16x8 b, f32x16 c) { return __builtin_amdgcn_mfma_f32_32x32x16_bf16(a, b, c, 0, 0, 0); }
__device__ __forceinline__ float fast_logsigmoid(float x) { return fminf(x, 0.f) - __logf(1.f + __expf(-fabsf(x))); }
__device__ __forceinline__ void unpack8(const v4u w, float (&f)[8]) {
    f[0] = __builtin_bit_cast(float, w.x << 16); f[1] = __builtin_bit_cast(float, w.x & 0xffff0000u); f[2] = __builtin_bit_cast(float, w.y << 16); f[3] = __builtin_bit_cast(float, w.y & 0xffff0000u);
    f[4] = __builtin_bit_cast(float, w.z << 16); f[5] = __builtin_bit_cast(float, w.z & 0xffff0000u); f[6] = __builtin_bit_cast(float, w.w << 16); f[7] = __builtin_bit_cast(float, w.w & 0xffff0000u);
}
__device__ __forceinline__ v4u pack8(const float (&f)[8]) { v4u w; w.x = pk2(f[0], f[1]); w.y = pk2(f[2], f[3]); w.z = pk2(f[4], f[5]); w.w = pk2(f[6], f[7]); return w; }

typedef short v4i16_t __attribute__((ext_vector_type(4)));
__device__ __forceinline__ bf16x8 tr_frag(const LAS bf16_t* T, int ld, int k0, int n0, int lane) {
    const int hh = lane >> 5, blk = (lane >> 4) & 1, q = (lane & 15) >> 2, p = lane & 3;
    const LAS bf16_t* a0 = T + (k0 + 8 * hh + q) * ld + n0 + 16 * blk + 4 * p;
    const v4i16_t lo = __builtin_amdgcn_ds_read_tr16_b64_v4i16((LAS v4i16_t*)a0), hi = __builtin_amdgcn_ds_read_tr16_b64_v4i16((LAS v4i16_t*)(a0 + 4 * ld));
    bf16x8 r; r[0] = lo[0]; r[1] = lo[1]; r[2] = lo[2]; r[3] = lo[3]; r[4] = hi[0]; r[5] = hi[1]; r[6] = hi[2]; r[7] = hi[3]; return r;
}
struct DecPre { v4u a, bhi, blo; float bias; };
__device__ __forceinline__ void decays_load(DecPre& p, const Ctx& F, const bf16_t* P, const bf16_t* WGPl, const float* b_gkl, int r0, int h) {
    const int n = F.wave >> 2, tt = (F.wave >> 1) & 1, dt = F.wave & 1, r = F.lane & 31, hh = F.lane >> 5;
    p.a = *(const GAS v4u*)(P + (size_t)(r0 + 32 * tt + r) * PLD + 2048 + n * 16 + 8 * hh);
    const bf16_t* wg = WGPl + ((size_t)(n * 4 + h) * 64 + 32 * dt + r) * 16 + 8 * hh;
    p.bhi = *(const GAS v4u*)wg; p.blo = *(const GAS v4u*)(wg + 2 * 4 * 64 * 16);
    p.bias = b_gkl[n * 256 + h * 64 + 32 * dt + r];
}
__device__ __forceinline__ void chunk_decays(const Ctx& F, const DecPre& p) {
    LAS float* LG = (LAS float*)(F.lds + G_LG); LAS float* TT = (LAS float*)(F.lds + G_TMP);
    const int n = F.wave >> 2, tt = (F.wave >> 1) & 1, dt = F.wave & 1, r = F.lane & 31, hh = F.lane >> 5;
    f32x16 acc = {0.f, 0.f, 0.f, 0.f, 0.f, 0.f, 0.f, 0.f, 0.f, 0.f, 0.f, 0.f, 0.f, 0.f, 0.f, 0.f};
    acc = mfma32(__builtin_bit_cast(bf16x8, p.a), __builtin_bit_cast(bf16x8, p.bhi), acc);
    acc = mfma32(__builtin_bit_cast(bf16x8, p.a), __builtin_bit_cast(bf16x8, p.blo), acc);
    float v[16];
#pragma unroll
    for (int g = 0; g < 16; ++g) v[g] = fast_logsigmoid(acc[g] + p.bias) * (1.f / 16.f);
    float T[4], Pq[4];
    if (n == 0) {
#pragma unroll
        for (int q = 0; q < 4; ++q) { v[4 * q + 1] += v[4 * q]; v[4 * q + 2] += v[4 * q + 1]; v[4 * q + 3] += v[4 * q + 2]; T[q] = v[4 * q + 3]; }
    } else {
#pragma unroll
        for (int q = 0; q < 4; ++q) { v[4 * q + 2] += v[4 * q + 3]; v[4 * q + 1] += v[4 * q + 2]; v[4 * q] += v[4 * q + 1]; T[q] = v[4 * q]; }
    }
#pragma unroll
    for (int q = 0; q < 4; ++q) Pq[q] = __shfl_xor(T[q], 32);
    const float tot = ((T[0] + Pq[0]) + (T[1] + Pq[1])) + ((T[2] + Pq[2]) + (T[3] + Pq[3]));
    if (hh == 0) TT[(n * 2 + tt) * 64 + 32 * dt + r] = tot;
    float off[4];
    if (n == 0) { float run = 0.f;
#pragma unroll
        for (int q = 0; q < 4; ++q) { off[q] = run + (hh ? Pq[q] : 0.f); run += T[q] + Pq[q]; }
    } else { float run = 0.f;
#pragma unroll
        for (int q = 3; q >= 0; --q) { off[q] = run + (hh ? 0.f : Pq[q]); run += T[q] + Pq[q]; }
    }
    __syncthreads();
    const float xo = (n == 0) ? (tt == 1 ? TT[(0 * 2 + 0) * 64 + 32 * dt + r] : 0.f) : (tt == 0 ? TT[(1 * 2 + 1) * 64 + 32 * dt + r] : 0.f);
#pragma unroll
    for (int g = 0; g < 16; ++g) { const int t = 32 * tt + (g & 3) + 8 * (g >> 2) + 4 * hh; LG[(n * 64 + t) * 64 + 32 * dt + r] = v[g] + off[g >> 2] + xo; }
    __syncthreads();
}

struct KvPre { DecPre dec; v4u k, v0, v1; };
__device__ __forceinline__ void kv_decode(int job, int& b, int& h, int& j) { b = job / 144; const int rem = job % 144; h = rem / NCH; j = rem % NCH; }
__device__ __forceinline__ void kv_load(KvPre& p, const Ctx& F, KArgs A, int l, int job) {
    int b, h, j; kv_decode(job, b, h, j); const bf16_t* P = (const bf16_t*)(A->ws + WS_P); const int r0 = chunk_row0(b, j);
    decays_load(p.dec, F, P, (const bf16_t*)(A->ws + WS_WGP) + (size_t)l * 2 * 2 * 4 * 64 * 16, A->in.b_gk + (size_t)l * 2 * 256, r0, h);
    const int t = F.tid >> 3, dg = F.tid & 7; const bf16_t* pr = P + (size_t)(r0 + t) * PLD;
    p.k = *(const GAS v4u*)(pr + 768 + h * 64 + 8 * dg); p.v0 = *(const GAS v4u*)(pr + 1024 + h * 128 + 16 * dg); p.v1 = *(const GAS v4u*)(pr + 1024 + h * 128 + 16 * dg + 8);
}
__device__ __forceinline__ void kv_compute(const KvPre& p, const Ctx& F, unsigned char* ws, int job) {
    int b, h, j; kv_decode(job, b, h, j);
    chunk_decays(F, p.dec);
    LAS float* LG = (LAS float*)(F.lds + G_LG);
    LAS bf16_t* KEF = (LAS bf16_t*)(F.lds + G_AO); LAS bf16_t* KEB = KEF + 64 * 72; LAS bf16_t* VN = (LAS bf16_t*)(F.lds + G_VN);
    { const int t = F.tid >> 3, dg = F.tid & 7;
      float k[8]; unpack8(p.k, k); float kf[8], kb[8];
#pragma unroll
      for (int i = 0; i < 8; ++i) { const int d = 8 * dg + i;
          kf[i] = k[i] * __expf(LG[63 * 64 + d] - LG[t * 64 + d]); kb[i] = k[i] * __expf(LG[64 * 64 + d] - LG[(64 + t) * 64 + d]); }
      *(LAS v4u*)(KEF + t * 72 + 8 * dg) = pack8(kf); *(LAS v4u*)(KEB + t * 72 + 8 * dg) = pack8(kb);
      *(LAS v4u*)(VN + t * 136 + 16 * dg) = p.v0; *(LAS v4u*)(VN + t * 136 + 16 * dg + 8) = p.v1; }
    const int seq0 = (b * 4 + h) * 2;
    if (F.tid < 128) { const int n = F.tid >> 6, d = F.tid & 63; float* ADEC = (float*)(ws + WS_ADEC);
        ADEC[((size_t)(seq0 + n) * NCH + j) * 64 + d] = __expf(n == 0 ? LG[63 * 64 + d] : LG[64 * 64 + d]); }
    __syncthreads();
    { const int dir = F.wave >> 2, et = F.wave & 3, r = F.lane & 31, hh = F.lane >> 5;
      const LAS bf16_t* KE = dir ? KEB : KEF;
      f32x16 a0 = {0.f, 0.f, 0.f, 0.f, 0.f, 0.f, 0.f, 0.f, 0.f, 0.f, 0.f, 0.f, 0.f, 0.f, 0.f, 0.f}, a1 = a0;
#pragma unroll
      for (int ks = 0; ks < 4; ++ks) { const bf16x8 av = tr_frag(VN, 136, 16 * ks, 32 * et, F.lane);
          const bf16x8 b0 = tr_frag(KE, 72, 16 * ks, 0, F.lane), b1 = tr_frag(KE, 72, 16 * ks, 32, F.lane);
          a0 = mfma32(av, b0, a0); a1 = mfma32(av, b1, a1); }
      bf16_t* KVS = (bf16_t*)(ws + WS_KVS) + ((size_t)(seq0 + dir) * NCH + j) * 8192;
#pragma unroll
      for (int g = 0; g < 16; ++g) { const int e = 32 * et + (g & 3) + 8 * (g >> 2) + 4 * hh; KVS[e * 64 + r] = (bf16_t)pk2(a0[g], 0.f); KVS[e * 64 + 32 + r] = (bf16_t)pk2(a1[g], 0.f); } }
    __syncthreads();
}

template <int HW>
__device__ __forceinline__ void pool_job_t(int l, int pj, int g) {
    const Ctx F = mkctx(); KArgs A = kargs(); unsigned char* const ws = A->ws;
    const bf16_t* P = (const bf16_t*)(ws + WS_P);
    LAS float* VS = (LAS float*)(F.lds);
    LAS bf16_t* PD = (LAS bf16_t*)(F.lds + 33792);
    LAS bf16_t* WP = (LAS bf16_t*)(F.lds + 33792 + 17408);
    const bool latent = pj < 1024;
    int b, i64; if (latent) { b = pj >> 7; i64 = (pj >> 2) & 31; } else { const int q = pj - 1024; b = q >> 4; i64 = (q >> 2) & 3; }
    const int row0 = latent ? b * SEQ + i64 * 64 : NX + b * CTXL + i64 * 64;
    v4u wpre[4];
    { const bf16_t* wsrc = (const bf16_t*)(ws + WS_WPOOL) + (size_t)(l * 4 + g) * 128 * 128;
#pragma unroll
      for (int c = 0; c < 4; ++c) { const int u = F.tid + NTHR * c, d = u >> 4, q = u & 15; wpre[c] = *(const GAS v4u*)(wsrc + d * 128 + 8 * q); } }
    const float psc = A->in.pool_scale[l * 512 + g * 128 + 32 * (F.wave & 3) + (F.lane & 31)];
    v4u upre[2];
#pragma unroll
    for (int c = 0; c < 2; ++c) { const int u = F.tid + NTHR * c, jc = u >> 4, cg = u & 15; upre[c] = *(const GAS v4u*)(P + (size_t)(row0 + jc) * PLD + g * 128 + 8 * cg); }
    if (latent) {
        const int rlo = max(i64 - HW, 0), rhi = min(i64 + HW, 32); const float rc = 1.f / (float)(rhi - rlo);
#pragma unroll
        for (int c = 0; c < 2; ++c) { const int u = F.tid + NTHR * c, jc = u >> 4, cg = u & 15; float s[8];
#pragma unroll
            for (int i = 0; i < 8; ++i) s[i] = 0.f;
            v4u ld[2 * HW];
#pragma unroll
            for (int k = 0; k < 2 * HW; ++k) { const int r2 = min(max(i64 - HW + k, 0), 31); ld[k] = *(const GAS v4u*)(P + (size_t)(b * SEQ + r2 * 64 + jc) * PLD + g * 128 + 8 * cg); }
#pragma unroll
            for (int k = 0; k < 2 * HW; ++k) { const int r2 = i64 - HW + k; const float wt = (r2 >= 0 && r2 < 32) ? 1.f : 0.f; float f[8]; unpack8(ld[k], f);
#pragma unroll
                for (int i = 0; i < 8; ++i) s[i] += wt * f[i]; }
#pragma unroll
            for (int i = 0; i < 8; ++i) VS[jc * 132 + 8 * cg + i] = s[i] * rc; }
    }
#pragma unroll
    for (int c = 0; c < 4; ++c) { const int u = F.tid + NTHR * c, d = u >> 4, q = u & 15; *(LAS v4u*)(WP + d * 136 + 8 * q) = wpre[c]; }
    if (latent) __syncthreads();
#pragma unroll
    for (int c = 0; c < 2; ++c) { const int u = F.tid + NTHR * c, jc = u >> 4, cg = u & 15; float s[8];
#pragma unroll
        for (int i = 0; i < 8; ++i) s[i] = 0.f;
        float cnt;
        if (latent) { const int clo = max(jc - HW, 0), chi = min(jc + HW, 64); cnt = (float)(chi - clo);
#pragma unroll
            for (int k = 0; k < 2 * HW; ++k) { const int j2 = jc - HW + k; const float wt = (j2 >= 0 && j2 < 64) ? 1.f : 0.f; const int j2c = min(max(j2, 0), 63);
                const f32x4 v0 = *(const LAS f32x4*)(VS + j2c * 132 + 8 * cg), v1 = *(const LAS f32x4*)(VS + j2c * 132 + 8 * cg + 4);
                s[0] += wt * v0.x; s[1] += wt * v0.y; s[2] += wt * v0.z; s[3] += wt * v0.w; s[4] += wt * v1.x; s[5] += wt * v1.y; s[6] += wt * v1.z; s[7] += wt * v1.w; } }
        else { const int t = i64 * 64 + jc; const int lo = max(t - HW, 0), hi = min(t + HW, CTXL); cnt = (float)(hi - lo);
            v4u ld[2 * HW];
#pragma unroll
            for (int k = 0; k < 2 * HW; ++k) { const int t2 = min(max(t - HW + k, 0), CTXL - 1); ld[k] = *(const GAS v4u*)(P + (size_t)(NX + b * CTXL + t2) * PLD + g * 128 + 8 * cg); }
#pragma unroll
            for (int k = 0; k < 2 * HW; ++k) { const int t2 = t - HW + k; const float wt = (t2 >= 0 && t2 < CTXL) ? 1.f : 0.f; float f[8]; unpack8(ld[k], f);
#pragma unroll
                for (int i = 0; i < 8; ++i) s[i] += wt * f[i]; } }
        float uv[8]; unpack8(upre[c], uv);
        const float ic = 1.f / cnt; float pd[8];
#pragma unroll
        for (int i = 0; i < 8; ++i) pd[i] = s[i] * ic - uv[i];
        *(LAS v4u*)(PD + jc * 136 + 8 * cg) = pack8(pd); }
    __syncthreads();
    { const int mt = F.wave >> 2, nt = F.wave & 3, r = F.lane & 31, hh = F.lane >> 5;
      f32x16 acc = {0.f, 0.f, 0.f, 0.f, 0.f, 0.f, 0.f, 0.f, 0.f, 0.f, 0.f, 0.f, 0.f, 0.f, 0.f, 0.f};
#pragma unroll
      for (int ks = 0; ks < 8; ++ks) { const bf16x8 av = *(const LAS bf16x8*)(PD + (32 * mt + r) * 136 + 16 * ks + 8 * hh), bv = *(const LAS bf16x8*)(WP + (32 * nt + r) * 136 + 16 * ks + 8 * hh);
          acc = mfma32(av, bv, acc); }
      const int dcol = g * 128 + 32 * nt + r;
      bf16_t* MIX = (bf16_t*)(ws + WS_HB);
#pragma unroll
      for (int q = 0; q < 16; ++q) { const int jc = 32 * mt + (q & 3) + 8 * (q >> 2) + 4 * hh; MIX[(size_t)(row0 + jc) * D + dcol] = (bf16_t)pk2(acc[q] * psc, 0.f); } }
    __syncthreads();
}
__device__ __forceinline__ void pool_job(int l, int pj) {
    const int g = ((pj & 3) + (pj >> 8)) & 3;
    if (g == 0) pool_job_t<1>(l, pj, 0); else if (g == 1) pool_job_t<2>(l, pj, 1); else if (g == 2) pool_job_t<4>(l, pj, 2); else pool_job_t<8>(l, pj, 3);
}

__device__ __forceinline__ void gla_phase1(int l) {
    const int npool = (l < DEPTH - 1) ? 1152 : 1024;
    const int pflags = kargs()->flags;
    if (!(pflags & 4)) {
        const Ctx F = mkctx(); KArgs A = kargs(); unsigned char* const ws = A->ws;
        int job = blockIdx.x; KvPre pre;
        if (job < 1152) kv_load(pre, F, A, l, job);
        while (job < 1152) {
            const KvPre cur = pre; const int nj = job + gridDim.x;
            if (nj < 1152) kv_load(pre, F, A, l, nj);
            kv_compute(cur, F, ws, job);
            job = nj;
        }
    }
    if (!(pflags & 2)) for (int J = blockIdx.x; J < 1152 + npool; J += gridDim.x) if (J >= 1152) pool_job(l, J - 1152);
}

__device__ __forceinline__ void gla_phase2(int l) {
    const Ctx F = mkctx(); KArgs A = kargs(); unsigned char* const ws = A->ws;
    const int gid = F.bid * NTHR + F.tid; if (gid >= 64 * 2048) return;
    const int seq = gid >> 11, rem = gid & 2047, e = rem >> 4, dq = rem & 15, dir = seq & 1;
    bf16_t* base = (bf16_t*)(ws + WS_KVS) + (size_t)seq * NCH * 8192 + e * 64 + 4 * dq;
    const float* adec = (const float*)(ws + WS_ADEC) + (size_t)seq * NCH * 64 + 4 * dq;
    f32x4 S = {0.f, 0.f, 0.f, 0.f};
    for (int bt = 0; bt < 3; ++bt) {
        v2u kv[12]; f32x4 av[12];
#pragma unroll
        for (int i = 0; i < 12; ++i) { const int s = bt * 12 + i; const int jj = dir == 0 ? s : (s < 4 ? 3 - s : 39 - s);
            kv[i] = *(const GAS v2u*)(base + (size_t)jj * 8192); av[i] = *(const GAS f32x4*)(adec + jj * 64); }
#pragma unroll
        for (int i = 0; i < 12; ++i) { const int s = bt * 12 + i; const int jj = dir == 0 ? s : (s < 4 ? 3 - s : 39 - s);
            v2u o; o.x = pk2(S.x, S.y); o.y = pk2(S.z, S.w); *(GAS v2u*)(base + (size_t)jj * 8192) = o;
            const f32x4 k4 = {__builtin_bit_cast(float, kv[i].x << 16), __builtin_bit_cast(float, kv[i].x & 0xffff0000u), __builtin_bit_cast(float, kv[i].y << 16), __builtin_bit_cast(float, kv[i].y & 0xffff0000u)};
            S = av[i] * S + k4; }
    }
}

struct OutPre { DecPre dec; v4u q, k, v0, v1, g0, g1, sf0, sf1, sb0, sb1; f32x4 gg[4]; };
__device__ __forceinline__ void out_load(OutPre& p, const Ctx& F, KArgs A, int l, int job) {
    int b, h, j; kv_decode(job, b, h, j); const bf16_t* P = (const bf16_t*)(A->ws + WS_P); const int r0 = chunk_row0(b, j);
    decays_load(p.dec, F, P, (const bf16_t*)(A->ws + WS_WGP) + (size_t)l * 2 * 2 * 4 * 64 * 16, A->in.b_gk + (size_t)l * 2 * 256, r0, h);
    const int t = F.tid >> 3, dg = F.tid & 7; const bf16_t* pr = P + (size_t)(r0 + t) * PLD;
    p.q = *(const GAS v4u*)(pr + 512 + h * 64 + 8 * dg); p.k = *(const GAS v4u*)(pr + 768 + h * 64 + 8 * dg);
    p.v0 = *(const GAS v4u*)(pr + 1024 + h * 128 + 16 * dg); p.v1 = *(const GAS v4u*)(pr + 1024 + h * 128 + 16 * dg + 8);
    p.g0 = *(const GAS v4u*)(pr + 1536 + h * 128 + 16 * dg); p.g1 = *(const GAS v4u*)(pr + 1536 + h * 128 + 16 * dg + 8);
#pragma unroll
    for (int c = 0; c < 4; ++c) p.gg[c] = *(const GAS f32x4*)(A->in.gla_gain + l * 128 + 16 * dg + 4 * c);
    const int e = F.tid >> 2, q4 = F.tid & 3; const bf16_t* sf = (const bf16_t*)(A->ws + WS_KVS) + ((size_t)((b * 4 + h) * 2) * NCH + j) * 8192 + e * 64 + 16 * q4;
    p.sf0 = *(const GAS v4u*)sf; p.sf1 = *(const GAS v4u*)(sf + 8); p.sb0 = *(const GAS v4u*)(sf + (size_t)NCH * 8192); p.sb1 = *(const GAS v4u*)(sf + (size_t)NCH * 8192 + 8);
}
__device__ __forceinline__ void out_compute(const OutPre& p, const Ctx& F, KArgs A, int l, int job) {
    int b, h, j; kv_decode(job, b, h, j); unsigned char* const ws = A->ws; const int r0 = chunk_row0(b, j);
    chunk_decays(F, p.dec);
    LAS float* LG = (LAS float*)(F.lds + G_LG);
    LAS bf16_t* KTF = (LAS bf16_t*)(F.lds + G_TMP); LAS bf16_t* KTB = KTF + 64 * 72;
    LAS bf16_t* AO = (LAS bf16_t*)(F.lds + G_AO); LAS bf16_t* VN = (LAS bf16_t*)(F.lds + G_VN); LAS bf16_t* BS = (LAS bf16_t*)(F.lds + G_BS);
    { const int t = F.tid >> 3, dg = F.tid & 7;
      float q[8], k[8]; unpack8(p.q, q); unpack8(p.k, k);
      float qf[8], qb[8], kf[8], kb[8];
#pragma unroll
      for (int i = 0; i < 8; ++i) { const int d = 8 * dg + i; const float bf = LG[t * 64 + d], bb = LG[(64 + t) * 64 + d];
          qf[i] = q[i] * __expf(bf); kf[i] = k[i] * __expf(-bf); qb[i] = q[i] * __expf(bb); kb[i] = k[i] * __expf(-bb); }
      *(LAS v4u*)(AO + t * 200 + 64 + 8 * dg) = pack8(qf); *(LAS v4u*)(AO + t * 200 + 128 + 8 * dg) = pack8(qb);
      *(LAS v4u*)(KTF + t * 72 + 8 * dg) = pack8(kf); *(LAS v4u*)(KTB + t * 72 + 8 * dg) = pack8(kb);
      *(LAS v4u*)(VN + t * 136 + 16 * dg) = p.v0; *(LAS v4u*)(VN + t * 136 + 16 * dg + 8) = p.v1; }
    { const int e = F.tid >> 2, q4 = F.tid & 3;
      *(LAS v4u*)(BS + e * 136 + 16 * q4) = p.sf0; *(LAS v4u*)(BS + e * 136 + 16 * q4 + 8) = p.sf1; *(LAS v4u*)(BS + e * 136 + 64 + 16 * q4) = p.sb0; *(LAS v4u*)(BS + e * 136 + 64 + 16 * q4 + 8) = p.sb1; }
    __syncthreads();
    const int mt = F.wave >> 2, nt = F.wave & 3, r = F.lane & 31, hh = F.lane >> 5;
    f32x16 acc = {0.f, 0.f, 0.f, 0.f, 0.f, 0.f, 0.f, 0.f, 0.f, 0.f, 0.f, 0.f, 0.f, 0.f, 0.f, 0.f};
    if (F.wave < 4) {
        const int tt = F.wave == 0 ? 0 : (F.wave == 1 ? 1 : (F.wave == 2 ? 1 : 0)), st = F.wave == 0 ? 0 : (F.wave == 1 ? 1 : (F.wave == 2 ? 0 : 1));
        const bool dof = F.wave != 3, dob = F.wave != 2;
        f32x16 af = {0.f, 0.f, 0.f, 0.f, 0.f, 0.f, 0.f, 0.f, 0.f, 0.f, 0.f, 0.f, 0.f, 0.f, 0.f, 0.f}, ab = af;
        if (dof) {
#pragma unroll
            for (int ks = 0; ks < 4; ++ks) af = mfma32(*(const LAS bf16x8*)(AO + (32 * tt + r) * 200 + 64 + 16 * ks + 8 * hh), *(const LAS bf16x8*)(KTF + (32 * st + r) * 72 + 16 * ks + 8 * hh), af); }
        if (dob) {
#pragma unroll
            for (int ks = 0; ks < 4; ++ks) ab = mfma32(*(const LAS bf16x8*)(AO + (32 * tt + r) * 200 + 128 + 16 * ks + 8 * hh), *(const LAS bf16x8*)(KTB + (32 * st + r) * 72 + 16 * ks + 8 * hh), ab); }
        const bool diag = tt == st;
#pragma unroll
        for (int g = 0; g < 16; ++g) { const int trow = (g & 3) + 8 * (g >> 2) + 4 * hh;
            float v = af[g] + ab[g];
            if (diag) v = (r <= trow ? af[g] : 0.f) + (r >= trow ? ab[g] : 0.f);
            AO[(32 * tt + trow) * 200 + 32 * st + r] = (bf16_t)pk2(v, 0.f); }
    }
#pragma unroll
    for (int ks = 4; ks < 12; ++ks) acc = mfma32(*(const LAS bf16x8*)(AO + (32 * mt + r) * 200 + 16 * ks + 8 * hh), *(const LAS bf16x8*)(BS + (32 * nt + r) * 136 + 16 * (ks - 4) + 8 * hh), acc);
    __syncthreads();
    {
#pragma unroll
      for (int ks = 0; ks < 4; ++ks) acc = mfma32(*(const LAS bf16x8*)(AO + (32 * mt + r) * 200 + 16 * ks + 8 * hh), tr_frag(VN, 136, 16 * ks, 32 * nt, F.lane), acc);
      LAS float* OUT = (LAS float*)(F.lds + G_OUT);
#pragma unroll
      for (int g = 0; g < 16; ++g) { const int trow = 32 * mt + (g & 3) + 8 * (g >> 2) + 4 * hh; OUT[trow * 132 + 32 * nt + r] = acc[g]; } }
    __syncthreads();
    { const int t = F.tid >> 3, eg = F.tid & 7; const LAS float* o = (const LAS float*)(F.lds + G_OUT) + t * 132 + 16 * eg;
      float ov[16]; float ss = 0.f;
#pragma unroll
      for (int i = 0; i < 4; ++i) { const f32x4 x4 = *(const LAS f32x4*)(o + 4 * i); ov[4 * i] = x4.x; ov[4 * i + 1] = x4.y; ov[4 * i + 2] = x4.z; ov[4 * i + 3] = x4.w; ss += (x4.x * x4.x + x4.y * x4.y) + (x4.z * x4.z + x4.w * x4.w); }
      ss += __shfl_xor(ss, 1); ss += __shfl_xor(ss, 2); ss += __shfl_xor(ss, 4);
      const float rinv = rsqrtf(ss * (1.f / 128.f) + 1e-6f);
      float gg[16];
#pragma unroll
      for (int c = 0; c < 4; ++c) { gg[4 * c] = p.gg[c].x; gg[4 * c + 1] = p.gg[c].y; gg[4 * c + 2] = p.gg[c].z; gg[4 * c + 3] = p.gg[c].w; }
      bf16_t* mp = (bf16_t*)(ws + WS_HB) + (size_t)(r0 + t) * D + 512 + h * 128 + 16 * eg;
#pragma unroll
      for (int c = 0; c < 2; ++c) { float gv[8]; unpack8(c ? p.g1 : p.g0, gv); float y[8];
#pragma unroll
          for (int i = 0; i < 8; ++i) { const float gx = gv[i]; y[i] = ov[8 * c + i] * rinv * gg[8 * c + i] * gx * __builtin_amdgcn_rcpf(1.f + __expf(-gx)); }
          *(GAS v4u*)(mp + 8 * c) = pack8(y); } }
    __syncthreads();
}
__device__ __forceinline__ int out_next(int l, int job, int G) { job += G; if (l == DEPTH - 1) while (job < 1152 && (job % 144) % NCH < 4) job += G; return job; }
__device__ __forceinline__ void gla_phase3(int l) {
    const Ctx F = mkctx(); KArgs A = kargs();
    const int G = gridDim.x; int job = out_next(l, (int)blockIdx.x - G, G); OutPre pre;
    if (job < 1152) out_load(pre, F, A, l, job);
    while (job < 1152) {
        const OutPre cur = pre; const int nj = out_next(l, job, G);
        if (nj < 1152) out_load(pre, F, A, l, nj);
        out_compute(cur, F, A, l, job);
        job = nj;
    }
}
#define HAVE_MOE 1
#define DPPF(x, ctrl) __builtin_bit_cast(float, __builtin_amdgcn_update_dpp(0, __builtin_bit_cast(int, (x)), (ctrl), 0xF, 0xF, true))
__device__ __forceinline__ float reduce16(const float (&a)[16], int lane) {
    float b8[8], b4[4], b2[2];
    bool h = (lane & 8) != 0;
#pragma unroll
    for (int i = 0; i < 8; ++i) { const float keep = h ? a[8 + i] : a[i], send = h ? a[i] : a[8 + i]; b8[i] = keep + DPPF(send, 0x140); }
    h = (lane & 4) != 0;
#pragma unroll
    for (int i = 0; i < 4; ++i) { const float keep = h ? b8[4 + i] : b8[i], send = h ? b8[i] : b8[4 + i]; b4[i] = keep + DPPF(send, 0x141); }
    h = (lane & 2) != 0;
#pragma unroll
    for (int i = 0; i < 2; ++i) { const float keep = h ? b4[2 + i] : b4[i], send = h ? b4[i] : b4[2 + i]; b2[i] = keep + DPPF(send, 0x4E); }
    h = (lane & 1) != 0;
    float r; { const float keep = h ? b2[1] : b2[0], send = h ? b2[0] : b2[1]; r = keep + DPPF(send, 0xB1); }
    r += __shfl_xor(r, 16); r += __shfl_xor(r, 32);
    return r;
}

__device__ __forceinline__ void router_phase(int l, int nrows) {
    const Ctx F = mkctx(); KArgs A = kargs(); unsigned char* const ws = A->ws;
    constexpr int WRS = D + 4;
    LAS float* WRT = (LAS float*)F.lds;
    LAS float* LGS = (LAS float*)(F.lds + 69632);
    LAS int* CNT = (LAS int*)(F.lds + 69632 + 2048);
    LAS int* BASE = CNT + 16;
    LAS int* ASG = (LAS int*)(F.lds + 69632 + 4096);
    { const float* wr = A->in.w_router;
      float wl[32];
#pragma unroll
      for (int c = 0; c < 32; ++c) wl[c] = wr[F.tid + NTHR * c];
#pragma unroll
      for (int c = 0; c < 32; ++c) { const int i = F.tid + NTHR * c; WRT[(i & 15) * WRS + (i >> 4)] = wl[c]; } }
    if (F.tid < 32) CNT[F.tid] = 0;
    __syncthreads();
    const bf16_t* XB = (const bf16_t*)(ws + WS_XB);
    const float* MODl = (const float*)(ws + WS_MOD) + (size_t)l * 9 * 6144;
    bf16_t* H = (bf16_t*)(ws + WS_HB);
    float* WTS = (float*)(ws + WS_WTS);
    const float rb_lane = A->in.router_bias[F.lane & 15];
    const int rpb = nrows / F.G, rpw = rpb / NWAVES;
    const int row_base = F.bid * rpb + F.wave * rpw;
    LAS float* GT = (LAS float*)(F.lds + 77824); LAS float* ST = GT + 2048;
    const int v0 = variant_of_row(F.bid * rpb), v1 = variant_of_row(F.bid * rpb + rpb - 1);
    { float tn[4], tsc[4], tsh[4];
#pragma unroll
      for (int c = 0; c < 4; ++c) { const int i = F.tid + NTHR * c, ti = i >> 10, k = i & 1023; const float* m = MODl + (size_t)(ti ? v1 : v0) * 6144;
          tn[c] = A->in.norm2[l * D + k]; tsc[c] = m[4 * D + k]; tsh[c] = m[3 * D + k]; }
#pragma unroll
      for (int c = 0; c < 4; ++c) { const int i = F.tid + NTHR * c; GT[i] = tn[c] * (1.f + tsc[c]); ST[i] = tsh[c]; } }
    v2u xq[3][4];
#pragma unroll
    for (int r = 0; r < 3; ++r) { const int rr = (r < rpw) ? r : rpw - 1;
#pragma unroll
        for (int j = 0; j < 4; ++j) xq[r][j] = *(const GAS v2u*)(XB + (size_t)(row_base + rr) * D + 4 * F.lane + 256 * j); }
    __syncthreads();
    for (int g0 = 0; g0 < rpw; g0 += 3) {
        int lane_ = F.lane; asm volatile("" : "+v"(lane_));
        const int lane = lane_;
        f32x4 hx[3][4]; int rws[3]; bool vld[3];
#pragma unroll
        for (int r = 0; r < 3; ++r) {
            const int rr = (g0 + r < rpw) ? g0 + r : rpw - 1; rws[r] = row_base + rr; vld[r] = (g0 + r < rpw);
#pragma unroll
            for (int j = 0; j < 4; ++j) { const v2u a = xq[r][j];
                hx[r][j] = (f32x4){__builtin_bit_cast(float, a.x << 16), __builtin_bit_cast(float, a.x & 0xffff0000u), __builtin_bit_cast(float, a.y << 16), __builtin_bit_cast(float, a.y & 0xffff0000u)}; } }
        if (g0 + 3 < rpw) {
#pragma unroll
            for (int r = 0; r < 3; ++r) { const int rr = (g0 + 3 + r < rpw) ? g0 + 3 + r : rpw - 1;
#pragma unroll
                for (int j = 0; j < 4; ++j) xq[r][j] = *(const GAS v2u*)(XB + (size_t)(row_base + rr) * D + 4 * lane + 256 * j); } }
#pragma unroll
        for (int r = 0; r < 3; ++r) { const int row = rws[r]; float ss = 0.f;
#pragma unroll
            for (int j = 0; j < 4; ++j) ss += (hx[r][j].x * hx[r][j].x + hx[r][j].y * hx[r][j].y) + (hx[r][j].z * hx[r][j].z + hx[r][j].w * hx[r][j].w);
            const float rinv = rsqrtf(wave_sum(ss) * (1.f / D) + 1e-6f);
            const int ti = variant_of_row(row) == v0 ? 0 : 1024;
#pragma unroll
            for (int j = 0; j < 4; ++j) { const int c0 = 4 * lane + 256 * j;
                const f32x4 gt = *(const LAS f32x4*)(GT + ti + c0), sh = *(const LAS f32x4*)(ST + ti + c0);
                const f32x4 h = hx[r][j] * rinv * gt + sh; hx[r][j] = h;
                if (vld[r]) { v2u o; o.x = pk2(h.x, h.y); o.y = pk2(h.z, h.w); *(GAS v2u*)(H + (size_t)row * D + c0) = o; } }
        }
#pragma unroll
        for (int r = 0; r < 3; ++r)
#pragma unroll
            for (int j = 0; j < 4; ++j) asm volatile("" : "+v"(hx[r][j]));
        typedef float f32x2 __attribute__((ext_vector_type(2)));
        float acc[3][16];
#pragma unroll
        for (int e = 0; e < 16; ++e) {
            f32x2 a2[3] = {{0.f, 0.f}, {0.f, 0.f}, {0.f, 0.f}};
#pragma unroll
            for (int j = 0; j < 4; ++j) { const f32x4 w = *(const LAS f32x4*)(WRT + e * WRS + 4 * lane + 256 * j); const f32x2 wl = {w.x, w.y}, wh = {w.z, w.w};
#pragma unroll
                for (int r = 0; r < 3; ++r) { const f32x2 xl = {hx[r][j].x, hx[r][j].y}, xh = {hx[r][j].z, hx[r][j].w}; a2[r] = __builtin_elementwise_fma(xl, wl, a2[r]); a2[r] = __builtin_elementwise_fma(xh, wh, a2[r]); } }
#pragma unroll
            for (int r = 0; r < 3; ++r) acc[r][e] = a2[r].x + a2[r].y;
            asm volatile("" : "+v"(acc[0][e]), "+v"(acc[1][e]), "+v"(acc[2][e]) :: "memory");
        }
        float tot3[3];
#pragma unroll
        for (int r = 0; r < 3; ++r) tot3[r] = reduce16(acc[r], lane);
        { const int q = lane >> 4, e = lane & 15, g = e >> 2, jp = e & 3;
          const float val = q == 0 ? tot3[0] : (q == 1 ? tot3[1] : tot3[2]);
          const float sg = sigmoid_f(val), sb = sg + rb_lane;
          const float va = DPPF(sb, 0x4E), vb = DPPF(sb, 0xB1), vc = DPPF(sb, 0x1B);
          const float hi1 = fmaxf(sb, va), lo1 = fminf(sb, va), hi2 = fmaxf(vb, vc), lo2 = fminf(vb, vc);
          const float gs = fmaxf(hi1, hi2) + fmaxf(fminf(hi1, hi2), fmaxf(lo1, lo2));
          const float gb = DPPF(gs, 0x141), gc = DPPF(gs, 0x140), ga = DPPF(gb, 0x140);
          float bestv = gs; int bestg = g;
          { const int ia = g ^ 2; if (ga > bestv || (ga == bestv && ia < bestg)) { bestv = ga; bestg = ia; } }
          { const int ib = g ^ 1; if (gb > bestv || (gb == bestv && ib < bestg)) { bestv = gb; bestg = ib; } }
          { const int ic = g ^ 3; if (gc > bestv || (gc == bestv && ic < bestg)) { bestv = gc; bestg = ic; } }
          const int rank = ((va > sb || (va == sb && (jp ^ 2) < jp)) ? 1 : 0) + ((vb > sb || (vb == sb && (jp ^ 1) < jp)) ? 1 : 0) + ((vc > sb || (vc == sb && (jp ^ 3) < jp)) ? 1 : 0);
          if (q < 3 && g == bestg && rank < 2) { LGS[((F.wave * 3 + q) * 2 + rank) * 2] = __builtin_bit_cast(float, e); LGS[((F.wave * 3 + q) * 2 + rank) * 2 + 1] = sg; } }
        LDS_WAIT(); asm volatile("" ::: "memory");
        if ((lane & 15) == 0 && (lane >> 4) < 3 && g0 + (lane >> 4) < rpw) { const int q = lane >> 4;
            const LAS float* sl = LGS + (F.wave * 3 + q) * 4;
            const int e0 = __builtin_bit_cast(int, sl[0]), e1 = __builtin_bit_cast(int, sl[2]); const float s0 = sl[1], s1 = sl[3];
            const int rl = F.wave * rpw + g0 + q, row = F.bid * rpb + rl;
            const float wsum = s0 + s1;
            WTS[row * 2] = s0 / wsum; WTS[row * 2 + 1] = s1 / wsum;
            const int p0 = __hip_atomic_fetch_add(CNT + e0, 1, __ATOMIC_RELAXED, __HIP_MEMORY_SCOPE_WORKGROUP);
            const int p1 = __hip_atomic_fetch_add(CNT + e1, 1, __ATOMIC_RELAXED, __HIP_MEMORY_SCOPE_WORKGROUP);
            ASG[rl * 4 + 0] = e0; ASG[rl * 4 + 1] = p0; ASG[rl * 4 + 2] = e1; ASG[rl * 4 + 3] = p1;
        }
        LDS_WAIT(); asm volatile("" ::: "memory");
    }
    __syncthreads();
    gu32* ecnt = (gu32*)(ws + WS_CTL) + CW_ECNT + l * NE * 64;
    if (F.tid < NE) BASE[F.tid] = (int)__hip_atomic_fetch_add(ecnt + F.tid * 64, (unsigned)CNT[F.tid], __ATOMIC_RELAXED, __HIP_MEMORY_SCOPE_AGENT);
    __syncthreads();
    int* LIST = (int*)(ws + WS_LIST); int* TOK = (int*)(ws + WS_TOK);
    if (F.tid < rpb) { const int row = F.bid * rpb + F.tid;
#pragma unroll
        for (int k = 0; k < 2; ++k) { const int e = ASG[F.tid * 4 + 2 * k], p = ASG[F.tid * 4 + 2 * k + 1] + BASE[e]; LIST[e * NT + p] = row; TOK[row * 2 + k] = e | (p << 4); } }
}
enum { PH_PRO = 0, PH_N1 = 0, PH_GIN = 1, PH_G1 = 2, PH_G2 = 3, PH_G3 = 4, PH_GOUT = 5, PH_R2 = 6, PH_GUP = 7, PH_GDN = 8, PH_PER_LAYER = 9, PH_FINAL = 1 + 9 * DEPTH, PH_END = PH_FINAL + 1 };

__global__ void __launch_bounds__(NTHR, 2) mega_fwd(Args args_unused) {
    LAS unsigned char* const lds = (LAS unsigned char*)lds_raw;
    volatile LAS unsigned* MISC = (volatile LAS unsigned*)(lds + MISC_OFF);
    for (int u = threadIdx.x; u < (LDS_BYTES - LDSCTL_OFF) / 4; u += NTHR) ((LAS unsigned*)(lds + LDSCTL_OFF))[u] = 0u;
    __syncthreads();
    int lo, hi; bool comb_en; unsigned* barw;
    bool probe16;
    { KArgs A = kargs(); lo = A->ph_lo; hi = A->ph_hi; comb_en = (A->flags & 1) != 0; probe16 = (A->flags & 16) != 0; if (probe16) comb_en = true; barw = (unsigned*)(A->ws + WS_CTL) + CW_BAR; }
    const bool multi = (hi - lo) > 1;
    XcdBarrier bar; bar.bar = barw; bar.x = 0; bar.st = nullptr;
    if (multi) bar = xcd_barrier_post(barw, MISC + 8);
    for (int ph = lo; ph < hi; ++ph) {
        if (ph == PH_PRO) {
            p0_prologue();
        } else if (ph == PH_FINAL) {
            rowpass_n1<true, false>(DEPTH, comb_en, NX, false);
        } else {
            const int l = (ph - 1) / PH_PER_LAYER, s = (ph - 1) % PH_PER_LAYER;
            const bool keep = l < DEPTH - 1;
            if (s == PH_N1) {
                if (l > 0) convert_from_cursor(l, -1);
                if (l == 0 && !probe16) rowpass_n1<false, true>(l, false, NT, false); else rowpass_n1<false, false>(l, comb_en && l > 0, NT, probe16);
            } else if (s == PH_GIN || s == PH_GOUT || s == PH_GUP || s == PH_GDN) {
                KArgs A = kargs(); unsigned char* const ws = A->ws;
                const LAS int* tab = (const LAS int*)(lds + LDSCTL_OFF);
                pg8::GCfg S; S.list = (const int*)(ws + WS_LIST); S.tab = tab; S.amode = 0; S.bmode = 0; S.bexp = 0; S.K = D; S.Abase = (const char*)(ws + WS_HB);
                S.O = nullptr; S.ldc = 0; S.xl = nullptr; S.xc = nullptr; S.MODl = nullptr; S.gidx = 0; S.gscale = (A->flags & 8) ? 0.f : 1.f;
                int nM, nN;
                if (s == PH_GIN) { nM = NT / 256; nN = PLD / 256; S.Bbase = (const char*)(ws + WS_WIN) + (size_t)l * PLD * D * 2; S.emode = 0; S.O = (bf16_t*)(ws + WS_P); S.ldc = PLD; }
                else if (s == PH_GOUT) { nM = (keep ? NT : NX) / 256; nN = D / 256; S.Bbase = (const char*)(ws + WS_WOUT) + (size_t)l * D * D * 2; S.emode = 1;
                    S.O = (bf16_t*)(ws + WS_XB); S.MODl = (const float*)(ws + WS_MOD) + (size_t)l * 9 * 6144; S.gidx = 2; }
                else {
                    { LAS int* t = (LAS int*)(lds + LDSCTL_OFF); const gu32* ec = (const gu32*)(ws + WS_CTL) + CW_ECNT + l * NE * 64;
                      if (threadIdx.x < NE) t[32 + threadIdx.x] = (int)__hip_atomic_load(ec + threadIdx.x * 64, RLX_AGENT);
                      __syncthreads();
                      if (threadIdx.x == 0) { int run = 0; for (int e = 0; e < NE; ++e) { t[e] = run; run += (t[32 + e] + 255) >> 8; } t[16] = run; }
                      __syncthreads(); }
                    nM = tab[16]; nN = 4; S.bmode = 1;
                    if (s == PH_GUP) { S.amode = 1; S.Bbase = (const char*)(ws + WS_W13) + (size_t)l * NE * 1024 * D * 2; S.bexp = (size_t)1024 * D * 2; S.emode = 2; S.O = (bf16_t*)(ws + WS_HID); S.ldc = DE; }
                    else { S.K = DE; S.Abase = (const char*)(ws + WS_HID); S.Bbase = (const char*)(ws + WS_W2) + (size_t)l * NE * D * DE * 2; S.bexp = (size_t)D * DE * 2; S.emode = 0; S.O = (bf16_t*)(ws + WS_P); S.ldc = D; }
                }
                S.T.init(nM, nN, gridDim.x, blockIdx.x);
                pg8::gemm_phase(lds, S);
                if (keep) {
                    const int nwg = nM * nN, G = (int)gridDim.x, c = (int)blockIdx.x;
                    const int rounds = (nwg + G - 1) / G, mine = c < nwg ? (nwg - c + G - 1) / G : 0;
                    if (mine < rounds) convert_from_cursor(l + 1, s == PH_GDN ? 2 : 3);
                }
            }
#ifdef HAVE_GLA
            else if (s == PH_G1) { gla_phase1(l); }
            else if (s == PH_G2) { gla_phase2(l); }
            else if (s == PH_G3) { gla_phase3(l); }
#endif
#ifdef HAVE_MOE
            else if (s == PH_R2) { router_phase(l, keep ? NT : NX); }
#endif
        }
        if (ph + 1 < hi) {
            xcd_barrier(bar);
#ifdef PROBE_BAR2
            xcd_barrier(bar);
#endif
        }
    }
}

static bool g_init_done = false;
static void launch_mega(const In& I, float* out, unsigned char* ws, int lo, int hi, int flags, hipStream_t st) {
    if (!g_init_done) { (void)hipFuncSetAttribute((const void*)mega_fwd, hipFuncAttributeMaxDynamicSharedMemorySize, LDS_BYTES); g_init_done = true; }
    Args a{}; a.in = I; a.out = out; a.ws = ws; a.ph_lo = lo; a.ph_hi = hi; a.flags = flags; a.pad = 0;
    hipLaunchKernelGGL(mega_fwd, dim3(256), dim3(NTHR), LDS_BYTES, st, a);
}

#ifndef FUSED
#ifndef OPT_PRO
#define OPT_PRO 1
#endif
#ifndef OPT_A
#define OPT_A 1
#endif
#ifndef OPT_B
#define OPT_B 0
#endif
#ifndef OPT_C
#define OPT_C 1
#endif
#ifndef OPT_D
#define OPT_D 0
#endif
static void run_hybrid(const In& I, float* out, unsigned char* ws, hipStream_t st) {
    float* xc = (float*)(ws + WS_XC); float* MOD = (float*)(ws + WS_MOD); bf16_t* HB = (bf16_t*)(ws + WS_HB); bf16_t* P = (bf16_t*)(ws + WS_P);
    float* OF = (float*)(ws + WS_KVS); float* OB = (float*)(ws + WS_HID); float* HIDN = (float*)(ws + WS_P);
    int* EIDX = (int*)(ws + WS_NEIDX); float* WTSN = (float*)(ws + WS_NWTS);
    (void)hipMemsetAsync(ws + WS_CTL, 0, CTL_BYTES, st);
    const int flags = OPT_D ? 1 : 0;
    if (OPT_PRO) launch_mega(I, out, ws, PH_PRO, PH_PRO + 1, flags, st);
    else nv::k_mod<<<(DEPTH * 6144 + 255) / 256, 256, 0, st>>>(I.c, I.c_ctx, I.w_mod, I.b_mod, MOD);
    if (!OPT_A) { (void)hipMemcpyAsync(out, I.x, (size_t)NX * D * 4, hipMemcpyDeviceToDevice, st); (void)hipMemcpyAsync(xc, I.ctx, (size_t)NC * D * 4, hipMemcpyDeviceToDevice, st); }
    for (int l = 0; l < DEPTH; ++l) {
        const bool keep = l < DEPTH - 1; const int Mo = keep ? NT : NX;
        const float* MODl = MOD + (size_t)l * 9 * 6144;
        const int pb = 1 + l * PH_PER_LAYER;
        if (OPT_A) { launch_mega(I, out, ws, pb + PH_N1, pb + PH_N1 + 1, flags, st); launch_mega(I, out, ws, pb + PH_GIN, pb + PH_GIN + 1, flags, st); }
        else {
            if (OPT_D && l > 0) launch_mega(I, out, ws, pb + PH_N1, pb + PH_N1 + 1, flags, st);
            nv::k_normmod<<<NT, 256, 0, st>>>(out, xc, I.norm1 + l * D, MODl, 0, 1, HB, NT);
            nv::k_gemm<<<dim3((INW + 63) / 64, NT / 64), 256, 0, st>>>(HB, D, I.w_in + (size_t)l * D * INW, INW, P, PLD, NT, INW, D, 0, nullptr, 0, nullptr, nullptr, 512, 768);
        }
        if (OPT_B) { for (int s = PH_G1; s <= PH_G3; ++s) launch_mega(I, out, ws, pb + s, pb + s + 1, flags, st); }
        else {
            nv::k_gla<<<NB * 4, 256, 0, st>>>(P, I.w_gk2 + (size_t)l * 2 * 16 * 256, I.b_gk + (size_t)l * 2 * 256, OF, OB);
            nv::k_pool<<<NT, 512, 0, st>>>(P, I.w_pool + (size_t)l * 4 * 128 * 128, I.pool_scale + l * 512, HB);
            nv::k_glaout<<<NT, 512, 0, st>>>(P, OF, OB, I.gla_gain + l * 128, HB);
        }
        if (OPT_C) launch_mega(I, out, ws, pb + PH_GOUT, pb + PH_GOUT + 1, flags, st);
        else nv::k_gemm<<<dim3(D / 64, Mo / 64), 256, 0, st>>>(HB, D, I.w_out + (size_t)l * D * D, D, nullptr, 0, Mo, D, D, 1, MODl, 2, out, xc, 0, 0);
        if (OPT_D) { for (int s = PH_R2; s <= PH_GDN; ++s) launch_mega(I, out, ws, pb + s, pb + s + 1, flags, st); }
        else {
            nv::k_normmod<<<Mo, 256, 0, st>>>(out, xc, I.norm2 + l * D, MODl, 3, 4, HB, Mo);
            nv::k_router<<<Mo, 64, 0, st>>>(out, xc, I.norm2 + l * D, MODl, I.w_router, I.router_bias, EIDX, WTSN, Mo);
            nv::k_moe_up<<<Mo * 2, 512, 0, st>>>(HB, EIDX, I.w1 + (size_t)l * NE * D * DE, I.w3 + (size_t)l * NE * D * DE, HIDN);
            nv::k_moe_down_combine<<<Mo, 256, 0, st>>>(HIDN, EIDX, WTSN, I.w2 + (size_t)l * NE * DE * D, MODl, out, xc);
        }
    }
    if (OPT_D) launch_mega(I, out, ws, PH_FINAL, PH_FINAL + 1, flags, st);
    else nv::k_final<<<NX, 256, 0, st>>>(out, I.norm_f);
}

#endif
extern "C" void kernel_launch(void* const* d_in, const int* in_sizes, int n_in, void* d_out, int out_size, void* d_ws, size_t ws_size, hipStream_t stream) {
    In I;
    const float** f = (const float**)&I;
    for (int i = 0; i < 21; ++i) f[i] = (const float*)d_in[i];
    if (ws_size < WS_END) { fprintf(stderr, "ws too small: %zu < %zu\n", ws_size, (size_t)WS_END); return; }
#ifdef FUSED
    (void)hipMemsetAsync((unsigned char*)d_ws + WS_CTL, 0, CTL_BYTES, stream);
    launch_mega(I, (float*)d_out, (unsigned char*)d_ws, 0, PH_END, 1, stream);
#ifndef PROBE_FLAGS
#define PROBE_FLAGS 0
#endif
#ifdef PROBE_KIND
    if (PROBE_KIND < 0) launch_mega(I, (float*)d_out, (unsigned char*)d_ws, PH_PRO, PH_PRO + 1, 0, stream);
    else for (int l = 0; l < DEPTH; ++l) launch_mega(I, (float*)d_out, (unsigned char*)d_ws, 1 + l * PH_PER_LAYER + PROBE_KIND, 1 + l * PH_PER_LAYER + PROBE_KIND + 1, PROBE_FLAGS, stream);
#endif
#else
    run_hybrid(I, (float*)d_out, (unsigned char*)d_ws, stream);
#endif
}
```

```cpp
#define FUSED 1
#include <hip/hip_runtime.h>
#include <cstdio>
#include <cstdint>
typedef unsigned short bf16_t;
constexpr int D = 1024, NB = 8, SEQ = 2048, DEPTH = 4, CTXL = 256;
constexpr int NX = NB * SEQ, NC = NB * CTXL, NT = NX + NC;
constexpr int INW = 2080, PLD = 2304, NE = 16, DE = 512;
constexpr int NCH = 36;
constexpr int MAXSLOT = 41216;
constexpr size_t MiB = 1u << 20;
constexpr size_t WS_CTL = 0, CTL_BYTES = 1 * MiB;
constexpr size_t WS_MOD = 1 * MiB;
constexpr size_t WS_WPOOL = 2 * MiB;
constexpr size_t WS_WGP = 2 * MiB + 512 * 1024;
constexpr size_t WS_WRP = 2 * MiB + 640 * 1024;
constexpr size_t WS_TOK = 3 * MiB;
constexpr size_t WS_WTS = 3 * MiB + 256 * 1024;
constexpr size_t WS_NEIDX = 3 * MiB + 512 * 1024;
constexpr size_t WS_NWTS = 3 * MiB + 768 * 1024;
constexpr size_t WS_LIST = 4 * MiB;
constexpr size_t WS_WIN = 6 * MiB;
constexpr size_t WS_WOUT = 24 * MiB;
constexpr size_t WS_W13 = 32 * MiB;
constexpr size_t WS_W2 = 160 * MiB;
constexpr size_t WS_XC = 224 * MiB;
constexpr size_t WS_HB = 232 * MiB;
constexpr size_t WS_P = 268 * MiB;
constexpr size_t WS_KVS = 349 * MiB;
constexpr size_t WS_ADEC = 385 * MiB;
constexpr size_t WS_HID = 386 * MiB;
constexpr size_t WS_XB = 427 * MiB;
constexpr size_t WS_END = 463 * MiB;

struct In {
    const float *x, *c, *ctx, *c_ctx, *w_mod, *b_mod, *norm1, *norm2, *w_in, *w_gk2, *b_gk, *w_pool, *pool_scale, *gla_gain, *w_out, *w_router, *router_bias, *w1, *w3, *w2, *norm_f;
};

__host__ __device__ __forceinline__ unsigned f2bf(float f) { unsigned u = __builtin_bit_cast(unsigned, f); return (u + 0x7fffu + ((u >> 16) & 1u)) >> 16; }
__host__ __device__ __forceinline__ float bf2f(bf16_t h) { return __builtin_bit_cast(float, (unsigned)h << 16); }
typedef float pk2_f32x2 __attribute__((ext_vector_type(2)));
typedef __bf16 pk2_bf16x2 __attribute__((ext_vector_type(2)));
__device__ __forceinline__ unsigned pk2(float lo, float hi) { const pk2_f32x2 v = {lo, hi}; return __builtin_bit_cast(unsigned, __builtin_convertvector(v, pk2_bf16x2)); }
__device__ __forceinline__ float silu_f(float x) { return x / (1.f + expf(-x)); }
__device__ __forceinline__ float sigmoid_f(float x) { return 1.f / (1.f + expf(-x)); }
__device__ __forceinline__ float logsigmoid_f(float x) { return fminf(x, 0.f) - log1pf(expf(-fabsf(x))); }
__device__ __forceinline__ int variant_of_row(int row) { return row < NX ? (row >> 11) : 8; }
__device__ __forceinline__ float* resid_row(float* xl, float* xc, int row) { return row < NX ? xl + (size_t)row * D : xc + (size_t)(row - NX) * D; }
__device__ __forceinline__ int chunk_row0(int b, int j) { return j < 4 ? NX + b * CTXL + j * 64 : b * SEQ + (j - 4) * 64; }
#define GAS __attribute__((address_space(1)))
#define LAS __attribute__((address_space(3)))
typedef unsigned v4u __attribute__((ext_vector_type(4)));
typedef unsigned v2u __attribute__((ext_vector_type(2)));
typedef float f32x4 __attribute__((ext_vector_type(4)));
typedef float f32x16 __attribute__((ext_vector_type(16)));
typedef short bf16x8 __attribute__((ext_vector_type(8)));
typedef GAS unsigned gu32;
#define RLX_AGENT __ATOMIC_RELAXED, __HIP_MEMORY_SCOPE_AGENT
#define LDS_WAIT() asm volatile("s_waitcnt lgkmcnt(0)" ::: "memory")
#define VM_WAIT() asm volatile("s_waitcnt vmcnt(0)" ::: "memory")
constexpr int NWAVES = 8, NTHR = 512;
constexpr int RING_BYTES = 131072;
constexpr int LDSCTL_OFF = RING_BYTES, MISC_OFF = LDSCTL_OFF + 320;
constexpr int LDS_BYTES = 147456;
constexpr int CW_BAR = 4096;
constexpr int CW_ECNT = 8192;
constexpr int CW_CVT = 16384;

__device__ __forceinline__ float wave_sum(float v) {
    v += __builtin_bit_cast(float, __builtin_amdgcn_update_dpp(0, __builtin_bit_cast(int, v), 0xB1, 0xF, 0xF, true));
    v += __builtin_bit_cast(float, __builtin_amdgcn_update_dpp(0, __builtin_bit_cast(int, v), 0x4E, 0xF, 0xF, true));
    v += __builtin_bit_cast(float, __builtin_amdgcn_update_dpp(0, __builtin_bit_cast(int, v), 0x141, 0xF, 0xF, true));
    v += __builtin_bit_cast(float, __builtin_amdgcn_update_dpp(0, __builtin_bit_cast(int, v), 0x140, 0xF, 0xF, true));
    const int iv = __builtin_bit_cast(int, v);
    const float r0 = __builtin_bit_cast(float, __builtin_amdgcn_readlane(iv, 0)), r1 = __builtin_bit_cast(float, __builtin_amdgcn_readlane(iv, 16));
    const float r2 = __builtin_bit_cast(float, __builtin_amdgcn_readlane(iv, 32)), r3 = __builtin_bit_cast(float, __builtin_amdgcn_readlane(iv, 48));
    return (r0 + r1) + (r2 + r3);
}

#define XB_TMO      128
#define XB_XCNT(j)  (256  + 64 * (j))
#define XB_XSUB(j)  (1280 + 64 * (j))
#define XB_XGEN(j)  (2304 + 64 * (j))
#define XB_TOP      3328
#define XB_TOPGEN   3392
#define XCD_BAR_WORDS 3456
#define XB_SPIN_CAP (1u << 18)
__device__ __forceinline__ unsigned xb_ld(unsigned* p)              { return __hip_atomic_load(p, __ATOMIC_RELAXED, __HIP_MEMORY_SCOPE_AGENT); }
__device__ __forceinline__ unsigned xb_add(unsigned* p, unsigned v) { return __hip_atomic_fetch_add(p, v, __ATOMIC_RELAXED, __HIP_MEMORY_SCOPE_AGENT); }
__device__ __forceinline__ unsigned xb_xcc_id() { return (unsigned)__builtin_amdgcn_s_getreg((3 << 11) | 20) & 0xFu; }
#define XB_SPIN(cond, bar) do { unsigned _sp = 0; while (cond) { __builtin_amdgcn_s_sleep(1); \
    if ((++_sp & 255u) == 0u) { if (xb_ld(&(bar)[XB_TMO])) break; if (_sp > XB_SPIN_CAP) { atomicAdd(&(bar)[XB_TMO], 1u); break; } } } } while (0)
struct XcdBarrier { unsigned* bar; unsigned x; volatile LAS unsigned* st; };
__device__ __forceinline__ XcdBarrier xcd_barrier_post(unsigned* bar, volatile LAS unsigned* st) {
    XcdBarrier b; b.bar = bar; b.x = xb_xcc_id(); b.st = st;
    if (threadIdx.x == 0) (void)xb_add(&bar[XB_XCNT(b.x)], 1u);
    return b;
}
__device__ __forceinline__ void xcd_barrier(const XcdBarrier& b) {
    asm volatile("s_waitcnt vmcnt(0)" ::: "memory");
    __syncthreads();
    if (threadIdx.x < 64 && b.st[0] == 0u) {
        unsigned* bar = b.bar; const unsigned G = gridDim.x * gridDim.y * gridDim.z; const int lane = threadIdx.x; unsigned sp = 0u, c, sum, cnt;
        for (;;) {
            c = lane < 16 ? xb_ld(&bar[XB_XCNT(lane)]) : 0u; sum = c; cnt = c > 0u ? 1u : 0u;
#pragma unroll
            for (int o = 1; o < 16; o <<= 1) { sum += __shfl_xor(sum, o); cnt += __shfl_xor(cnt, o); }
            sum = __builtin_amdgcn_readfirstlane(sum); cnt = __builtin_amdgcn_readfirstlane(cnt);
            if (sum == G) break;
            __builtin_amdgcn_s_sleep(1);
            if ((++sp & 255u) == 0u) { if (__builtin_amdgcn_readfirstlane(xb_ld(&bar[XB_TMO]))) break; if (sp > XB_SPIN_CAP) { if (lane == 0) atomicAdd(&bar[XB_TMO], 1u); break; } }
        }
        const unsigned mine = __builtin_amdgcn_readlane(c, b.x);
        if (lane == 0) { b.st[0] = mine > 0u ? mine : 1u; b.st[1] = cnt > 0u ? cnt : 1u; }
        asm volatile("s_waitcnt lgkmcnt(0)" ::: "memory");
    }
    if (threadIdx.x == 0) {
        unsigned* bar = b.bar;
        __builtin_amdgcn_s_waitcnt(0);
        const unsigned nloc = b.st[0], nx = b.st[1];
        const unsigned old = xb_add(&bar[XB_XSUB(b.x)], 1u);
        const unsigned gen = old / nloc;
        if (old + 1u == (gen + 1u) * nloc) {
            __builtin_amdgcn_fence(__ATOMIC_RELEASE, "agent");
            asm volatile("s_waitcnt vmcnt(0)" ::: "memory");
            const unsigned og = xb_add(&bar[XB_TOP], 1u);
            const unsigned tg = og / nx;
            if (og + 1u == (tg + 1u) * nx) xb_add(&bar[XB_TOPGEN], 1u);
            else XB_SPIN(xb_ld(&bar[XB_TOPGEN]) == tg, bar);
            __builtin_amdgcn_fence(__ATOMIC_ACQUIRE, "agent");
            xb_add(&bar[XB_XGEN(b.x)], 1u);
            asm volatile("s_waitcnt vmcnt(0)" ::: "memory");
        } else {
            XB_SPIN(xb_ld(&bar[XB_XGEN(b.x)]) == gen, bar);
            __builtin_amdgcn_fence(__ATOMIC_ACQUIRE, "agent");
            asm volatile("s_waitcnt vmcnt(0)" ::: "memory");
        }
    }
    __syncthreads();
}

namespace pg8 {
constexpr int BM = 256, BK = 64, HALF = 128, HTB = HALF * BK * 2, STAGE_BYTES = 8 * HTB, NXCD = 8, WGM = 8;
__host__ __device__ __forceinline__ int lds_byte(int r, int c) { const int st = (r >> 4) * 2 + (c >> 5), rr = r & 15, cc = c & 31, ob = rr * 64 + cc * 2; return st * 1024 + (ob ^ (((ob >> 9) & 1) << 5)); }
__host__ __device__ __forceinline__ void stage_rc(int b, int& R, int& C) { const int st = b / 1024, sb = b % 1024, swz = sb ^ (((sb >> 9) & 1) << 5); R = (st >> 1) * 16 + swz / 64; C = (st & 1) * 32 + (swz % 64) / 2; }
__host__ __device__ __forceinline__ int perm32(int rho) { const int n = rho >> 4, i = rho & 15; return 8 * (i >> 2) + 4 * n + (i & 3); }

struct Unit { int pm, pn, e, ti; };

struct TileOrder {
    int nM, nN, nwg, G, c;
    __device__ void init(int nM_, int nN_, int G_, int c_) { nM = nM_; nN = nN_; nwg = nM * nN; G = G_; c = c_; }
    __device__ bool tile(int i, int& pm, int& pn) const {
        const long L = (long)i * G + c; if (L >= nwg) return false;
        int wgid = (int)L; { const int q = nwg / NXCD, r = nwg % NXCD, xcd = wgid % NXCD, off = wgid / NXCD; wgid = (xcd < r ? xcd * (q + 1) : r * (q + 1) + (xcd - r) * q) + off; }
        const int nig = WGM * nN, gid = wgid / nig, fm = gid * WGM, gsz = (nM - fm) < WGM ? (nM - fm) : WGM;
        pm = fm + ((wgid % nig) % gsz); pn = (wgid % nig) / gsz; return true;
    }
};
struct GCfg {
    TileOrder T; const char* Abase; const char* Bbase; int K; int amode, bmode; size_t bexp; const int* list; const LAS int* tab;
    int emode;
    bf16_t* O; int ldc;
    float* xl; float* xc; const float* MODl; int gidx; float gscale;
    __device__ __forceinline__ void units_of_lane(int i, int& upk, int& epk) const {
        Unit u; u.e = 0; u.ti = 0; const bool ok = (i < 8) && T.tile(i, u.pm, u.pn);
        if (ok && bmode) { int e = 0;
#pragma unroll
            for (int j = 1; j < 16; ++j) e += (u.pm >= tab[j]) ? 1 : 0;
            u.e = e; u.ti = u.pm - tab[e]; }
        upk = ok ? (u.pm | (u.pn << 16)) : -1; epk = u.e | (u.ti << 16); }
    __device__ __forceinline__ bool next(int i, Unit& u, int upk_v, int epk_v) const {
        const int a = __builtin_amdgcn_readlane(upk_v, i), b = __builtin_amdgcn_readlane(epk_v, i);
        u.pm = a & 0xffff; u.pn = (a >> 16) & 0xffff; u.e = b & 0xffff; u.ti = (b >> 16) & 0xffff;
        return a >= 0; }
    __device__ __forceinline__ const char* b_base(const Unit& u) const { return Bbase + (size_t)u.e * bexp + (size_t)u.pn * BM * K * 2; }
    __device__ __forceinline__ void a_rows_to_lds(const Unit& u, int R0, int R1, LAS unsigned* slot, int lane) const {
        if (amode) { const int cnt = tab[32 + u.e]; const int* lp = list + u.e * NT; const int base = u.ti * BM;
            int p00 = base + R0, p01 = base + R1, p10 = base + HALF + R0, p11 = base + HALF + R1;
            p00 = p00 < cnt ? p00 : cnt - 1; p01 = p01 < cnt ? p01 : cnt - 1; p10 = p10 < cnt ? p10 : cnt - 1; p11 = p11 < cnt ? p11 : cnt - 1;
            __builtin_amdgcn_global_load_lds((const unsigned*)(lp + p00), slot, 4, 0, 0); __builtin_amdgcn_global_load_lds((const unsigned*)(lp + p01), slot + 64, 4, 0, 0);
            __builtin_amdgcn_global_load_lds((const unsigned*)(lp + p10), slot + 128, 4, 0, 0); __builtin_amdgcn_global_load_lds((const unsigned*)(lp + p11), slot + 192, 4, 0, 0);
        } else { const unsigned r = (unsigned)(u.pm * BM); slot[lane] = r + R0; slot[64 + lane] = r + R1; slot[128 + lane] = r + HALF + R0; slot[192 + lane] = r + HALF + R1; }
    }
    __device__ __forceinline__ unsigned a_off(const Unit& u, int h, int R, int C) const {
        if (amode) { const int cnt = tab[32 + u.e]; int pos = u.ti * BM + h * HALF + R; pos = pos < cnt ? pos : cnt - 1; const int src = list[u.e * NT + pos]; return (unsigned)((src * K + C) * 2); }
        return (unsigned)(((u.pm * BM + h * HALF + R) * K + C) * 2); }
    __device__ __forceinline__ bool perm() const { return emode != 2; }
    __device__ __forceinline__ void epi(const f32x4 (&acc)[2][2][4][2], const Unit& u, int wr, int wc, int fr, int fq) const {
        if (emode == 0) {
            const int row0 = u.pm * BM + wr * 64 + fr; const int col0 = u.pn * BM + wc * 32 + 8 * fq;
#pragma unroll
            for (int ai = 0; ai < 2; ++ai)
#pragma unroll
                for (int m = 0; m < 4; ++m) { bf16_t* rowp = O + (size_t)(row0 + ai * HALF + m * 16) * ldc + col0;
#pragma unroll
                    for (int bj = 0; bj < 2; ++bj) { const f32x4 v0 = acc[ai][bj][m][0], v1 = acc[ai][bj][m][1];
                        v4u w; w.x = pk2(v0[0], v0[1]); w.y = pk2(v0[2], v0[3]); w.z = pk2(v1[0], v1[1]); w.w = pk2(v1[2], v1[3]);
                        *(v4u*)(rowp + bj * HALF) = w; } }
        } else if (emode == 1) {
            const int rowt = u.pm * BM; const int v = rowt < NX ? (rowt >> 11) : 8;
            const float* gate = MODl + (size_t)v * 6144 + gidx * D; const float gsc = gscale;
            const int row0 = rowt + wr * 64 + fr; const int col0 = u.pn * BM + wc * 32 + 8 * fq;
            f32x4 gv[2][2];
#pragma unroll
            for (int bj = 0; bj < 2; ++bj)
#pragma unroll
                for (int n = 0; n < 2; ++n) gv[bj][n] = *(const f32x4*)(gate + col0 + bj * HALF + 4 * n) * gsc;
#pragma unroll
            for (int ai = 0; ai < 2; ++ai) {
                v4u xw[4][2];
#pragma unroll
                for (int m = 0; m < 4; ++m)
#pragma unroll
                    for (int bj = 0; bj < 2; ++bj) xw[m][bj] = *(const v4u*)(O + (size_t)(row0 + ai * HALF + m * 16) * D + col0 + bj * HALF);
#pragma unroll
                for (int m = 0; m < 4; ++m) { bf16_t* rowp = O + (size_t)(row0 + ai * HALF + m * 16) * D + col0;
#pragma unroll
                    for (int bj = 0; bj < 2; ++bj) { v4u* p = (v4u*)(rowp + bj * HALF); const v4u w = xw[m][bj];
                        const f32x4 x0 = {__builtin_bit_cast(float, w.x << 16), __builtin_bit_cast(float, w.x & 0xffff0000u), __builtin_bit_cast(float, w.y << 16), __builtin_bit_cast(float, w.y & 0xffff0000u)};
                        const f32x4 x1 = {__builtin_bit_cast(float, w.z << 16), __builtin_bit_cast(float, w.z & 0xffff0000u), __builtin_bit_cast(float, w.w << 16), __builtin_bit_cast(float, w.w & 0xffff0000u)};
                        const f32x4 y0 = x0 + gv[bj][0] * acc[ai][bj][m][0], y1 = x1 + gv[bj][1] * acc[ai][bj][m][1];
                        v4u o; o.x = pk2(y0[0], y0[1]); o.y = pk2(y0[2], y0[3]); o.z = pk2(y1[0], y1[1]); o.w = pk2(y1[2], y1[3]); *p = o; } }
            }
        } else {
            const int row0 = u.pm * BM + wr * 64 + fr; const int j0 = u.pn * 128 + wc * 32 + 8 * fq;
#pragma unroll
            for (int ai = 0; ai < 2; ++ai)
#pragma unroll
                for (int m = 0; m < 4; ++m) { float hv[8];
#pragma unroll
                    for (int bj = 0; bj < 2; ++bj)
#pragma unroll
                        for (int i = 0; i < 4; ++i) { const float a = acc[ai][bj][m][0][i], b = acc[ai][bj][m][1][i]; hv[bj * 4 + i] = a * b * __builtin_amdgcn_rcpf(1.f + __expf(-a)); }
                    v4u w; w.x = pk2(hv[0], hv[1]); w.y = pk2(hv[2], hv[3]); w.z = pk2(hv[4], hv[5]); w.w = pk2(hv[6], hv[7]);
                    *(v4u*)(O + (size_t)(row0 + ai * HALF + m * 16) * DE + j0) = w; }
        }
    }
};

__device__ __forceinline__ void gemm_phase(LAS unsigned char* lds, const GCfg& S) {
    const char* const Abase = S.Abase; const int K = S.K; const bool PERMB = S.perm();
    int tid_ = threadIdx.x; asm volatile("" : "+v"(tid_));
    const int tid = tid_, wid = __builtin_amdgcn_readfirstlane(tid >> 6), lane = tid & 63, wr = wid >> 2, wc = wid & 3, fr = lane & 15, fq = lane >> 4;
    const int nt = K / BK;
    int sR[2], sC[2]; unsigned voffB[2];
#pragma unroll
    for (int i = 0; i < 2; ++i) { stage_rc(tid * 16 + i * 8192, sR[i], sC[i]); const int Rb = PERMB ? ((sR[i] & ~31) + perm32(sR[i] & 31)) : sR[i]; voffB[i] = (unsigned)(Rb * K + sC[i]) * 2u; }
    const unsigned kstep = (unsigned)(BK * 2);
    const size_t hstepB = (size_t)HALF * K * 2;
    const unsigned ldsw = (unsigned)wid * 1024u;
    const int aoff = lds_byte(wr * 64 + fr, fq * 8), boff = lds_byte(wc * 32 + fr, fq * 8);
#define PG8_SA(b, h) (((b) * 2 + (h)) * HTB)
#define PG8_SB(b, h) ((4 + (b) * 2 + (h)) * HTB)
#define PG8_STAGE_B(bufoff, gbase) do { _Pragma("unroll") for (int _i = 0; _i < 2; ++_i) \
        __builtin_amdgcn_global_load_lds((const unsigned*)((const char*)(gbase) + voffB[_i]), (LAS unsigned*)(lds + (bufoff) + ldsw + _i * 8192), 16, 0, 0); } while (0)
#define PG8_STAGE_A(bufoff, o0, o1, kb) do { \
        __builtin_amdgcn_global_load_lds((const unsigned*)(Abase + (size_t)((o0) + (kb))), (LAS unsigned*)(lds + (bufoff) + ldsw), 16, 0, 0); \
        __builtin_amdgcn_global_load_lds((const unsigned*)(Abase + (size_t)((o1) + (kb))), (LAS unsigned*)(lds + (bufoff) + ldsw + 8192), 16, 0, 0); } while (0)
#define PG8_LDA(dst, b, h) do { _Pragma("unroll") for (int m = 0; m < 4; ++m) _Pragma("unroll") for (int k = 0; k < 2; ++k) dst[m][k] = *(const LAS bf16x8*)(lds + PG8_SA(b, h) + aoff + m * 2048 + k * 1024); } while (0)
#define PG8_LDB(dst, b, h) do { _Pragma("unroll") for (int n = 0; n < 2; ++n) _Pragma("unroll") for (int k = 0; k < 2; ++k) dst[n][k] = *(const LAS bf16x8*)(lds + PG8_SB(b, h) + boff + n * 2048 + k * 1024); } while (0)
#define PG8_MMA(ai, bj, At, Bt) do { __builtin_amdgcn_s_setprio(1); _Pragma("unroll") for (int m = 0; m < 4; ++m) _Pragma("unroll") for (int n = 0; n < 2; ++n) _Pragma("unroll") for (int k = 0; k < 2; ++k) \
        acc[ai][bj][m][n] = __builtin_amdgcn_mfma_f32_16x16x32_bf16(Bt[n][k], At[m][k], acc[ai][bj][m][n], 0, 0, 0); __builtin_amdgcn_s_setprio(0); } while (0)
#define PG8_WAIT_V(n) asm volatile("s_waitcnt vmcnt(" #n ")" ::: "memory")
#define PG8_WAIT_L(n) asm volatile("s_waitcnt lgkmcnt(" #n ")" ::: "memory")
#define PG8_BAR __builtin_amdgcn_s_barrier()
#define PG8_SCHED __builtin_amdgcn_sched_barrier(0)
    int upk_v, epk_v; S.units_of_lane(lane, upk_v, epk_v);
    Unit cur, nxt; int ui = 0;
    if (!S.next(0, cur, upk_v, epk_v)) return;
    f32x4 acc[2][2][4][2];
#pragma unroll
    for (int a = 0; a < 2; ++a)
#pragma unroll
        for (int b = 0; b < 2; ++b)
#pragma unroll
            for (int m = 0; m < 4; ++m)
#pragma unroll
                for (int n = 0; n < 2; ++n) acc[a][b][m][n] = (f32x4){0.f, 0.f, 0.f, 0.f};
    bf16x8 At[4][2], B0[2][2], B1[2][2];
    unsigned c00 = S.a_off(cur, 0, sR[0], sC[0]), c01 = S.a_off(cur, 0, sR[1], sC[1]), c10 = S.a_off(cur, 1, sR[0], sC[0]), c11 = S.a_off(cur, 1, sR[1], sC[1]);
    const char* cB = S.b_base(cur);
    PG8_STAGE_B(PG8_SB(0, 0), cB); PG8_STAGE_B(PG8_SB(0, 1), cB + hstepB); PG8_STAGE_A(PG8_SA(0, 0), c00, c01, 0u); PG8_STAGE_A(PG8_SA(0, 1), c10, c11, 0u);
    if (wr == 1) PG8_BAR;
    PG8_WAIT_V(2); PG8_BAR;
    PG8_STAGE_B(PG8_SB(1, 0), cB + kstep); PG8_STAGE_A(PG8_SA(1, 0), c00, c01, kstep); PG8_STAGE_B(PG8_SB(1, 1), cB + hstepB + kstep);
    PG8_WAIT_V(6); PG8_BAR;
    LAS unsigned* const nslot = (LAS unsigned*)(lds + LDSCTL_OFF + 1024) + wid * 256;
    for (;;) {
        const bool has_next = S.next(ui + 1, nxt, upk_v, epk_v);
        const char* nB = cB;
        if (has_next) {
            int t2 = tid; asm volatile("" : "+v"(t2)); int r0_, c0_, r1_, c1_; stage_rc(t2 * 16, r0_, c0_); stage_rc(t2 * 16 + 8192, r1_, c1_);
            S.a_rows_to_lds(nxt, r0_, r1_, nslot, lane); nB = S.b_base(nxt); }
        for (int t = 0; t < nt; t += 2) {
            const bool last = (t == nt - 2);
            const unsigned k1 = (unsigned)(t + 1) * kstep;
            const unsigned k2 = last ? 0u : (unsigned)(t + 2) * kstep, k3 = k2 + kstep;
            unsigned s00 = c00, s01 = c01, s10 = c10, s11 = c11;
            if (last && has_next) { int t3 = tid; asm volatile("" : "+v"(t3)); int r0_, c0_, r1_, c1_; stage_rc(t3 * 16, r0_, c0_); stage_rc(t3 * 16 + 8192, r1_, c1_);
                s00 = (nslot[lane] * (unsigned)K + c0_) * 2u; s01 = (nslot[64 + lane] * (unsigned)K + c1_) * 2u; s10 = (nslot[128 + lane] * (unsigned)K + c0_) * 2u; s11 = (nslot[192 + lane] * (unsigned)K + c1_) * 2u; }
            const char* b2 = last ? nB : cB + (size_t)(t + 2) * kstep; const char* b3 = b2 + kstep;
            const bool relax = (t == 0 && ui > 0);
            PG8_LDB(B0, 0, 0); PG8_LDB(B1, 0, 1); PG8_SCHED; PG8_LDA(At, 0, 0); PG8_STAGE_A(PG8_SA(1, 1), c10, c11, k1);
            if (relax) { if (S.emode == 2) PG8_WAIT_V(16); else PG8_WAIT_V(24); } else PG8_WAIT_V(8);
            PG8_WAIT_L(0); PG8_BAR; PG8_MMA(0, 0, At, B0); PG8_MMA(0, 1, At, B1); PG8_BAR; PG8_SCHED;
            PG8_LDA(At, 0, 1); PG8_STAGE_B(PG8_SB(0, 0), b2); PG8_STAGE_B(PG8_SB(0, 1), b2 + hstepB); PG8_STAGE_A(PG8_SA(0, 0), s00, s01, k2);
            if (relax) { if (S.emode == 2) PG8_WAIT_V(16); else PG8_WAIT_V(24); } else PG8_WAIT_V(8);
            PG8_WAIT_L(0); PG8_BAR; PG8_MMA(1, 0, At, B0); PG8_MMA(1, 1, At, B1); PG8_BAR; PG8_SCHED;
            PG8_LDB(B0, 1, 0); PG8_LDB(B1, 1, 1); PG8_SCHED; PG8_LDA(At, 1, 0); PG8_STAGE_A(PG8_SA(0, 1), s10, s11, k2);
            PG8_WAIT_V(8); PG8_WAIT_L(0); PG8_BAR; PG8_MMA(0, 0, At, B0); PG8_MMA(0, 1, At, B1); PG8_BAR; PG8_SCHED;
            PG8_LDA(At, 1, 1); PG8_STAGE_B(PG8_SB(1, 0), b3); PG8_STAGE_B(PG8_SB(1, 1), b3 + hstepB); PG8_STAGE_A(PG8_SA(1, 0), s00, s01, k3);
            PG8_WAIT_V(8); PG8_WAIT_L(0); PG8_BAR; PG8_MMA(1, 0, At, B0); PG8_MMA(1, 1, At, B1); PG8_BAR; PG8_SCHED;
        }
        if (wr == 0) PG8_BAR;
        S.epi(acc, cur, wr, wc, fr, fq);
        if (!has_next) break;
#pragma unroll
        for (int a = 0; a < 2; ++a)
#pragma unroll
            for (int b = 0; b < 2; ++b)
#pragma unroll
                for (int m = 0; m < 4; ++m)
#pragma unroll
                    for (int n = 0; n < 2; ++n) acc[a][b][m][n] = (f32x4){0.f, 0.f, 0.f, 0.f};
        { int t4 = tid; asm volatile("" : "+v"(t4)); int r0_, c0_, r1_, c1_; stage_rc(t4 * 16, r0_, c0_); stage_rc(t4 * 16 + 8192, r1_, c1_);
          c00 = (nslot[lane] * (unsigned)K + c0_) * 2u; c01 = (nslot[64 + lane] * (unsigned)K + c1_) * 2u; c10 = (nslot[128 + lane] * (unsigned)K + c0_) * 2u; c11 = (nslot[192 + lane] * (unsigned)K + c1_) * 2u; }
        cur = nxt; cB = nB; ++ui;
        if (wr == 1) PG8_BAR;
    }
    PG8_WAIT_V(0);
    PG8_BAR;
#undef PG8_SA
#undef PG8_SB
#undef PG8_STAGE_A
#undef PG8_STAGE_B
#undef PG8_LDA
#undef PG8_LDB
#undef PG8_MMA
#undef PG8_WAIT_V
#undef PG8_WAIT_L
#undef PG8_BAR
#undef PG8_SCHED
}
}
struct Args { In in; float* out; unsigned char* ws; int ph_lo, ph_hi, flags, pad; };
typedef const __attribute__((address_space(4))) Args* KArgs;
__device__ __forceinline__ KArgs kargs() { KArgs a = (KArgs)__builtin_amdgcn_kernarg_segment_ptr(); asm volatile("" : "+s"(a)); return a; }
struct Ctx {
    LAS unsigned char* lds; int tid, lane, wave, G, bid;
};
extern __shared__ __attribute__((aligned(16))) unsigned char lds_raw[];
__device__ __forceinline__ Ctx mkctx() { Ctx F; int t = threadIdx.x; asm volatile("" : "+v"(t)); F.lds = (LAS unsigned char*)lds_raw; F.tid = t; F.lane = t & 63; F.wave = __builtin_amdgcn_readfirstlane(t >> 6); F.G = gridDim.x; F.bid = blockIdx.x; return F; }

struct MapIdent { float qs; int qlo, qhi; __device__ __forceinline__ int row(int n) const { return n; } __device__ __forceinline__ float scale(int n) const { return (n >= qlo && n < qhi) ? qs : 1.f; } };
struct MapW13 { int sel; __device__ __forceinline__ int row(int j) const { return 256 * (j >> 7) + 128 * ((j >> 2) & 1) + 32 * ((j >> 5) & 3) + 16 * sel + 4 * ((j >> 3) & 3) + (j & 3); } __device__ __forceinline__ float scale(int) const { return 1.f; } };
template <bool DEEP, class Map>
__device__ __forceinline__ void transpose_item(const float* W, int ldn, int k0, int n0, bf16_t* WT, int ldk, LAS float* scr, int lane, const Map& map) {
    if (DEEP) {
        float ld[32];
#pragma unroll
        for (int i = 0; i < 32; ++i) ld[i] = W[(size_t)(k0 + 2 * i + (lane >> 5)) * ldn + n0 + (lane & 31)];
#pragma unroll
        for (int i = 0; i < 32; ++i) scr[(2 * i + (lane >> 5)) * 33 + (lane & 31)] = ld[i];
    } else {
#pragma unroll 8
        for (int i = 0; i < 32; ++i) { const int kk = 2 * i + (lane >> 5); scr[kk * 33 + (lane & 31)] = W[(size_t)(k0 + kk) * ldn + n0 + (lane & 31)]; }
    }
    LDS_WAIT(); asm volatile("" ::: "memory");
    const int c = lane & 7;
#pragma unroll
    for (int j = 0; j < 4; ++j) { const int n = (lane >> 3) + 8 * j; const LAS float* s = scr + (8 * c) * 33 + n; const float sc = map.scale(n0 + n);
        v4u o; o.x = pk2(s[0 * 33] * sc, s[1 * 33] * sc); o.y = pk2(s[2 * 33] * sc, s[3 * 33] * sc); o.z = pk2(s[4 * 33] * sc, s[5 * 33] * sc); o.w = pk2(s[6 * 33] * sc, s[7 * 33] * sc);
        *(GAS v4u*)(WT + (size_t)map.row(n0 + n) * ldk + k0 + 8 * c) = o; }
    LDS_WAIT(); asm volatile("" ::: "memory");
}

template <bool DEEP>
__device__ __forceinline__ void convert_layer_items(const Ctx& F, KArgs A, int l, int widx, int nw) {
    unsigned char* const ws = A->ws;
    LAS float* scr = (LAS float*)(F.lds + F.wave * 16384);
    bf16_t* WIN = (bf16_t*)(ws + WS_WIN) + (size_t)l * PLD * D; bf16_t* WOUT = (bf16_t*)(ws + WS_WOUT) + (size_t)l * D * D;
    bf16_t* W13 = (bf16_t*)(ws + WS_W13) + (size_t)l * NE * 1024 * D; bf16_t* W2 = (bf16_t*)(ws + WS_W2) + (size_t)l * NE * D * DE; bf16_t* WPL = (bf16_t*)(ws + WS_WPOOL) + (size_t)l * 4 * 128 * 128;
    constexpr int I_IN = 16 * 65, I_OUT = 16 * 32, I_W1 = NE * 256, I_W2 = NE * 256, I_PL = 4 * 8, I_Z = 224;
    constexpr int NITEMS = I_IN + I_OUT + 2 * I_W1 + I_W2 + I_PL + I_Z;
    for (int it = widx; it < NITEMS; it += nw) {
        int r = it;
        if (r < I_IN) { const int kb = r / 65, nb = r % 65;
            transpose_item<DEEP>(A->in.w_in + (size_t)l * D * INW, INW, kb * 64, nb * 32, WIN, D, scr, F.lane, MapIdent{0.125f, 512, 768}); continue; } r -= I_IN;
        if (r < I_OUT) { const int kb = r / 32, nb = r % 32;
            transpose_item<DEEP>(A->in.w_out + (size_t)l * D * D, D, kb * 64, nb * 32, WOUT, D, scr, F.lane, MapIdent{1.f, 0, 0}); continue; } r -= I_OUT;
        if (r < 2 * I_W1) { const int sel = r >= I_W1; if (sel) r -= I_W1; const int e = r / 256, q = r % 256, kb = q / 16, nb = q % 16;
            transpose_item<DEEP>((sel ? A->in.w3 : A->in.w1) + ((size_t)l * NE + e) * D * DE, DE, kb * 64, nb * 32, W13 + (size_t)e * 1024 * D, D, scr, F.lane, MapW13{sel}); continue; } r -= 2 * I_W1;
        if (r < I_W2) { const int e = r / 256, q = r % 256, kb = q / 32, nb = q % 32;
            transpose_item<DEEP>(A->in.w2 + ((size_t)l * NE + e) * DE * D, D, kb * 64, nb * 32, W2 + (size_t)e * D * DE, DE, scr, F.lane, MapIdent{1.f, 0, 0}); continue; } r -= I_W2;
        if (r < I_PL) { const int g = r / 8, q = r % 8, kb = q / 4, nb = q % 4;
            transpose_item<DEEP>(A->in.w_pool + ((size_t)l * 4 + g) * 128 * 128, 128, kb * 64, nb * 32, WPL + (size_t)g * 128 * 128, 128, scr, F.lane, MapIdent{1.f, 0, 0}); continue; } r -= I_PL;
        { const int row = INW + r; v4u z = {0u, 0u, 0u, 0u}; GAS v4u* p = (GAS v4u*)(WIN + (size_t)row * D) + F.lane; p[0] = z; p[64] = z; }
    }
}

__device__ __forceinline__ void convert_from_cursor(int l, int max_rounds) {
    const Ctx F = mkctx(); KArgs A = kargs();
    gu32* cur = (gu32*)(A->ws + WS_CTL) + CW_CVT + l * 64;
    volatile LAS unsigned* slot = (volatile LAS unsigned*)(F.lds + LDSCTL_OFF + 256);
    constexpr int NITEMS = 16 * 65 + 16 * 32 + 3 * NE * 256 + 4 * 8 + 224;
    for (int r = 0; max_rounds < 0 || r < max_rounds; ++r) {
        if (F.tid == 0) *slot = __hip_atomic_fetch_add(cur, 8u, RLX_AGENT);
        __syncthreads();
        const int start = (int)*slot;
        __syncthreads();
        if (start >= NITEMS) break;
        convert_layer_items<true>(F, A, l, start + F.wave, NITEMS + 8);
    }
}

__device__ __forceinline__ void p0_prologue() {
    const Ctx F = mkctx(); KArgs A = kargs(); unsigned char* const ws = A->ws;
    {
        LAS float* sc = (LAS float*)F.lds;
        LAS float* red = (LAS float*)(F.lds + 9 * 1024 * 4);
        for (int i = F.tid; i < 9 * 1024; i += NTHR) { const int v = i >> 10, k = i & 1023; const float cv = v < 8 ? A->in.c[v * D + k] : A->in.c_ctx[k]; sc[i] = silu_f(cv); }
        __syncthreads();
        float* MOD = (float*)(ws + WS_MOD);
        for (int it = F.bid; it < DEPTH * 96; it += F.G) {
            const int l = it / 96, j0 = (it % 96) * 64;
            const float* w = A->in.w_mod + ((size_t)l * D + F.wave * 128) * 6144 + j0 + F.lane;
            float acc[9];
#pragma unroll
            for (int v = 0; v < 9; ++v) acc[v] = 0.f;
            for (int k0 = 0; k0 < 128; k0 += 32) { float wv[32];
#pragma unroll
                for (int kk = 0; kk < 32; ++kk) wv[kk] = w[(size_t)(k0 + kk) * 6144];
#pragma unroll
                for (int kk = 0; kk < 32; ++kk) {
#pragma unroll
                    for (int v = 0; v < 9; ++v) acc[v] += sc[v * 1024 + F.wave * 128 + k0 + kk] * wv[kk]; } }
#pragma unroll
            for (int v = 0; v < 9; ++v) red[(F.wave * 9 + v) * 64 + F.lane] = acc[v];
            __syncthreads();
            for (int o = F.tid; o < 9 * 64; o += NTHR) { const int v = o >> 6, jj = o & 63; float s = 0.f;
#pragma unroll
                for (int wv = 0; wv < 8; ++wv) s += red[(wv * 9 + v) * 64 + jj];
                MOD[((size_t)l * 9 + v) * 6144 + j0 + jj] = s + A->in.b_mod[l * 6144 + j0 + jj]; }
            __syncthreads();
        }
    }
    { bf16_t* WGP = (bf16_t*)(ws + WS_WGP);
      for (int i = F.bid * NTHR + F.tid; i < DEPTH * 2 * 4 * 64 * 16; i += F.G * NTHR) { const int r = i & 15, d = (i >> 4) & 63, h = (i >> 10) & 3, n = (i >> 12) & 1, l = i >> 13;
          const float w = A->in.w_gk2[((size_t)(l * 2 + n) * 16 + r) * 256 + h * 64 + d]; const unsigned hi = f2bf(w); const float rem = w - __builtin_bit_cast(float, hi << 16);
          bf16_t* o = WGP + (size_t)l * 2 * 2 * 4 * 64 * 16 + ((size_t)(n * 4 + h) * 64 + d) * 16 + r; o[0] = (bf16_t)hi; o[2 * 4 * 64 * 16] = (bf16_t)f2bf(rem); } }
    { bf16_t* WRP = (bf16_t*)(ws + WS_WRP);
      for (int i = F.bid * NTHR + F.tid; i < NE * D; i += F.G * NTHR) { const int e = i & 15, k = i >> 4; const float w = A->in.w_router[i]; const unsigned hi = f2bf(w); const float rem = w - __builtin_bit_cast(float, hi << 16);
          WRP[(size_t)e * D + k] = (bf16_t)hi; WRP[(size_t)NE * D + (size_t)e * D + k] = (bf16_t)f2bf(rem); } }
    convert_layer_items<false>(F, A, 0, F.bid * NWAVES + F.wave, F.G * NWAVES);
}

template <bool FINAL, bool FROMIN>
__device__ __forceinline__ void rowpass_n1(int l, bool combine, int nrows, bool zero_w) {
    const Ctx F = mkctx(); KArgs A = kargs(); unsigned char* const ws = A->ws; float* const outp = A->out; gu32* const ctl = (gu32*)(ws + WS_CTL);
    const int gw = F.bid * NWAVES + F.wave, NGW = F.G * NWAVES;
    bf16_t* XB = (bf16_t*)(ws + WS_XB);
    const float* MOD = (const float*)(ws + WS_MOD);
    bf16_t* H = (bf16_t*)(ws + WS_HB);
    const bf16_t* YB = (const bf16_t*)(ws + WS_P);
    const int* TOK = (const int*)(ws + WS_TOK); const float* WTS = (const float*)(ws + WS_WTS);
    LAS int* pst = (LAS int*)(F.lds);
    if (combine) {
        if (F.tid < 64) {
            const int cnt = F.tid < NE ? (int)__hip_atomic_load(ctl + CW_ECNT + ((l - 1) * NE + F.tid) * 64, RLX_AGENT) : 0; const int pad = ((cnt + 255) >> 8) << 8; int inc = pad;
#pragma unroll
            for (int o = 1; o < 16; o <<= 1) { const int v = __shfl_up(inc, o, 16); if ((F.tid & 15) >= o) inc += v; }
            if (F.tid < NE) pst[F.tid] = inc - pad; }
        __syncthreads();
    }
    const int rpw = nrows / NGW, row_base = gw * rpw;
    const int c0l = 4 * F.lane;
    int vcur = -1; f32x4 gt[4], st[4], g2v[4];
    if (FINAL) {
#pragma unroll
        for (int j = 0; j < 4; ++j) gt[j] = *(const GAS f32x4*)(A->in.norm_f + c0l + 256 * j);
    }
    v2u pxb[3][4]; f32x4 pxf[3][4]; int pt0[3], pt1[3]; float pw0[3], pw1[3];
#define N1_LOAD_GROUP(G0) do { _Pragma("unroll") for (int r = 0; r < 3; ++r) { const int rr = ((G0) + r < rpw) ? (G0) + r : rpw - 1; const int row = row_base + rr; \
        if (FROMIN) { const float* src = row < NX ? A->in.x + (size_t)row * D : A->in.ctx + (size_t)(row - NX) * D; _Pragma("unroll") for (int j = 0; j < 4; ++j) pxf[r][j] = *(const GAS f32x4*)(src + c0l + 256 * j); } \
        else { _Pragma("unroll") for (int j = 0; j < 4; ++j) pxb[r][j] = *(const GAS v2u*)(XB + (size_t)row * D + c0l + 256 * j); } \
        pt0[r] = 0; pt1[r] = 0; pw0[r] = 0.f; pw1[r] = 0.f; \
        if (combine) { pt0[r] = TOK[row * 2]; pt1[r] = TOK[row * 2 + 1]; pw0[r] = WTS[row * 2]; pw1[r] = WTS[row * 2 + 1]; } } } while (0)
    N1_LOAD_GROUP(0);
    for (int g0 = 0; g0 < rpw; g0 += 3) {
        int rows[3]; bool valid[3]; f32x4 x[3][4]; int t0[3], t1[3]; float w0[3], w1[3];
#pragma unroll
        for (int r = 0; r < 3; ++r) { valid[r] = g0 + r < rpw; rows[r] = row_base + (valid[r] ? g0 + r : rpw - 1); t0[r] = pt0[r]; t1[r] = pt1[r]; w0[r] = zero_w ? 0.f : pw0[r]; w1[r] = zero_w ? 0.f : pw1[r];
#pragma unroll
            for (int j = 0; j < 4; ++j) { if (FROMIN) x[r][j] = pxf[r][j]; else { const v2u a = pxb[r][j];
                x[r][j] = (f32x4){__builtin_bit_cast(float, a.x << 16), __builtin_bit_cast(float, a.x & 0xffff0000u), __builtin_bit_cast(float, a.y << 16), __builtin_bit_cast(float, a.y & 0xffff0000u)}; } } }
        v2u ya[3][4], yb[3][4];
        if (combine) {
#pragma unroll
            for (int r = 0; r < 3; ++r) { const bf16_t* y0 = YB + (size_t)(pst[t0[r] & 15] + (t0[r] >> 4)) * D; const bf16_t* y1 = YB + (size_t)(pst[t1[r] & 15] + (t1[r] >> 4)) * D;
#pragma unroll
                for (int j = 0; j < 4; ++j) { ya[r][j] = *(const GAS v2u*)(y0 + c0l + 256 * j); yb[r][j] = *(const GAS v2u*)(y1 + c0l + 256 * j); } }
        }
        if (g0 + 3 < rpw) N1_LOAD_GROUP(g0 + 3);
#pragma unroll
        for (int r = 0; r < 3; ++r) { const int row = rows[r]; const int v = variant_of_row(row);
            if (!FINAL && v != vcur) {
                vcur = v; const float* m = MOD + ((size_t)l * 9 + v) * 6144; f32x4 gn[4], scl[4];
#pragma unroll
                for (int j = 0; j < 4; ++j) { gn[j] = *(const GAS f32x4*)(A->in.norm1 + l * D + c0l + 256 * j); scl[j] = *(const GAS f32x4*)(m + D + c0l + 256 * j); st[j] = *(const GAS f32x4*)(m + c0l + 256 * j); }
#pragma unroll
                for (int j = 0; j < 4; ++j) gt[j] = gn[j] * (scl[j] + 1.f);
                if (combine) {
#pragma unroll
                    for (int j = 0; j < 4; ++j) g2v[j] = *(const GAS f32x4*)(MOD + ((size_t)(l - 1) * 9 + v) * 6144 + 5 * D + c0l + 256 * j); }
            }
            if (FINAL && combine && v != vcur) { vcur = v;
#pragma unroll
                for (int j = 0; j < 4; ++j) g2v[j] = *(const GAS f32x4*)(MOD + ((size_t)(l - 1) * 9 + v) * 6144 + 5 * D + c0l + 256 * j); }
            if (combine) {
#pragma unroll
                for (int j = 0; j < 4; ++j) { const v2u a = ya[r][j], b = yb[r][j];
                    const f32x4 fa = {__builtin_bit_cast(float, a.x << 16), __builtin_bit_cast(float, a.x & 0xffff0000u), __builtin_bit_cast(float, a.y << 16), __builtin_bit_cast(float, a.y & 0xffff0000u)};
                    const f32x4 fb = {__builtin_bit_cast(float, b.x << 16), __builtin_bit_cast(float, b.x & 0xffff0000u), __builtin_bit_cast(float, b.y << 16), __builtin_bit_cast(float, b.y & 0xffff0000u)};
                    x[r][j] = x[r][j] + g2v[j] * (fa * w0[r] + fb * w1[r]); } }
            if (!FINAL && (combine || FROMIN) && valid[r]) {
#pragma unroll
                for (int j = 0; j < 4; ++j) { v2u o; o.x = pk2(x[r][j].x, x[r][j].y); o.y = pk2(x[r][j].z, x[r][j].w); *(GAS v2u*)(XB + (size_t)row * D + c0l + 256 * j) = o; }
            }
            float ss = 0.f;
#pragma unroll
            for (int j = 0; j < 4; ++j) ss += (x[r][j].x * x[r][j].x + x[r][j].y * x[r][j].y) + (x[r][j].z * x[r][j].z + x[r][j].w * x[r][j].w);
            const float rinv = rsqrtf(wave_sum(ss) * (1.f / D) + 1e-6f);
            if (valid[r]) {
                if (FINAL) { float* dst = outp + (size_t)row * D;
#pragma unroll
                    for (int j = 0; j < 4; ++j) *(GAS f32x4*)(dst + c0l + 256 * j) = x[r][j] * rinv * gt[j];
                } else {
#pragma unroll
                    for (int j = 0; j < 4; ++j) { const f32x4 h = x[r][j] * rinv * gt[j] + st[j];
                        v2u o; o.x = pk2(h.x, h.y); o.y = pk2(h.z, h.w); *(GAS v2u*)(H + (size_t)row * D + c0l + 256 * j) = o; }
                }
            }
        }
    }
#undef N1_LOAD_GROUP
}
#define HAVE_GLA 1
constexpr int G_LG = 0;
constexpr int G_TMP = 32768;
constexpr int G_AO = 51200;
constexpr int G_VN = 76800;
constexpr int G_BS = 94208;
constexpr int G_OUT = 0;
__device__ __forceinline__ f32x16 mfma32(bf16x8 a, bf16x8 b, f32x16 c) { return __builtin_amdgcn_mfma_f32_32x32x16_bf16(a, b, c, 0, 0, 0); }
__device__ __forceinline__ float fast_logsigmoid(float x) { return fminf(x, 0.f) - __logf(1.f + __expf(-fabsf(x))); }
__device__ __forceinline__ void unpack8(const v4u w, float (&f)[8]) {
    f[0] = __builtin_bit_cast(float, w.x << 16); f[1] = __builtin_bit_cast(float, w.x & 0xffff0000u); f[2] = __builtin_bit_cast(float, w.y << 16); f[3] = __builtin_bit_cast(float, w.y & 0xffff0000u);
    f[4] = __builtin_bit_cast(float, w.z << 16); f[5] = __builtin_bit_cast(float, w.z & 0xffff0000u); f[6] = __builtin_bit_cast(float, w.w << 16); f[7] = __builtin_bit_cast(float, w.w & 0xffff0000u);
}
__device__ __forceinline__ v4u pack8(const float (&f)[8]) { v4u w; w.x = pk2(f[0], f[1]); w.y = pk2(f[2], f[3]); w.z = pk2(f[4], f[5]); w.w = pk2(f[6], f[7]); return w; }

typedef short v4i16_t __attribute__((ext_vector_type(4)));
__device__ __forceinline__ bf16x8 tr_frag(const LAS bf16_t* T, int ld, int k0, int n0, int lane) {
    const int hh = lane >> 5, blk = (lane >> 4) & 1, q = (lane & 15) >> 2, p = lane & 3;
    const LAS bf16_t* a0 = T + (k0 + 8 * hh + q) * ld + n0 + 16 * blk + 4 * p;
    const v4i16_t lo = __builtin_amdgcn_ds_read_tr16_b64_v4i16((LAS v4i16_t*)a0), hi = __builtin_amdgcn_ds_read_tr16_b64_v4i16((LAS v4i16_t*)(a0 + 4 * ld));
    bf16x8 r; r[0] = lo[0]; r[1] = lo[1]; r[2] = lo[2]; r[3] = lo[3]; r[4] = hi[0]; r[5] = hi[1]; r[6] = hi[2]; r[7] = hi[3]; return r;
}
struct DecPre { v4u a, bhi, blo; float bias; };
__device__ __forceinline__ void decays_load(DecPre& p, const Ctx& F, const bf16_t* P, const bf16_t* WGPl, const float* b_gkl, int r0, int h) {
    const int n = F.wave >> 2, tt = (F.wave >> 1) & 1, dt = F.wave & 1, r = F.lane & 31, hh = F.lane >> 5;
    p.a = *(const GAS v4u*)(P + (size_t)(r0 + 32 * tt + r) * PLD + 2048 + n * 16 + 8 * hh);
    const bf16_t* wg = WGPl + ((size_t)(n * 4 + h) * 64 + 32 * dt + r) * 16 + 8 * hh;
    p.bhi = *(const GAS v4u*)wg; p.blo = *(const GAS v4u*)(wg + 2 * 4 * 64 * 16);
    p.bias = b_gkl[n * 256 + h * 64 + 32 * dt + r];
}
__device__ __forceinline__ void chunk_decays(const Ctx& F, const DecPre& p) {
    LAS float* LG = (LAS float*)(F.lds + G_LG); LAS float* TT = (LAS float*)(F.lds + G_TMP);
    const int n = F.wave >> 2, tt = (F.wave >> 1) & 1, dt = F.wave & 1, r = F.lane & 31, hh = F.lane >> 5;
    f32x16 acc = {0.f, 0.f, 0.f, 0.f, 0.f, 0.f, 0.f, 0.f, 0.f, 0.f, 0.f, 0.f, 0.f, 0.f, 0.f, 0.f};
    acc = mfma32(__builtin_bit_cast(bf16x8, p.a), __builtin_bit_cast(bf16x8, p.bhi), acc);
    acc = mfma32(__builtin_bit_cast(bf16x8, p.a), __builtin_bit_cast(bf16x8, p.blo), acc);
    float v[16];
#pragma unroll
    for (int g = 0; g < 16; ++g) v[g] = fast_logsigmoid(acc[g] + p.bias) * (1.f / 16.f);
    float T[4], Pq[4];
    if (n == 0) {
#pragma unroll
        for (int q = 0; q < 4; ++q) { v[4 * q + 1] += v[4 * q]; v[4 * q + 2] += v[4 * q + 1]; v[4 * q + 3] += v[4 * q + 2]; T[q] = v[4 * q + 3]; }
    } else {
#pragma unroll
        for (int q = 0; q < 4; ++q) { v[4 * q + 2] += v[4 * q + 3]; v[4 * q + 1] += v[4 * q + 2]; v[4 * q] += v[4 * q + 1]; T[q] = v[4 * q]; }
    }
#pragma unroll
    for (int q = 0; q < 4; ++q) Pq[q] = __shfl_xor(T[q], 32);
    const float tot = ((T[0] + Pq[0]) + (T[1] + Pq[1])) + ((T[2] + Pq[2]) + (T[3] + Pq[3]));
    if (hh == 0) TT[(n * 2 + tt) * 64 + 32 * dt + r] = tot;
    float off[4];
    if (n == 0) { float run = 0.f;
#pragma unroll
        for (int q = 0; q < 4; ++q) { off[q] = run + (hh ? Pq[q] : 0.f); run += T[q] + Pq[q]; }
    } else { float run = 0.f;
#pragma unroll
        for (int q = 3; q >= 0; --q) { off[q] = run + (hh ? 0.f : Pq[q]); run += T[q] + Pq[q]; }
    }
    __syncthreads();
    const float xo = (n == 0) ? (tt == 1 ? TT[(0 * 2 + 0) * 64 + 32 * dt + r] : 0.f) : (tt == 0 ? TT[(1 * 2 + 1) * 64 + 32 * dt + r] : 0.f);
#pragma unroll
    for (int g = 0; g < 16; ++g) { const int t = 32 * tt + (g & 3) + 8 * (g >> 2) + 4 * hh; LG[(n * 64 + t) * 64 + 32 * dt + r] = v[g] + off[g >> 2] + xo; }
    __syncthreads();
}

struct KvPre { DecPre dec; v4u k, v0, v1; };
__device__ __forceinline__ void kv_decode(int job, int& b, int& h, int& j) { b = job / 144; const int rem = job % 144; h = rem / NCH; j = rem % NCH; }
__device__ __forceinline__ void kv_load(KvPre& p, const Ctx& F, KArgs A, int l, int job) {
    int b, h, j; kv_decode(job, b, h, j); const bf16_t* P = (const bf16_t*)(A->ws + WS_P); const int r0 = chunk_row0(b, j);
    decays_load(p.dec, F, P, (const bf16_t*)(A->ws + WS_WGP) + (size_t)l * 2 * 2 * 4 * 64 * 16, A->in.b_gk + (size_t)l * 2 * 256, r0, h);
    const int t = F.tid >> 3, dg = F.tid & 7; const bf16_t* pr = P + (size_t)(r0 + t) * PLD;
    p.k = *(const GAS v4u*)(pr + 768 + h * 64 + 8 * dg); p.v0 = *(const GAS v4u*)(pr + 1024 + h * 128 + 16 * dg); p.v1 = *(const GAS v4u*)(pr + 1024 + h * 128 + 16 * dg + 8);
}
__device__ __forceinline__ void kv_compute(const KvPre& p, const Ctx& F, unsigned char* ws, int job) {
    int b, h, j; kv_decode(job, b, h, j);
    chunk_decays(F, p.dec);
    LAS float* LG = (LAS float*)(F.lds + G_LG);
    LAS bf16_t* KEF = (LAS bf16_t*)(F.lds + G_AO); LAS bf16_t* KEB = KEF + 64 * 72; LAS bf16_t* VN = (LAS bf16_t*)(F.lds + G_VN);
    { const int t = F.tid >> 3, dg = F.tid & 7;
      float k[8]; unpack8(p.k, k); float kf[8], kb[8];
#pragma unroll
      for (int i = 0; i < 8; ++i) { const int d = 8 * dg + i;
          kf[i] = k[i] * __expf(LG[63 * 64 + d] - LG[t * 64 + d]); kb[i] = k[i] * __expf(LG[64 * 64 + d] - LG[(64 + t) * 64 + d]); }
      *(LAS v4u*)(KEF + t * 72 + 8 * dg) = pack8(kf); *(LAS v4u*)(KEB + t * 72 + 8 * dg) = pack8(kb);
      *(LAS v4u*)(VN + t * 136 + 16 * dg) = p.v0; *(LAS v4u*)(VN + t * 136 + 16 * dg + 8) = p.v1; }
    const int seq0 = (b * 4 + h) * 2;
    if (F.tid < 128) { const int n = F.tid >> 6, d = F.tid & 63; float* ADEC = (float*)(ws + WS_ADEC);
        ADEC[((size_t)(seq0 + n) * NCH + j) * 64 + d] = __expf(n == 0 ? LG[63 * 64 + d] : LG[64 * 64 + d]); }
    __syncthreads();
    { const int dir = F.wave >> 2, et = F.wave & 3, r = F.lane & 31, hh = F.lane >> 5;
      const LAS bf16_t* KE = dir ? KEB : KEF;
      f32x16 a0 = {0.f, 0.f, 0.f, 0.f, 0.f, 0.f, 0.f, 0.f, 0.f, 0.f, 0.f, 0.f, 0.f, 0.f, 0.f, 0.f}, a1 = a0;
#pragma unroll
      for (int ks = 0; ks < 4; ++ks) { const bf16x8 av = tr_frag(VN, 136, 16 * ks, 32 * et, F.lane);
          const bf16x8 b0 = tr_frag(KE, 72, 16 * ks, 0, F.lane), b1 = tr_frag(KE, 72, 16 * ks, 32, F.lane);
          a0 = mfma32(av, b0, a0); a1 = mfma32(av, b1, a1); }
      bf16_t* KVS = (bf16_t*)(ws + WS_KVS) + ((size_t)(seq0 + dir) * NCH + j) * 8192;
#pragma unroll
      for (int g = 0; g < 16; ++g) { const int e = 32 * et + (g & 3) + 8 * (g >> 2) + 4 * hh; KVS[e * 64 + r] = (bf16_t)pk2(a0[g], 0.f); KVS[e * 64 + 32 + r] = (bf16_t)pk2(a1[g], 0.f); } }
    __syncthreads();
}

template <int HW>
__device__ __forceinline__ void pool_job_t(int l, int pj, int g) {
    const Ctx F = mkctx(); KArgs A = kargs(); unsigned char* const ws = A->ws;
    const bf16_t* P = (const bf16_t*)(ws + WS_P);
    LAS float* VS = (LAS float*)(F.lds);
    LAS bf16_t* PD = (LAS bf16_t*)(F.lds + 33792);
    LAS bf16_t* WP = (LAS bf16_t*)(F.lds + 33792 + 17408);
    const bool latent = pj < 1024;
    int b, i64; if (latent) { b = pj >> 7; i64 = (pj >> 2) & 31; } else { const int q = pj - 1024; b = q >> 4; i64 = (q >> 2) & 3; }
    const int row0 = latent ? b * SEQ + i64 * 64 : NX + b * CTXL + i64 * 64;
    v4u wpre[4];
    { const bf16_t* wsrc = (const bf16_t*)(ws + WS_WPOOL) + (size_t)(l * 4 + g) * 128 * 128;
#pragma unroll
      for (int c = 0; c < 4; ++c) { const int u = F.tid + NTHR * c, d = u >> 4, q = u & 15; wpre[c] = *(const GAS v4u*)(wsrc + d * 128 + 8 * q); } }
    const float psc = A->in.pool_scale[l * 512 + g * 128 + 32 * (F.wave & 3) + (F.lane & 31)];
    v4u upre[2];
#pragma unroll
    for (int c = 0; c < 2; ++c) { const int u = F.tid + NTHR * c, jc = u >> 4, cg = u & 15; upre[c] = *(const GAS v4u*)(P + (size_t)(row0 + jc) * PLD + g * 128 + 8 * cg); }
    if (latent) {
        const int rlo = max(i64 - HW, 0), rhi = min(i64 + HW, 32); const float rc = 1.f / (float)(rhi - rlo);
#pragma unroll
        for (int c = 0; c < 2; ++c) { const int u = F.tid + NTHR * c, jc = u >> 4, cg = u & 15; float s[8];
#pragma unroll
            for (int i = 0; i < 8; ++i) s[i] = 0.f;
            v4u ld[2 * HW];
#pragma unroll
            for (int k = 0; k < 2 * HW; ++k) { const int r2 = min(max(i64 - HW + k, 0), 31); ld[k] = *(const GAS v4u*)(P + (size_t)(b * SEQ + r2 * 64 + jc) * PLD + g * 128 + 8 * cg); }
#pragma unroll
            for (int k = 0; k < 2 * HW; ++k) { const int r2 = i64 - HW + k; const float wt = (r2 >= 0 && r2 < 32) ? 1.f : 0.f; float f[8]; unpack8(ld[k], f);
#pragma unroll
                for (int i = 0; i < 8; ++i) s[i] += wt * f[i]; }
#pragma unroll
            for (int i = 0; i < 8; ++i) VS[jc * 132 + 8 * cg + i] = s[i] * rc; }
    }
#pragma unroll
    for (int c = 0; c < 4; ++c) { const int u = F.tid + NTHR * c, d = u >> 4, q = u & 15; *(LAS v4u*)(WP + d * 136 + 8 * q) = wpre[c]; }
    if (latent) __syncthreads();
#pragma unroll
    for (int c = 0; c < 2; ++c) { const int u = F.tid + NTHR * c, jc = u >> 4, cg = u & 15; float s[8];
#pragma unroll
        for (int i = 0; i < 8; ++i) s[i] = 0.f;
        float cnt;
        if (latent) { const int clo = max(jc - HW, 0), chi = min(jc + HW, 64); cnt = (float)(chi - clo);
#pragma unroll
            for (int k = 0; k < 2 * HW; ++k) { const int j2 = jc - HW + k; const float wt = (j2 >= 0 && j2 < 64) ? 1.f : 0.f; const int j2c = min(max(j2, 0), 63);
                const f32x4 v0 = *(const LAS f32x4*)(VS + j2c * 132 + 8 * cg), v1 = *(const LAS f32x4*)(VS + j2c * 132 + 8 * cg + 4);
                s[0] += wt * v0.x; s[1] += wt * v0.y; s[2] += wt * v0.z; s[3] += wt * v0.w; s[4] += wt * v1.x; s[5] += wt * v1.y; s[6] += wt * v1.z; s[7] += wt * v1.w; } }
        else { const int t = i64 * 64 + jc; const int lo = max(t - HW, 0), hi = min(t + HW, CTXL); cnt = (float)(hi - lo);
            v4u ld[2 * HW];
#pragma unroll
            for (int k = 0; k < 2 * HW; ++k) { const int t2 = min(max(t - HW + k, 0), CTXL - 1); ld[k] = *(const GAS v4u*)(P + (size_t)(NX + b * CTXL + t2) * PLD + g * 128 + 8 * cg); }
#pragma unroll
            for (int k = 0; k < 2 * HW; ++k) { const int t2 = t - HW + k; const float wt = (t2 >= 0 && t2 < CTXL) ? 1.f : 0.f; float f[8]; unpack8(ld[k], f);
#pragma unroll
                for (int i = 0; i < 8; ++i) s[i] += wt * f[i]; } }
        float uv[8]; unpack8(upre[c], uv);
        const float ic = 1.f / cnt; float pd[8];
#pragma unroll
        for (int i = 0; i < 8; ++i) pd[i] = s[i] * ic - uv[i];
        *(LAS v4u*)(PD + jc * 136 + 8 * cg) = pack8(pd); }
    __syncthreads();
    { const int mt = F.wave >> 2, nt = F.wave & 3, r = F.lane & 31, hh = F.lane >> 5;
      f32x16 acc = {0.f, 0.f, 0.f, 0.f, 0.f, 0.f, 0.f, 0.f, 0.f, 0.f, 0.f, 0.f, 0.f, 0.f, 0.f, 0.f};
#pragma unroll
      for (int ks = 0; ks < 8; ++ks) { const bf16x8 av = *(const LAS bf16x8*)(PD + (32 * mt + r) * 136 + 16 * ks + 8 * hh), bv = *(const LAS bf16x8*)(WP + (32 * nt + r) * 136 + 16 * ks + 8 * hh);
          acc = mfma32(av, bv, acc); }
      const int dcol = g * 128 + 32 * nt + r;
      bf16_t* MIX = (bf16_t*)(ws + WS_HB);
#pragma unroll
      for (int q = 0; q < 16; ++q) { const int jc = 32 * mt + (q & 3) + 8 * (q >> 2) + 4 * hh; MIX[(size_t)(row0 + jc) * D + dcol] = (bf16_t)pk2(acc[q] * psc, 0.f); } }
    __syncthreads();
}
__device__ __forceinline__ void pool_job(int l, int pj) {
    const int g = ((pj & 3) + (pj >> 8)) & 3;
    if (g == 0) pool_job_t<1>(l, pj, 0); else if (g == 1) pool_job_t<2>(l, pj, 1); else if (g == 2) pool_job_t<4>(l, pj, 2); else pool_job_t<8>(l, pj, 3);
}

__device__ __forceinline__ void gla_phase1(int l) {
    const int npool = (l < DEPTH - 1) ? 1152 : 1024;
    const int pflags = kargs()->flags;
    if (!(pflags & 4)) {
        const Ctx F = mkctx(); KArgs A = kargs(); unsigned char* const ws = A->ws;
        int job = blockIdx.x; KvPre pre;
        if (job < 1152) kv_load(pre, F, A, l, job);
        while (job < 1152) {
            const KvPre cur = pre; const int nj = job + gridDim.x;
            if (nj < 1152) kv_load(pre, F, A, l, nj);
            kv_compute(cur, F, ws, job);
            job = nj;
        }
    }
    if (!(pflags & 2)) for (int J = blockIdx.x; J < 1152 + npool; J += gridDim.x) if (J >= 1152) pool_job(l, J - 1152);
}

__device__ __forceinline__ void gla_phase2(int l) {
    const Ctx F = mkctx(); KArgs A = kargs(); unsigned char* const ws = A->ws;
    const int gid = F.bid * NTHR + F.tid; if (gid >= 64 * 2048) return;
    const int seq = gid >> 11, rem = gid & 2047, e = rem >> 4, dq = rem & 15, dir = seq & 1;
    bf16_t* base = (bf16_t*)(ws + WS_KVS) + (size_t)seq * NCH * 8192 + e * 64 + 4 * dq;
    const float* adec = (const float*)(ws + WS_ADEC) + (size_t)seq * NCH * 64 + 4 * dq;
    f32x4 S = {0.f, 0.f, 0.f, 0.f};
    for (int bt = 0; bt < 3; ++bt) {
        v2u kv[12]; f32x4 av[12];
#pragma unroll
        for (int i = 0; i < 12; ++i) { const int s = bt * 12 + i; const int jj = dir == 0 ? s : (s < 4 ? 3 - s : 39 - s);
            kv[i] = *(const GAS v2u*)(base + (size_t)jj * 8192); av[i] = *(const GAS f32x4*)(adec + jj * 64); }
#pragma unroll
        for (int i = 0; i < 12; ++i) { const int s = bt * 12 + i; const int jj = dir == 0 ? s : (s < 4 ? 3 - s : 39 - s);
            v2u o; o.x = pk2(S.x, S.y); o.y = pk2(S.z, S.w); *(GAS v2u*)(base + (size_t)jj * 8192) = o;
            const f32x4 k4 = {__builtin_bit_cast(float, kv[i].x << 16), __builtin_bit_cast(float, kv[i].x & 0xffff0000u), __builtin_bit_cast(float, kv[i].y << 16), __builtin_bit_cast(float, kv[i].y & 0xffff0000u)};
            S = av[i] * S + k4; }
    }
}

struct OutPre { DecPre dec; v4u q, k, v0, v1, g0, g1, sf0, sf1, sb0, sb1; f32x4 gg[4]; };
__device__ __forceinline__ void out_load(OutPre& p, const Ctx& F, KArgs A, int l, int job) {
    int b, h, j; kv_decode(job, b, h, j); const bf16_t* P = (const bf16_t*)(A->ws + WS_P); const int r0 = chunk_row0(b, j);
    decays_load(p.dec, F, P, (const bf16_t*)(A->ws + WS_WGP) + (size_t)l * 2 * 2 * 4 * 64 * 16, A->in.b_gk + (size_t)l * 2 * 256, r0, h);
    const int t = F.tid >> 3, dg = F.tid & 7; const bf16_t* pr = P + (size_t)(r0 + t) * PLD;
    p.q = *(const GAS v4u*)(pr + 512 + h * 64 + 8 * dg); p.k = *(const GAS v4u*)(pr + 768 + h * 64 + 8 * dg);
    p.v0 = *(const GAS v4u*)(pr + 1024 + h * 128 + 16 * dg); p.v1 = *(const GAS v4u*)(pr + 1024 + h * 128 + 16 * dg + 8);
    p.g0 = *(const GAS v4u*)(pr + 1536 + h * 128 + 16 * dg); p.g1 = *(const GAS v4u*)(pr + 1536 + h * 128 + 16 * dg + 8);
#pragma unroll
    for (int c = 0; c < 4; ++c) p.gg[c] = *(const GAS f32x4*)(A->in.gla_gain + l * 128 + 16 * dg + 4 * c);
    const int e = F.tid >> 2, q4 = F.tid & 3; const bf16_t* sf = (const bf16_t*)(A->ws + WS_KVS) + ((size_t)((b * 4 + h) * 2) * NCH + j) * 8192 + e * 64 + 16 * q4;
    p.sf0 = *(const GAS v4u*)sf; p.sf1 = *(const GAS v4u*)(sf + 8); p.sb0 = *(const GAS v4u*)(sf + (size_t)NCH * 8192); p.sb1 = *(const GAS v4u*)(sf + (size_t)NCH * 8192 + 8);
}
__device__ __forceinline__ void out_compute(const OutPre& p, const Ctx& F, KArgs A, int l, int job) {
    int b, h, j; kv_decode(job, b, h, j); unsigned char* const ws = A->ws; const int r0 = chunk_row0(b, j);
    chunk_decays(F, p.dec);
    LAS float* LG = (LAS float*)(F.lds + G_LG);
    LAS bf16_t* KTF = (LAS bf16_t*)(F.lds + G_TMP); LAS bf16_t* KTB = KTF + 64 * 72;
    LAS bf16_t* AO = (LAS bf16_t*)(F.lds + G_AO); LAS bf16_t* VN = (LAS bf16_t*)(F.lds + G_VN); LAS bf16_t* BS = (LAS bf16_t*)(F.lds + G_BS);
    { const int t = F.tid >> 3, dg = F.tid & 7;
      float q[8], k[8]; unpack8(p.q, q); unpack8(p.k, k);
      float qf[8], qb[8], kf[8], kb[8];
#pragma unroll
      for (int i = 0; i < 8; ++i) { const int d = 8 * dg + i; const float bf = LG[t * 64 + d], bb = LG[(64 + t) * 64 + d];
          qf[i] = q[i] * __expf(bf); kf[i] = k[i] * __expf(-bf); qb[i] = q[i] * __expf(bb); kb[i] = k[i] * __expf(-bb); }
      *(LAS v4u*)(AO + t * 200 + 64 + 8 * dg) = pack8(qf); *(LAS v4u*)(AO + t * 200 + 128 + 8 * dg) = pack8(qb);
      *(LAS v4u*)(KTF + t * 72 + 8 * dg) = pack8(kf); *(LAS v4u*)(KTB + t * 72 + 8 * dg) = pack8(kb);
      *(LAS v4u*)(VN + t * 136 + 16 * dg) = p.v0; *(LAS v4u*)(VN + t * 136 + 16 * dg + 8) = p.v1; }
    { const int e = F.tid >> 2, q4 = F.tid & 3;
      *(LAS v4u*)(BS + e * 136 + 16 * q4) = p.sf0; *(LAS v4u*)(BS + e * 136 + 16 * q4 + 8) = p.sf1; *(LAS v4u*)(BS + e * 136 + 64 + 16 * q4) = p.sb0; *(LAS v4u*)(BS + e * 136 + 64 + 16 * q4 + 8) = p.sb1; }
    __syncthreads();
    const int mt = F.wave >> 2, nt = F.wave & 3, r = F.lane & 31, hh = F.lane >> 5;
    f32x16 acc = {0.f, 0.f, 0.f, 0.f, 0.f, 0.f, 0.f, 0.f, 0.f, 0.f, 0.f, 0.f, 0.f, 0.f, 0.f, 0.f};
    if (F.wave < 4) {
        const int tt = F.wave == 0 ? 0 : (F.wave == 1 ? 1 : (F.wave == 2 ? 1 : 0)), st = F.wave == 0 ? 0 : (F.wave == 1 ? 1 : (F.wave == 2 ? 0 : 1));
        const bool dof = F.wave != 3, dob = F.wave != 2;
        f32x16 af = {0.f, 0.f, 0.f, 0.f, 0.f, 0.f, 0.f, 0.f, 0.f, 0.f, 0.f, 0.f, 0.f, 0.f, 0.f, 0.f}, ab = af;
        if (dof) {
#pragma unroll
            for (int ks = 0; ks < 4; ++ks) af = mfma32(*(const LAS bf16x8*)(AO + (32 * tt + r) * 200 + 64 + 16 * ks + 8 * hh), *(const LAS bf16x8*)(KTF + (32 * st + r) * 72 + 16 * ks + 8 * hh), af); }
        if (dob) {
#pragma unroll
            for (int ks = 0; ks < 4; ++ks) ab = mfma32(*(const LAS bf16x8*)(AO + (32 * tt + r) * 200 + 128 + 16 * ks + 8 * hh), *(const LAS bf16x8*)(KTB + (32 * st + r) * 72 + 16 * ks + 8 * hh), ab); }
        const bool diag = tt == st;
#pragma unroll
        for (int g = 0; g < 16; ++g) { const int trow = (g & 3) + 8 * (g >> 2) + 4 * hh;
            float v = af[g] + ab[g];
            if (diag) v = (r <= trow ? af[g] : 0.f) + (r >= trow ? ab[g] : 0.f);
            AO[(32 * tt + trow) * 200 + 32 * st + r] = (bf16_t)pk2(v, 0.f); }
    }
#pragma unroll
    for (int ks = 4; ks < 12; ++ks) acc = mfma32(*(const LAS bf16x8*)(AO + (32 * mt + r) * 200 + 16 * ks + 8 * hh), *(const LAS bf16x8*)(BS + (32 * nt + r) * 136 + 16 * (ks - 4) + 8 * hh), acc);
    __syncthreads();
    {
#pragma unroll
      for (int ks = 0; ks < 4; ++ks) acc = mfma32(*(const LAS bf16x8*)(AO + (32 * mt + r) * 200 + 16 * ks + 8 * hh), tr_frag(VN, 136, 16 * ks, 32 * nt, F.lane), acc);
      LAS float* OUT = (LAS float*)(F.lds + G_OUT);
#pragma unroll
      for (int g = 0; g < 16; ++g) { const int trow = 32 * mt + (g & 3) + 8 * (g >> 2) + 4 * hh; OUT[trow * 132 + 32 * nt + r] = acc[g]; } }
    __syncthreads();
    { const int t = F.tid >> 3, eg = F.tid & 7; const LAS float* o = (const LAS float*)(F.lds + G_OUT) + t * 132 + 16 * eg;
      float ov[16]; float ss = 0.f;
#pragma unroll
      for (int i = 0; i < 4; ++i) { const f32x4 x4 = *(const LAS f32x4*)(o + 4 * i); ov[4 * i] = x4.x; ov[4 * i + 1] = x4.y; ov[4 * i + 2] = x4.z; ov[4 * i + 3] = x4.w; ss += (x4.x * x4.x + x4.y * x4.y) + (x4.z * x4.z + x4.w * x4.w); }
      ss += __shfl_xor(ss, 1); ss += __shfl_xor(ss, 2); ss += __shfl_xor(ss, 4);
      const float rinv = rsqrtf(ss * (1.f / 128.f) + 1e-6f);
      float gg[16];
#pragma unroll
      for (int c = 0; c < 4; ++c) { gg[4 * c] = p.gg[c].x; gg[4 * c + 1] = p.gg[c].y; gg[4 * c + 2] = p.gg[c].z; gg[4 * c + 3] = p.gg[c].w; }
      bf16_t* mp = (bf16_t*)(ws + WS_HB) + (size_t)(r0 + t) * D + 512 + h * 128 + 16 * eg;
#pragma unroll
      for (int c = 0; c < 2; ++c) { float gv[8]; unpack8(c ? p.g1 : p.g0, gv); float y[8];
#pragma unroll
          for (int i = 0; i < 8; ++i) { const float gx = gv[i]; y[i] = ov[8 * c + i] * rinv * gg[8 * c + i] * gx * __builtin_amdgcn_rcpf(1.f + __expf(-gx)); }
          *(GAS v4u*)(mp + 8 * c) = pack8(y); } }
    __syncthreads();
}
__device__ __forceinline__ int out_next(int l, int job, int G) { job += G; if (l == DEPTH - 1) while (job < 1152 && (job % 144) % NCH < 4) job += G; return job; }
__device__ __forceinline__ void gla_phase3(int l) {
    const Ctx F = mkctx(); KArgs A = kargs();
    const int G = gridDim.x; int job = out_next(l, (int)blockIdx.x - G, G); OutPre pre;
    if (job < 1152) out_load(pre, F, A, l, job);
    while (job < 1152) {
        const OutPre cur = pre; const int nj = out_next(l, job, G);
        if (nj < 1152) out_load(pre, F, A, l, nj);
        out_compute(cur, F, A, l, job);
        job = nj;
    }
}
#define HAVE_MOE 1
#define DPPF(x, ctrl) __builtin_bit_cast(float, __builtin_amdgcn_update_dpp(0, __builtin_bit_cast(int, (x)), (ctrl), 0xF, 0xF, true))
__device__ __forceinline__ float reduce16(const float (&a)[16], int lane) {
    float b8[8], b4[4], b2[2];
    bool h = (lane & 8) != 0;
#pragma unroll
    for (int i = 0; i < 8; ++i) { const float keep = h ? a[8 + i] : a[i], send = h ? a[i] : a[8 + i]; b8[i] = keep + DPPF(send, 0x140); }
    h = (lane & 4) != 0;
#pragma unroll
    for (int i = 0; i < 4; ++i) { const float keep = h ? b8[4 + i] : b8[i], send = h ? b8[i] : b8[4 + i]; b4[i] = keep + DPPF(send, 0x141); }
    h = (lane & 2) != 0;
#pragma unroll
    for (int i = 0; i < 2; ++i) { const float keep = h ? b4[2 + i] : b4[i], send = h ? b4[i] : b4[2 + i]; b2[i] = keep + DPPF(send, 0x4E); }
    h = (lane & 1) != 0;
    float r; { const float keep = h ? b2[1] : b2[0], send = h ? b2[0] : b2[1]; r = keep + DPPF(send, 0xB1); }
    r += __shfl_xor(r, 16); r += __shfl_xor(r, 32);
    return r;
}

__device__ __forceinline__ void router_phase(int l, int nrows) {
    const Ctx F = mkctx(); KArgs A = kargs(); unsigned char* const ws = A->ws;
    constexpr int WRS = D + 4;
    LAS float* WRT = (LAS float*)F.lds;
    LAS float* LGS = (LAS float*)(F.lds + 69632);
    LAS int* CNT = (LAS int*)(F.lds + 69632 + 2048);
    LAS int* BASE = CNT + 16;
    LAS int* ASG = (LAS int*)(F.lds + 69632 + 4096);
    { const float* wr = A->in.w_router;
      float wl[32];
#pragma unroll
      for (int c = 0; c < 32; ++c) wl[c] = wr[F.tid + NTHR * c];
#pragma unroll
      for (int c = 0; c < 32; ++c) { const int i = F.tid + NTHR * c; WRT[(i & 15) * WRS + (i >> 4)] = wl[c]; } }
    if (F.tid < 32) CNT[F.tid] = 0;
    __syncthreads();
    const bf16_t* XB = (const bf16_t*)(ws + WS_XB);
    const float* MODl = (const float*)(ws + WS_MOD) + (size_t)l * 9 * 6144;
    bf16_t* H = (bf16_t*)(ws + WS_HB);
    float* WTS = (float*)(ws + WS_WTS);
    const float rb_lane = A->in.router_bias[F.lane & 15];
    const int rpb = nrows / F.G, rpw = rpb / NWAVES;
    const int row_base = F.bid * rpb + F.wave * rpw;
    LAS float* GT = (LAS float*)(F.lds + 77824); LAS float* ST = GT + 2048;
    const int v0 = variant_of_row(F.bid * rpb), v1 = variant_of_row(F.bid * rpb + rpb - 1);
    { float tn[4], tsc[4], tsh[4];
#pragma unroll
      for (int c = 0; c < 4; ++c) { const int i = F.tid + NTHR * c, ti = i >> 10, k = i & 1023; const float* m = MODl + (size_t)(ti ? v1 : v0) * 6144;
          tn[c] = A->in.norm2[l * D + k]; tsc[c] = m[4 * D + k]; tsh[c] = m[3 * D + k]; }
#pragma unroll
      for (int c = 0; c < 4; ++c) { const int i = F.tid + NTHR * c; GT[i] = tn[c] * (1.f + tsc[c]); ST[i] = tsh[c]; } }
    v2u xq[3][4];
#pragma unroll
    for (int r = 0; r < 3; ++r) { const int rr = (r < rpw) ? r : rpw - 1;
#pragma unroll
        for (int j = 0; j < 4; ++j) xq[r][j] = *(const GAS v2u*)(XB + (size_t)(row_base + rr) * D + 4 * F.lane + 256 * j); }
    __syncthreads();
    for (int g0 = 0; g0 < rpw; g0 += 3) {
        int lane_ = F.lane; asm volatile("" : "+v"(lane_));
        const int lane = lane_;
        f32x4 hx[3][4]; int rws[3]; bool vld[3];
#pragma unroll
        for (int r = 0; r < 3; ++r) {
            const int rr = (g0 + r < rpw) ? g0 + r : rpw - 1; rws[r] = row_base + rr; vld[r] = (g0 + r < rpw);
#pragma unroll
            for (int j = 0; j < 4; ++j) { const v2u a = xq[r][j];
                hx[r][j] = (f32x4){__builtin_bit_cast(float, a.x << 16), __builtin_bit_cast(float, a.x & 0xffff0000u), __builtin_bit_cast(float, a.y << 16), __builtin_bit_cast(float, a.y & 0xffff0000u)}; } }
        if (g0 + 3 < rpw) {
#pragma unroll
            for (int r = 0; r < 3; ++r) { const int rr = (g0 + 3 + r < rpw) ? g0 + 3 + r : rpw - 1;
#pragma unroll
                for (int j = 0; j < 4; ++j) xq[r][j] = *(const GAS v2u*)(XB + (size_t)(row_base + rr) * D + 4 * lane + 256 * j); } }
#pragma unroll
        for (int r = 0; r < 3; ++r) { const int row = rws[r]; float ss = 0.f;
#pragma unroll
            for (int j = 0; j < 4; ++j) ss += (hx[r][j].x * hx[r][j].x + hx[r][j].y * hx[r][j].y) + (hx[r][j].z * hx[r][j].z + hx[r][j].w * hx[r][j].w);
            const float rinv = rsqrtf(wave_sum(ss) * (1.f / D) + 1e-6f);
            const int ti = variant_of_row(row) == v0 ? 0 : 1024;
#pragma unroll
            for (int j = 0; j < 4; ++j) { const int c0 = 4 * lane + 256 * j;
                const f32x4 gt = *(const LAS f32x4*)(GT + ti + c0), sh = *(const LAS f32x4*)(ST + ti + c0);
                const f32x4 h = hx[r][j] * rinv * gt + sh; hx[r][j] = h;
                if (vld[r]) { v2u o; o.x = pk2(h.x, h.y); o.y = pk2(h.z, h.w); *(GAS v2u*)(H + (size_t)row * D + c0) = o; } }
        }
#pragma unroll
        for (int r = 0; r < 3; ++r)
#pragma unroll
            for (int j = 0; j < 4; ++j) asm volatile("" : "+v"(hx[r][j]));
        typedef float f32x2 __attribute__((ext_vector_type(2)));
        float acc[3][16];
#pragma unroll
        for (int e = 0; e < 16; ++e) {
            f32x2 a2[3] = {{0.f, 0.f}, {0.f, 0.f}, {0.f, 0.f}};
#pragma unroll
            for (int j = 0; j < 4; ++j) { const f32x4 w = *(const LAS f32x4*)(WRT + e * WRS + 4 * lane + 256 * j); const f32x2 wl = {w.x, w.y}, wh = {w.z, w.w};
#pragma unroll
                for (int r = 0; r < 3; ++r) { const f32x2 xl = {hx[r][j].x, hx[r][j].y}, xh = {hx[r][j].z, hx[r][j].w}; a2[r] = __builtin_elementwise_fma(xl, wl, a2[r]); a2[r] = __builtin_elementwise_fma(xh, wh, a2[r]); } }
#pragma unroll
            for (int r = 0; r < 3; ++r) acc[r][e] = a2[r].x + a2[r].y;
            asm volatile("" : "+v"(acc[0][e]), "+v"(acc[1][e]), "+v"(acc[2][e]) :: "memory");
        }
        float tot3[3];
#pragma unroll
        for (int r = 0; r < 3; ++r) tot3[r] = reduce16(acc[r], lane);
        { const int q = lane >> 4, e = lane & 15, g = e >> 2, jp = e & 3;
          const float val = q == 0 ? tot3[0] : (q == 1 ? tot3[1] : tot3[2]);
          const float sg = sigmoid_f(val), sb = sg + rb_lane;
          const float va = DPPF(sb, 0x4E), vb = DPPF(sb, 0xB1), vc = DPPF(sb, 0x1B);
          const float hi1 = fmaxf(sb, va), lo1 = fminf(sb, va), hi2 = fmaxf(vb, vc), lo2 = fminf(vb, vc);
          const float gs = fmaxf(hi1, hi2) + fmaxf(fminf(hi1, hi2), fmaxf(lo1, lo2));
          const float gb = DPPF(gs, 0x141), gc = DPPF(gs, 0x140), ga = DPPF(gb, 0x140);
          float bestv = gs; int bestg = g;
          { const int ia = g ^ 2; if (ga > bestv || (ga == bestv && ia < bestg)) { bestv = ga; bestg = ia; } }
          { const int ib = g ^ 1; if (gb > bestv || (gb == bestv && ib < bestg)) { bestv = gb; bestg = ib; } }
          { const int ic = g ^ 3; if (gc > bestv || (gc == bestv && ic < bestg)) { bestv = gc; bestg = ic; } }
          const int rank = ((va > sb || (va == sb && (jp ^ 2) < jp)) ? 1 : 0) + ((vb > sb || (vb == sb && (jp ^ 1) < jp)) ? 1 : 0) + ((vc > sb || (vc == sb && (jp ^ 3) < jp)) ? 1 : 0);
          if (q < 3 && g == bestg && rank < 2) { LGS[((F.wave * 3 + q) * 2 + rank) * 2] = __builtin_bit_cast(float, e); LGS[((F.wave * 3 + q) * 2 + rank) * 2 + 1] = sg; } }
        LDS_WAIT(); asm volatile("" ::: "memory");
        if ((lane & 15) == 0 && (lane >> 4) < 3 && g0 + (lane >> 4) < rpw) { const int q = lane >> 4;
            const LAS float* sl = LGS + (F.wave * 3 + q) * 4;
            const int e0 = __builtin_bit_cast(int, sl[0]), e1 = __builtin_bit_cast(int, sl[2]); const float s0 = sl[1], s1 = sl[3];
            const int rl = F.wave * rpw + g0 + q, row = F.bid * rpb + rl;
            const float wsum = s0 + s1;
            WTS[row * 2] = s0 / wsum; WTS[row * 2 + 1] = s1 / wsum;
            const int p0 = __hip_atomic_fetch_add(CNT + e0, 1, __ATOMIC_RELAXED, __HIP_MEMORY_SCOPE_WORKGROUP);
            const int p1 = __hip_atomic_fetch_add(CNT + e1, 1, __ATOMIC_RELAXED, __HIP_MEMORY_SCOPE_WORKGROUP);
            ASG[rl * 4 + 0] = e0; ASG[rl * 4 + 1] = p0; ASG[rl * 4 + 2] = e1; ASG[rl * 4 + 3] = p1;
        }
        LDS_WAIT(); asm volatile("" ::: "memory");
    }
    __syncthreads();
    gu32* ecnt = (gu32*)(ws + WS_CTL) + CW_ECNT + l * NE * 64;
    if (F.tid < NE) BASE[F.tid] = (int)__hip_atomic_fetch_add(ecnt + F.tid * 64, (unsigned)CNT[F.tid], __ATOMIC_RELAXED, __HIP_MEMORY_SCOPE_AGENT);
    __syncthreads();
    int* LIST = (int*)(ws + WS_LIST); int* TOK = (int*)(ws + WS_TOK);
    if (F.tid < rpb) { const int row = F.bid * rpb + F.tid;
#pragma unroll
        for (int k = 0; k < 2; ++k) { const int e = ASG[F.tid * 4 + 2 * k], p = ASG[F.tid * 4 + 2 * k + 1] + BASE[e]; LIST[e * NT + p] = row; TOK[row * 2 + k] = e | (p << 4); } }
}
enum { PH_PRO = 0, PH_N1 = 0, PH_GIN = 1, PH_G1 = 2, PH_G2 = 3, PH_G3 = 4, PH_GOUT = 5, PH_R2 = 6, PH_GUP = 7, PH_GDN = 8, PH_PER_LAYER = 9, PH_FINAL = 1 + 9 * DEPTH, PH_END = PH_FINAL + 1 };

__global__ void __launch_bounds__(NTHR, 2) mega_fwd(Args args_unused) {
    LAS unsigned char* const lds = (LAS unsigned char*)lds_raw;
    volatile LAS unsigned* MISC = (volatile LAS unsigned*)(lds + MISC_OFF);
    for (int u = threadIdx.x; u < (LDS_BYTES - LDSCTL_OFF) / 4; u += NTHR) ((LAS unsigned*)(lds + LDSCTL_OFF))[u] = 0u;
    __syncthreads();
    int lo, hi; bool comb_en; unsigned* barw;
    bool probe16;
    { KArgs A = kargs(); lo = A->ph_lo; hi = A->ph_hi; comb_en = (A->flags & 1) != 0; probe16 = (A->flags & 16) != 0; if (probe16) comb_en = true; barw = (unsigned*)(A->ws + WS_CTL) + CW_BAR; }
    const bool multi = (hi - lo) > 1;
    XcdBarrier bar; bar.bar = barw; bar.x = 0; bar.st = nullptr;
    if (multi) bar = xcd_barrier_post(barw, MISC + 8);
    for (int ph = lo; ph < hi; ++ph) {
        if (ph == PH_PRO) {
            p0_prologue();
        } else if (ph == PH_FINAL) {
            rowpass_n1<true, false>(DEPTH, comb_en, NX, false);
        } else {
            const int l = (ph - 1) / PH_PER_LAYER, s = (ph - 1) % PH_PER_LAYER;
            const bool keep = l < DEPTH - 1;
            if (s == PH_N1) {
                if (l > 0) convert_from_cursor(l, -1);
                if (l == 0 && !probe16) rowpass_n1<false, true>(l, false, NT, false); else rowpass_n1<false, false>(l, comb_en && l > 0, NT, probe16);
            } else if (s == PH_GIN || s == PH_GOUT || s == PH_GUP || s == PH_GDN) {
                KArgs A = kargs(); unsigned char* const ws = A->ws;
                const LAS int* tab = (const LAS int*)(lds + LDSCTL_OFF);
                pg8::GCfg S; S.list = (const int*)(ws + WS_LIST); S.tab = tab; S.amode = 0; S.bmode = 0; S.bexp = 0; S.K = D; S.Abase = (const char*)(ws + WS_HB);
                S.O = nullptr; S.ldc = 0; S.xl = nullptr; S.xc = nullptr; S.MODl = nullptr; S.gidx = 0; S.gscale = (A->flags & 8) ? 0.f : 1.f;
                int nM, nN;
                if (s == PH_GIN) { nM = NT / 256; nN = PLD / 256; S.Bbase = (const char*)(ws + WS_WIN) + (size_t)l * PLD * D * 2; S.emode = 0; S.O = (bf16_t*)(ws + WS_P); S.ldc = PLD; }
                else if (s == PH_GOUT) { nM = (keep ? NT : NX) / 256; nN = D / 256; S.Bbase = (const char*)(ws + WS_WOUT) + (size_t)l * D * D * 2; S.emode = 1;
                    S.O = (bf16_t*)(ws + WS_XB); S.MODl = (const float*)(ws + WS_MOD) + (size_t)l * 9 * 6144; S.gidx = 2; }
                else {
                    { LAS int* t = (LAS int*)(lds + LDSCTL_OFF); const gu32* ec = (const gu32*)(ws + WS_CTL) + CW_ECNT + l * NE * 64;
                      if (threadIdx.x < 64) {
                          const int ln = (int)threadIdx.x; const int cnt = ln < NE ? (int)__hip_atomic_load(ec + ln * 64, RLX_AGENT) : 0; const int tl = (cnt + 255) >> 8; int inc = tl;
#pragma unroll
                          for (int o = 1; o < 16; o <<= 1) { const int v = __shfl_up(inc, o, 16); if ((ln & 15) >= o) inc += v; }
                          if (ln < NE) { t[32 + ln] = cnt; t[ln] = inc - tl; if (ln == NE - 1) t[16] = inc; } }
                      __syncthreads(); }
                    nM = tab[16]; nN = 4; S.bmode = 1;
                    if (s == PH_GUP) { S.amode = 1; S.Bbase = (const char*)(ws + WS_W13) + (size_t)l * NE * 1024 * D * 2; S.bexp = (size_t)1024 * D * 2; S.emode = 2; S.O = (bf16_t*)(ws + WS_HID); S.ldc = DE; }
                    else { S.K = DE; S.Abase = (const char*)(ws + WS_HID); S.Bbase = (const char*)(ws + WS_W2) + (size_t)l * NE * D * DE * 2; S.bexp = (size_t)D * DE * 2; S.emode = 0; S.O = (bf16_t*)(ws + WS_P); S.ldc = D; }
                }
                S.T.init(nM, nN, gridDim.x, blockIdx.x);
                pg8::gemm_phase(lds, S);
                if (keep) {
                    const int nwg = nM * nN, G = (int)gridDim.x, c = (int)blockIdx.x;
                    const int rounds = (nwg + G - 1) / G, mine = c < nwg ? (nwg - c + G - 1) / G : 0;
                    if (mine < rounds) convert_from_cursor(l + 1, s == PH_GDN ? 2 : 3);
                }
            }
#ifdef HAVE_GLA
            else if (s == PH_G1) { gla_phase1(l); }
            else if (s == PH_G2) { gla_phase2(l); }
            else if (s == PH_G3) { gla_phase3(l); }
#endif
#ifdef HAVE_MOE
            else if (s == PH_R2) { router_phase(l, keep ? NT : NX); }
#endif
        }
        if (ph + 1 < hi) {
            xcd_barrier(bar);
#ifdef PROBE_BAR2
            xcd_barrier(bar);
#endif
        }
    }
}

static bool g_init_done = false;
static void launch_mega(const In& I, float* out, unsigned char* ws, int lo, int hi, int flags, hipStream_t st) {
    if (!g_init_done) { (void)hipFuncSetAttribute((const void*)mega_fwd, hipFuncAttributeMaxDynamicSharedMemorySize, LDS_BYTES); g_init_done = true; }
    Args a{}; a.in = I; a.out = out; a.ws = ws; a.ph_lo = lo; a.ph_hi = hi; a.flags = flags; a.pad = 0;
    hipLaunchKernelGGL(mega_fwd, dim3(256), dim3(NTHR), LDS_BYTES, st, a);
}

#ifndef FUSED
#ifndef OPT_PRO
#define OPT_PRO 1
#endif
#ifndef OPT_A
#define OPT_A 1
#endif
#ifndef OPT_B
#define OPT_B 0
#endif
#ifndef OPT_C
#define OPT_C 1
#endif
#ifndef OPT_D
#define OPT_D 0
#endif
static void run_hybrid(const In& I, float* out, unsigned char* ws, hipStream_t st) {
    float* xc = (float*)(ws + WS_XC); float* MOD = (float*)(ws + WS_MOD); bf16_t* HB = (bf16_t*)(ws + WS_HB); bf16_t* P = (bf16_t*)(ws + WS_P);
    float* OF = (float*)(ws + WS_KVS); float* OB = (float*)(ws + WS_HID); float* HIDN = (float*)(ws + WS_P);
    int* EIDX = (int*)(ws + WS_NEIDX); float* WTSN = (float*)(ws + WS_NWTS);
    (void)hipMemsetAsync(ws + WS_CTL, 0, CTL_BYTES, st);
    const int flags = OPT_D ? 1 : 0;
    if (OPT_PRO) launch_mega(I, out, ws, PH_PRO, PH_PRO + 1, flags, st);
    else nv::k_mod<<<(DEPTH * 6144 + 255) / 256, 256, 0, st>>>(I.c, I.c_ctx, I.w_mod, I.b_mod, MOD);
    if (!OPT_A) { (void)hipMemcpyAsync(out, I.x, (size_t)NX * D * 4, hipMemcpyDeviceToDevice, st); (void)hipMemcpyAsync(xc, I.ctx, (size_t)NC * D * 4, hipMemcpyDeviceToDevice, st); }
    for (int l = 0; l < DEPTH; ++l) {
        const bool keep = l < DEPTH - 1; const int Mo = keep ? NT : NX;
        const float* MODl = MOD + (size_t)l * 9 * 6144;
        const int pb = 1 + l * PH_PER_LAYER;
        if (OPT_A) { launch_mega(I, out, ws, pb + PH_N1, pb + PH_N1 + 1, flags, st); launch_mega(I, out, ws, pb + PH_GIN, pb + PH_GIN + 1, flags, st); }
        else {
            if (OPT_D && l > 0) launch_mega(I, out, ws, pb + PH_N1, pb + PH_N1 + 1, flags, st);
            nv::k_normmod<<<NT, 256, 0, st>>>(out, xc, I.norm1 + l * D, MODl, 0, 1, HB, NT);
            nv::k_gemm<<<dim3((INW + 63) / 64, NT / 64), 256, 0, st>>>(HB, D, I.w_in + (size_t)l * D * INW, INW, P, PLD, NT, INW, D, 0, nullptr, 0, nullptr, nullptr, 512, 768);
        }
        if (OPT_B) { for (int s = PH_G1; s <= PH_G3; ++s) launch_mega(I, out, ws, pb + s, pb + s + 1, flags, st); }
        else {
            nv::k_gla<<<NB * 4, 256, 0, st>>>(P, I.w_gk2 + (size_t)l * 2 * 16 * 256, I.b_gk + (size_t)l * 2 * 256, OF, OB);
            nv::k_pool<<<NT, 512, 0, st>>>(P, I.w_pool + (size_t)l * 4 * 128 * 128, I.pool_scale + l * 512, HB);
            nv::k_glaout<<<NT, 512, 0, st>>>(P, OF, OB, I.gla_gain + l * 128, HB);
        }
        if (OPT_C) launch_mega(I, out, ws, pb + PH_GOUT, pb + PH_GOUT + 1, flags, st);
        else nv::k_gemm<<<dim3(D / 64, Mo / 64), 256, 0, st>>>(HB, D, I.w_out + (size_t)l * D * D, D, nullptr, 0, Mo, D, D, 1, MODl, 2, out, xc, 0, 0);
        if (OPT_D) { for (int s = PH_R2; s <= PH_GDN; ++s) launch_mega(I, out, ws, pb + s, pb + s + 1, flags, st); }
        else {
            nv::k_normmod<<<Mo, 256, 0, st>>>(out, xc, I.norm2 + l * D, MODl, 3, 4, HB, Mo);
            nv::k_router<<<Mo, 64, 0, st>>>(out, xc, I.norm2 + l * D, MODl, I.w_router, I.router_bias, EIDX, WTSN, Mo);
            nv::k_moe_up<<<Mo * 2, 512, 0, st>>>(HB, EIDX, I.w1 + (size_t)l * NE * D * DE, I.w3 + (size_t)l * NE * D * DE, HIDN);
            nv::k_moe_down_combine<<<Mo, 256, 0, st>>>(HIDN, EIDX, WTSN, I.w2 + (size_t)l * NE * DE * D, MODl, out, xc);
        }
    }
    if (OPT_D) launch_mega(I, out, ws, PH_FINAL, PH_FINAL + 1, flags, st);
    else nv::k_final<<<NX, 256, 0, st>>>(out, I.norm_f);
}

#endif
extern "C" void kernel_launch(void* const* d_in, const int* in_sizes, int n_in, void* d_out, int out_size, void* d_ws, size_t ws_size, hipStream_t stream) {
    In I;
    const float** f = (const float**)&I;
    for (int i = 0; i < 21; ++i) f[i] = (const float*)d_in[i];
    if (ws_size < WS_END) { fprintf(stderr, "ws too small: %zu < %zu\n", ws_size, (size_t)WS_END); return; }
#ifdef FUSED
    (void)hipMemsetAsync((unsigned char*)d_ws + WS_CTL, 0, CTL_BYTES, stream);
    launch_mega(I, (float*)d_out, (unsigned char*)d_ws, 0, PH_END, 1, stream);
#ifndef PROBE_FLAGS
#define PROBE_FLAGS 0
#endif
#ifdef PROBE_KIND
    if (PROBE_KIND < 0) launch_mega(I, (float*)d_out, (unsigned char*)d_ws, PH_PRO, PH_PRO + 1, 0, stream);
    else for (int l = 0; l < DEPTH; ++l) launch_mega(I, (float*)d_out, (unsigned char*)d_ws, 1 + l * PH_PER_LAYER + PROBE_KIND, 1 + l * PH_PER_LAYER + PROBE_KIND + 1, PROBE_FLAGS, stream);
#endif
#else
    run_hybrid(I, (float*)d_out, (unsigned char*)d_ws, stream);
#endif
}
```

```cpp
#define FUSED 1
#include <hip/hip_runtime.h>
#include <cstdio>
#include <cstdint>
typedef unsigned short bf16_t;
constexpr int D = 1024, NB = 8, SEQ = 2048, DEPTH = 4, CTXL = 256;
constexpr int NX = NB * SEQ, NC = NB * CTXL, NT = NX + NC;
constexpr int INW = 2080, PLD = 2304, NE = 16, DE = 512;
constexpr int NCH = 36;
constexpr int MAXSLOT = 41216;
constexpr size_t MiB = 1u << 20;
constexpr size_t WS_CTL = 0, CTL_BYTES = 1 * MiB;
constexpr size_t WS_MOD = 1 * MiB;
constexpr size_t WS_WPOOL = 2 * MiB;
constexpr size_t WS_WGP = 2 * MiB + 512 * 1024;
constexpr size_t WS_WRP = 2 * MiB + 640 * 1024;
constexpr size_t WS_TOK = 3 * MiB;
constexpr size_t WS_WTS = 3 * MiB + 256 * 1024;
constexpr size_t WS_NEIDX = 3 * MiB + 512 * 1024;
constexpr size_t WS_NWTS = 3 * MiB + 768 * 1024;
constexpr size_t WS_LIST = 4 * MiB;
constexpr size_t WS_WIN = 6 * MiB;
constexpr size_t WS_WOUT = 24 * MiB;
constexpr size_t WS_W13 = 32 * MiB;
constexpr size_t WS_W2 = 160 * MiB;
constexpr size_t WS_XC = 224 * MiB;
constexpr size_t WS_HB = 232 * MiB;
constexpr size_t WS_P = 268 * MiB;
constexpr size_t WS_KVS = 349 * MiB;
constexpr size_t WS_ADEC = 385 * MiB;
constexpr size_t WS_HID = 386 * MiB;
constexpr size_t WS_XB = 427 * MiB;
constexpr size_t WS_END = 463 * MiB;

struct In {
    const float *x, *c, *ctx, *c_ctx, *w_mod, *b_mod, *norm1, *norm2, *w_in, *w_gk2, *b_gk, *w_pool, *pool_scale, *gla_gain, *w_out, *w_router, *router_bias, *w1, *w3, *w2, *norm_f;
};

__host__ __device__ __forceinline__ unsigned f2bf(float f) { unsigned u = __builtin_bit_cast(unsigned, f); return (u + 0x7fffu + ((u >> 16) & 1u)) >> 16; }
__host__ __device__ __forceinline__ float bf2f(bf16_t h) { return __builtin_bit_cast(float, (unsigned)h << 16); }
typedef float pk2_f32x2 __attribute__((ext_vector_type(2)));
typedef __bf16 pk2_bf16x2 __attribute__((ext_vector_type(2)));
__device__ __forceinline__ unsigned pk2(float lo, float hi) { const pk2_f32x2 v = {lo, hi}; return __builtin_bit_cast(unsigned, __builtin_convertvector(v, pk2_bf16x2)); }
__device__ __forceinline__ float silu_f(float x) { return x / (1.f + expf(-x)); }
__device__ __forceinline__ float sigmoid_f(float x) { return 1.f / (1.f + expf(-x)); }
__device__ __forceinline__ float logsigmoid_f(float x) { return fminf(x, 0.f) - log1pf(expf(-fabsf(x))); }
__device__ __forceinline__ int variant_of_row(int row) { return row < NX ? (row >> 11) : 8; }
__device__ __forceinline__ float* resid_row(float* xl, float* xc, int row) { return row < NX ? xl + (size_t)row * D : xc + (size_t)(row - NX) * D; }
__device__ __forceinline__ int chunk_row0(int b, int j) { return j < 4 ? NX + b * CTXL + j * 64 : b * SEQ + (j - 4) * 64; }
#define GAS __attribute__((address_space(1)))
#define LAS __attribute__((address_space(3)))
typedef unsigned v4u __attribute__((ext_vector_type(4)));
typedef unsigned v2u __attribute__((ext_vector_type(2)));
typedef float f32x4 __attribute__((ext_vector_type(4)));
typedef float f32x16 __attribute__((ext_vector_type(16)));
typedef short bf16x8 __attribute__((ext_vector_type(8)));
typedef GAS unsigned gu32;
#define RLX_AGENT __ATOMIC_RELAXED, __HIP_MEMORY_SCOPE_AGENT
#define LDS_WAIT() asm volatile("s_waitcnt lgkmcnt(0)" ::: "memory")
#define VM_WAIT() asm volatile("s_waitcnt vmcnt(0)" ::: "memory")
constexpr int NWAVES = 8, NTHR = 512;
constexpr int RING_BYTES = 131072;
constexpr int LDSCTL_OFF = RING_BYTES, MISC_OFF = LDSCTL_OFF + 320;
constexpr int LDS_BYTES = 147456;
constexpr int CW_BAR = 4096;
constexpr int CW_ECNT = 8192;
constexpr int CW_CVT = 16384;

__device__ __forceinline__ float wave_sum(float v) {
    v += __builtin_bit_cast(float, __builtin_amdgcn_update_dpp(0, __builtin_bit_cast(int, v), 0xB1, 0xF, 0xF, true));
    v += __builtin_bit_cast(float, __builtin_amdgcn_update_dpp(0, __builtin_bit_cast(int, v), 0x4E, 0xF, 0xF, true));
    v += __builtin_bit_cast(float, __builtin_amdgcn_update_dpp(0, __builtin_bit_cast(int, v), 0x141, 0xF, 0xF, true));
    v += __builtin_bit_cast(float, __builtin_amdgcn_update_dpp(0, __builtin_bit_cast(int, v), 0x140, 0xF, 0xF, true));
    const int iv = __builtin_bit_cast(int, v);
    const float r0 = __builtin_bit_cast(float, __builtin_amdgcn_readlane(iv, 0)), r1 = __builtin_bit_cast(float, __builtin_amdgcn_readlane(iv, 16));
    const float r2 = __builtin_bit_cast(float, __builtin_amdgcn_readlane(iv, 32)), r3 = __builtin_bit_cast(float, __builtin_amdgcn_readlane(iv, 48));
    return (r0 + r1) + (r2 + r3);
}

#define XB_TMO      128
#define XB_XCNT(j)  (256  + 64 * (j))
#define XB_XSUB(j)  (1280 + 64 * (j))
#define XB_XGEN(j)  (2304 + 64 * (j))
#define XB_TOP      3328
#define XB_TOPGEN   3392
#define XB_LSUB(j)  (3456 + 16 * (j))
#define XB_LGEN(j)  (3712 + 16 * (j))
#define XCD_BAR_WORDS 3968
#define XB_SPIN_CAP (1u << 18)
__device__ __forceinline__ unsigned xb_ld(unsigned* p)              { return __hip_atomic_load(p, __ATOMIC_RELAXED, __HIP_MEMORY_SCOPE_AGENT); }
__device__ __forceinline__ unsigned xb_add(unsigned* p, unsigned v) { return __hip_atomic_fetch_add(p, v, __ATOMIC_RELAXED, __HIP_MEMORY_SCOPE_AGENT); }
__device__ __forceinline__ unsigned xb_xcc_id() { return (unsigned)__builtin_amdgcn_s_getreg((3 << 11) | 20) & 0xFu; }
#define XB_SPIN(cond, bar) do { unsigned _sp = 0; while (cond) { __builtin_amdgcn_s_sleep(1); \
    if ((++_sp & 255u) == 0u) { if (xb_ld(&(bar)[XB_TMO])) break; if (_sp > XB_SPIN_CAP) { atomicAdd(&(bar)[XB_TMO], 1u); break; } } } } while (0)
struct XcdBarrier { unsigned* bar; unsigned x; volatile LAS unsigned* st; };
__device__ __forceinline__ XcdBarrier xcd_barrier_post(unsigned* bar, volatile LAS unsigned* st) {
    XcdBarrier b; b.bar = bar; b.x = xb_xcc_id(); b.st = st;
    if (threadIdx.x == 0) st[6] = xb_add(&bar[XB_XCNT(b.x)], 1u);
    return b;
}
__device__ __forceinline__ void xcd_barrier(const XcdBarrier& b) {
    asm volatile("s_waitcnt vmcnt(0)" ::: "memory");
    __syncthreads();
    if (threadIdx.x < 64 && b.st[0] == 0u) {
        unsigned* bar = b.bar; const unsigned G = gridDim.x * gridDim.y * gridDim.z; const int lane = threadIdx.x; unsigned sp = 0u, c, sum, cnt;
        for (;;) {
            c = lane < 16 ? xb_ld(&bar[XB_XCNT(lane)]) : 0u; sum = c; cnt = c > 0u ? 1u : 0u;
#pragma unroll
            for (int o = 1; o < 16; o <<= 1) { sum += __shfl_xor(sum, o); cnt += __shfl_xor(cnt, o); }
            sum = __builtin_amdgcn_readfirstlane(sum); cnt = __builtin_amdgcn_readfirstlane(cnt);
            if (sum == G) break;
            __builtin_amdgcn_s_sleep(1);
            if ((++sp & 255u) == 0u) { if (__builtin_amdgcn_readfirstlane(xb_ld(&bar[XB_TMO]))) break; if (sp > XB_SPIN_CAP) { if (lane == 0) atomicAdd(&bar[XB_TMO], 1u); break; } }
        }
        const unsigned mine = __builtin_amdgcn_readlane(c, b.x);
        const unsigned long long popm = __ballot(c > 0u), badm = __ballot(c != 0u && c != 32u);
        if (lane == 0) { b.st[0] = mine > 0u ? mine : 1u; b.st[1] = cnt > 0u ? cnt : 1u;
            const bool uni = (badm == 0ull) && (cnt == 8u) && (G == 256u);
            const unsigned xidx = (unsigned)__builtin_popcountll(popm & ((1ull << b.x) - 1ull));
            b.st[4] = uni ? xidx * 32u + b.st[6] : (unsigned)blockIdx.x; b.st[5] = uni ? 1u : 0u; }
        asm volatile("s_waitcnt lgkmcnt(0)" ::: "memory");
    }
    if (threadIdx.x == 0) {
        unsigned* bar = b.bar;
        __builtin_amdgcn_s_waitcnt(0);
        const unsigned nloc = b.st[0], nx = b.st[1];
        const unsigned old = xb_add(&bar[XB_XSUB(b.x)], 1u);
        const unsigned gen = old / nloc;
        if (old + 1u == (gen + 1u) * nloc) {
            __builtin_amdgcn_fence(__ATOMIC_RELEASE, "agent");
            asm volatile("s_waitcnt vmcnt(0)" ::: "memory");
            unsigned og;
            { unsigned* tp = &bar[XB_TOP]; const unsigned one = 1u;
              asm volatile("global_atomic_add %0, %1, %2, off sc0\n\tbuffer_inv sc1\n\ts_waitcnt vmcnt(0)" : "=&v"(og) : "v"(tp), "v"(one) : "memory"); }
            const unsigned tg = og / nx;
            if (og + 1u == (tg + 1u) * nx) xb_add(&bar[XB_TOPGEN], 1u);
            else XB_SPIN(xb_ld(&bar[XB_TOPGEN]) == tg, bar);
            xb_add(&bar[XB_XGEN(b.x)], 1u);
        } else {
            asm volatile("buffer_inv sc1" ::: "memory");
            XB_SPIN(xb_ld(&bar[XB_XGEN(b.x)]) == gen, bar);
            asm volatile("s_waitcnt vmcnt(0)" ::: "memory");
        }
    }
    __syncthreads();
}

__device__ __forceinline__ void xcd_barrier_local(const XcdBarrier& b) {
    asm volatile("s_waitcnt vmcnt(0)" ::: "memory");
    __syncthreads();
    if (threadIdx.x == 0) {
        unsigned* bar = b.bar;
        __builtin_amdgcn_s_waitcnt(0);
        const unsigned nloc = b.st[0], k = b.st[7]; b.st[7] = k + 1u;
        unsigned old;
        { unsigned* xp = &bar[XB_LSUB(b.x)]; const unsigned one = 1u;
          asm volatile("global_atomic_add %0, %1, %2, off sc0\n\tbuffer_inv sc1\n\ts_waitcnt vmcnt(1)" : "=&v"(old) : "v"(xp), "v"(one) : "memory"); }
        if (old + 1u == (k + 1u) * nloc) xb_add(&bar[XB_LGEN(b.x)], 1u);
        else XB_SPIN(xb_ld(&bar[XB_LGEN(b.x)]) == k, bar);
        asm volatile("s_waitcnt vmcnt(0)" ::: "memory");
    }
    __syncthreads();
}

namespace pg8 {
constexpr int BM = 256, BK = 64, HALF = 128, HTB = HALF * BK * 2, STAGE_BYTES = 8 * HTB, NXCD = 8, WGM = 8;
__host__ __device__ __forceinline__ int lds_byte(int r, int c) { const int st = (r >> 4) * 2 + (c >> 5), rr = r & 15, cc = c & 31, ob = rr * 64 + cc * 2; return st * 1024 + (ob ^ (((ob >> 9) & 1) << 5)); }
__host__ __device__ __forceinline__ void stage_rc(int b, int& R, int& C) { const int st = b / 1024, sb = b % 1024, swz = sb ^ (((sb >> 9) & 1) << 5); R = (st >> 1) * 16 + swz / 64; C = (st & 1) * 32 + (swz % 64) / 2; }
__host__ __device__ __forceinline__ int perm32(int rho) { const int n = rho >> 4, i = rho & 15; return 8 * (i >> 2) + 4 * n + (i & 3); }

struct Unit { int pm, pn, e, ti, h, half; };

struct TileOrder {
    int nM, nN, nwg, G, c, npm, rev, split;
    __device__ void init(int nM_, int nN_, int G_, int c_, int npm_, int rev_, int split_) { nM = nM_; nN = nN_; nwg = nM * nN; G = G_; c = c_; npm = npm_; rev = rev_; split = split_; }
    __device__ bool tile(int i, int& pm, int& pn, int& h, int& half) const {
        h = 0; half = 0;
        if (npm < 0) {
            const int x = c >> 5, t0 = x * nM / 8, nt = (x + 1) * nM / 8 - t0, L = i * 32 + (c & 31); if (L >= nt * nN) return false;
            pm = rev ? t0 + nt - 1 - L / nN : t0 + L / nN; pn = L % nN; return true; }
        if (npm > 0) { const int x = c >> 5, L = i * 32 + (c & 31);
            if (split && L >= (npm - 1) * nN) { const int hl = L - (npm - 1) * nN; if (hl >= 2 * nN) return false; pn = hl >> 1; h = hl & 1; half = 1; pm = 64 + x; return true; }
            if (L >= npm * nN) return false;
            const int pml = L / nN; pn = L % nN; pm = pml < 8 ? 8 * x + pml : 64 + x; return true; }
        const long L = (long)i * G + c; if (L >= nwg) return false;
        int wgid = (int)L; { const int q = nwg / NXCD, r = nwg % NXCD, xcd = wgid % NXCD, off = wgid / NXCD; wgid = (xcd < r ? xcd * (q + 1) : r * (q + 1) + (xcd - r) * q) + off; }
        const int nig = WGM * nN, gid = wgid / nig, fm = gid * WGM, gsz = (nM - fm) < WGM ? (nM - fm) : WGM;
        pm = fm + ((wgid % nig) % gsz); pn = (wgid % nig) / gsz; return true;
    }
};
struct GCfg {
    TileOrder T; const char* Abase; const char* Bbase; int K; int amode, bmode; size_t bexp; const int* list; const LAS int* tab;
    int emode;
    bf16_t* O; int ldc;
    float* xl; float* xc; const float* MODl; int gidx; float gscale;
    __device__ __forceinline__ void units_of_lane(int i, int& upk, int& epk) const {
        Unit u; u.e = 0; u.ti = 0; u.h = 0; u.half = 0; const bool ok = (i < 8) && T.tile(i, u.pm, u.pn, u.h, u.half);
        if (ok && bmode) { int e = 0;
#pragma unroll
            for (int j = 1; j < 16; ++j) e += (u.pm >= tab[j]) ? 1 : 0;
            u.e = e; u.ti = u.pm - tab[e]; }
        upk = ok ? (u.pm | (u.pn << 16) | (u.h << 20) | (u.half << 21)) : -1; epk = u.e | (u.ti << 16); }
    __device__ __forceinline__ bool next(int i, Unit& u, int upk_v, int epk_v) const {
        const int a = __builtin_amdgcn_readlane(upk_v, i), b = __builtin_amdgcn_readlane(epk_v, i);
        u.pm = a & 0xffff; u.pn = (a >> 16) & 15; u.h = (a >> 20) & 1; u.half = (a >> 21) & 1; u.e = b & 0xffff; u.ti = (b >> 16) & 0xffff;
        return a >= 0; }
    __device__ __forceinline__ const char* b_base(const Unit& u) const { return Bbase + (size_t)u.e * bexp + (size_t)u.pn * BM * K * 2; }
    __device__ __forceinline__ void a_rows_to_lds(const Unit& u, int R0, int R1, LAS unsigned* slot, int lane) const {
        if (amode) { const int cnt = tab[32 + u.e]; const int* lp = list + u.e * NT; const int base = u.ti * BM;
            int p00 = base + R0, p01 = base + R1, p10 = base + HALF + R0, p11 = base + HALF + R1;
            p00 = p00 < cnt ? p00 : cnt - 1; p01 = p01 < cnt ? p01 : cnt - 1; p10 = p10 < cnt ? p10 : cnt - 1; p11 = p11 < cnt ? p11 : cnt - 1;
            __builtin_amdgcn_global_load_lds((const unsigned*)(lp + p00), slot, 4, 0, 0); __builtin_amdgcn_global_load_lds((const unsigned*)(lp + p01), slot + 64, 4, 0, 0);
            __builtin_amdgcn_global_load_lds((const unsigned*)(lp + p10), slot + 128, 4, 0, 0); __builtin_amdgcn_global_load_lds((const unsigned*)(lp + p11), slot + 192, 4, 0, 0);
        } else { const unsigned r = (unsigned)(u.pm * BM + u.h * HALF); slot[lane] = r + R0; slot[64 + lane] = r + R1; slot[128 + lane] = r + HALF + R0; slot[192 + lane] = r + HALF + R1; }
    }
    __device__ __forceinline__ unsigned a_off(const Unit& u, int h, int R, int C) const {
        if (amode) { const int cnt = tab[32 + u.e]; int pos = u.ti * BM + h * HALF + R; pos = pos < cnt ? pos : cnt - 1; const int src = list[u.e * NT + pos]; return (unsigned)((src * K + C) * 2); }
        return (unsigned)(((u.pm * BM + (u.h + h) * HALF + R) * K + C) * 2); }
    __device__ __forceinline__ bool perm() const { return emode != 2; }
    __device__ __forceinline__ void epi(const f32x4 (&acc)[2][2][4][2], const Unit& u, int wr, int wc, int fr, int fq) const {
        if (emode == 0) {
            const int row0 = u.pm * BM + u.h * HALF + wr * 64 + fr; const int col0 = u.pn * BM + wc * 32 + 8 * fq;
#pragma unroll
            for (int ai = 0; ai < 2; ++ai) if (ai == 0 || !u.half)
#pragma unroll
                for (int m = 0; m < 4; ++m) { bf16_t* rowp = O + (size_t)(row0 + ai * HALF + m * 16) * ldc + col0;
#pragma unroll
                    for (int bj = 0; bj < 2; ++bj) { const f32x4 v0 = acc[ai][bj][m][0], v1 = acc[ai][bj][m][1];
                        v4u w; w.x = pk2(v0[0], v0[1]); w.y = pk2(v0[2], v0[3]); w.z = pk2(v1[0], v1[1]); w.w = pk2(v1[2], v1[3]);
                        *(v4u*)(rowp + bj * HALF) = w; } }
        } else if (emode == 1) {
            const int rowt = u.pm * BM; const int v = rowt < NX ? (rowt >> 11) : 8;
            const float* gate = MODl + (size_t)v * 6144 + gidx * D; const float gsc = gscale;
            const int row0 = rowt + u.h * HALF + wr * 64 + fr; const int col0 = u.pn * BM + wc * 32 + 8 * fq;
            f32x4 gv[2][2];
#pragma unroll
            for (int bj = 0; bj < 2; ++bj)
#pragma unroll
                for (int n = 0; n < 2; ++n) gv[bj][n] = *(const f32x4*)(gate + col0 + bj * HALF + 4 * n) * gsc;
#pragma unroll
            for (int ai = 0; ai < 2; ++ai) if (ai == 0 || !u.half) {
                v4u xw[4][2];
#pragma unroll
                for (int m = 0; m < 4; ++m)
#pragma unroll
                    for (int bj = 0; bj < 2; ++bj) xw[m][bj] = *(const v4u*)(O + (size_t)(row0 + ai * HALF + m * 16) * D + col0 + bj * HALF);
#pragma unroll
                for (int m = 0; m < 4; ++m) { bf16_t* rowp = O + (size_t)(row0 + ai * HALF + m * 16) * D + col0;
#pragma unroll
                    for (int bj = 0; bj < 2; ++bj) { v4u* p = (v4u*)(rowp + bj * HALF); const v4u w = xw[m][bj];
                        const f32x4 x0 = {__builtin_bit_cast(float, w.x << 16), __builtin_bit_cast(float, w.x & 0xffff0000u), __builtin_bit_cast(float, w.y << 16), __builtin_bit_cast(float, w.y & 0xffff0000u)};
                        const f32x4 x1 = {__builtin_bit_cast(float, w.z << 16), __builtin_bit_cast(float, w.z & 0xffff0000u), __builtin_bit_cast(float, w.w << 16), __builtin_bit_cast(float, w.w & 0xffff0000u)};
                        const f32x4 y0 = x0 + gv[bj][0] * acc[ai][bj][m][0], y1 = x1 + gv[bj][1] * acc[ai][bj][m][1];
                        v4u o; o.x = pk2(y0[0], y0[1]); o.y = pk2(y0[2], y0[3]); o.z = pk2(y1[0], y1[1]); o.w = pk2(y1[2], y1[3]); *p = o; } }
            }
        } else {
            const int row0 = u.pm * BM + u.h * HALF + wr * 64 + fr; const int j0 = u.pn * 128 + wc * 32 + 8 * fq;
#pragma unroll
            for (int ai = 0; ai < 2; ++ai) if (ai == 0 || !u.half)
#pragma unroll
                for (int m = 0; m < 4; ++m) { float hv[8];
#pragma unroll
                    for (int bj = 0; bj < 2; ++bj)
#pragma unroll
                        for (int i = 0; i < 4; ++i) { const float a = acc[ai][bj][m][0][i], b = acc[ai][bj][m][1][i]; hv[bj * 4 + i] = a * b * __builtin_amdgcn_rcpf(1.f + __expf(-a)); }
                    v4u w; w.x = pk2(hv[0], hv[1]); w.y = pk2(hv[2], hv[3]); w.z = pk2(hv[4], hv[5]); w.w = pk2(hv[6], hv[7]);
                    *(v4u*)(O + (size_t)(row0 + ai * HALF + m * 16) * DE + j0) = w; }
        }
    }
};

__device__ __forceinline__ void gemm_phase(LAS unsigned char* lds, const GCfg& S) {
    const char* const Abase = S.Abase; const int K = S.K; const bool PERMB = S.perm();
    int tid_ = threadIdx.x; asm volatile("" : "+v"(tid_));
    const int tid = tid_, wid = __builtin_amdgcn_readfirstlane(tid >> 6), lane = tid & 63, wr = wid >> 2, wc = wid & 3, fr = lane & 15, fq = lane >> 4;
    const int nt = K / BK;
    int sR[2], sC[2]; unsigned voffB[2];
#pragma unroll
    for (int i = 0; i < 2; ++i) { stage_rc(tid * 16 + i * 8192, sR[i], sC[i]); const int Rb = PERMB ? ((sR[i] & ~31) + perm32(sR[i] & 31)) : sR[i]; voffB[i] = (unsigned)(Rb * K + sC[i]) * 2u; }
    const unsigned kstep = (unsigned)(BK * 2);
    const size_t hstepB = (size_t)HALF * K * 2;
    const unsigned ldsw = (unsigned)wid * 1024u;
    const int aoff = lds_byte(wr * 64 + fr, fq * 8), boff = lds_byte(wc * 32 + fr, fq * 8);
#define PG8_SA(b, h) (((b) * 2 + (h)) * HTB)
#define PG8_SB(b, h) ((4 + (b) * 2 + (h)) * HTB)
#define PG8_STAGE_B(bufoff, gbase) do { _Pragma("unroll") for (int _i = 0; _i < 2; ++_i) \
        __builtin_amdgcn_global_load_lds((const unsigned*)((const char*)(gbase) + voffB[_i]), (LAS unsigned*)(lds + (bufoff) + ldsw + _i * 8192), 16, 0, 0); } while (0)
#define PG8_STAGE_A(bufoff, o0, o1, kb) do { \
        __builtin_amdgcn_global_load_lds((const unsigned*)(Abase + (size_t)((o0) + (kb))), (LAS unsigned*)(lds + (bufoff) + ldsw), 16, 0, 0); \
        __builtin_amdgcn_global_load_lds((const unsigned*)(Abase + (size_t)((o1) + (kb))), (LAS unsigned*)(lds + (bufoff) + ldsw + 8192), 16, 0, 0); } while (0)
#define PG8_LDA(dst, b, h) do { _Pragma("unroll") for (int m = 0; m < 4; ++m) _Pragma("unroll") for (int k = 0; k < 2; ++k) dst[m][k] = *(const LAS bf16x8*)(lds + PG8_SA(b, h) + aoff + m * 2048 + k * 1024); } while (0)
#define PG8_LDB(dst, b, h) do { _Pragma("unroll") for (int n = 0; n < 2; ++n) _Pragma("unroll") for (int k = 0; k < 2; ++k) dst[n][k] = *(const LAS bf16x8*)(lds + PG8_SB(b, h) + boff + n * 2048 + k * 1024); } while (0)
#define PG8_MMA(ai, bj, At, Bt) do { __builtin_amdgcn_s_setprio(1); _Pragma("unroll") for (int m = 0; m < 4; ++m) _Pragma("unroll") for (int n = 0; n < 2; ++n) _Pragma("unroll") for (int k = 0; k < 2; ++k) \
        acc[ai][bj][m][n] = __builtin_amdgcn_mfma_f32_16x16x32_bf16(Bt[n][k], At[m][k], acc[ai][bj][m][n], 0, 0, 0); __builtin_amdgcn_s_setprio(0); } while (0)
#define PG8_WAIT_V(n) asm volatile("s_waitcnt vmcnt(" #n ")" ::: "memory")
#define PG8_WAIT_L(n) asm volatile("s_waitcnt lgkmcnt(" #n ")" ::: "memory")
#define PG8_BAR __builtin_amdgcn_s_barrier()
#define PG8_SCHED __builtin_amdgcn_sched_barrier(0)
    int upk_v, epk_v; S.units_of_lane(lane, upk_v, epk_v);
    Unit cur, nxt; int ui = 0;
    if (!S.next(0, cur, upk_v, epk_v)) return;
    f32x4 acc[2][2][4][2];
#pragma unroll
    for (int a = 0; a < 2; ++a)
#pragma unroll
        for (int b = 0; b < 2; ++b)
#pragma unroll
            for (int m = 0; m < 4; ++m)
#pragma unroll
                for (int n = 0; n < 2; ++n) acc[a][b][m][n] = (f32x4){0.f, 0.f, 0.f, 0.f};
    bf16x8 At[4][2], B0[2][2], B1[2][2];
    const char* cB = S.b_base(cur);
    PG8_STAGE_B(PG8_SB(0, 0), cB); PG8_STAGE_B(PG8_SB(0, 1), cB + hstepB);
    unsigned c00 = S.a_off(cur, 0, sR[0], sC[0]), c01 = S.a_off(cur, 0, sR[1], sC[1]), c10 = S.a_off(cur, 1, sR[0], sC[0]), c11 = S.a_off(cur, 1, sR[1], sC[1]);
    PG8_STAGE_A(PG8_SA(0, 0), c00, c01, 0u); PG8_STAGE_A(PG8_SA(0, 1), c10, c11, 0u);
    if (wr == 1) PG8_BAR;
    PG8_WAIT_V(2); PG8_BAR;
    PG8_STAGE_B(PG8_SB(1, 0), cB + kstep); PG8_STAGE_A(PG8_SA(1, 0), c00, c01, kstep); PG8_STAGE_B(PG8_SB(1, 1), cB + hstepB + kstep);
    PG8_WAIT_V(6); PG8_BAR;
    LAS unsigned* const nslot = (LAS unsigned*)(lds + LDSCTL_OFF + 1024) + wid * 256;
    for (;;) {
        const bool has_next = S.next(ui + 1, nxt, upk_v, epk_v);
        const char* nB = cB;
        if (has_next) {
            int t2 = tid; asm volatile("" : "+v"(t2)); int r0_, c0_, r1_, c1_; stage_rc(t2 * 16, r0_, c0_); stage_rc(t2 * 16 + 8192, r1_, c1_);
            S.a_rows_to_lds(nxt, r0_, r1_, nslot, lane); nB = S.b_base(nxt); }
        const bool hf = cur.half != 0;
        for (int t = 0; t < nt; t += 2) {
            const bool last = (t == nt - 2);
            const unsigned k1 = (unsigned)(t + 1) * kstep;
            const unsigned k2 = last ? 0u : (unsigned)(t + 2) * kstep, k3 = k2 + kstep;
            unsigned s00 = c00, s01 = c01, s10 = c10, s11 = c11;
            if (last && has_next) { int t3 = tid; asm volatile("" : "+v"(t3)); int r0_, c0_, r1_, c1_; stage_rc(t3 * 16, r0_, c0_); stage_rc(t3 * 16 + 8192, r1_, c1_);
                s00 = (nslot[lane] * (unsigned)K + c0_) * 2u; s01 = (nslot[64 + lane] * (unsigned)K + c1_) * 2u; s10 = (nslot[128 + lane] * (unsigned)K + c0_) * 2u; s11 = (nslot[192 + lane] * (unsigned)K + c1_) * 2u; }
            const char* b2 = last ? nB : cB + (size_t)(t + 2) * kstep; const char* b3 = b2 + kstep;
            const bool relax = (t == 0 && ui > 0);
            PG8_LDB(B0, 0, 0); PG8_LDB(B1, 0, 1); PG8_SCHED; PG8_LDA(At, 0, 0); PG8_STAGE_A(PG8_SA(1, 1), c10, c11, k1);
            if (relax) { if (S.emode == 2) PG8_WAIT_V(16); else PG8_WAIT_V(24); } else PG8_WAIT_V(8);
            PG8_WAIT_L(0); PG8_BAR; PG8_MMA(0, 0, At, B0); PG8_MMA(0, 1, At, B1); PG8_BAR; PG8_SCHED;
            if (!hf) PG8_LDA(At, 0, 1); PG8_STAGE_B(PG8_SB(0, 0), b2); PG8_STAGE_B(PG8_SB(0, 1), b2 + hstepB); PG8_STAGE_A(PG8_SA(0, 0), s00, s01, k2);
            if (relax) { if (S.emode == 2) PG8_WAIT_V(16); else PG8_WAIT_V(24); } else PG8_WAIT_V(8);
            PG8_WAIT_L(0); PG8_BAR; if (!hf) { PG8_MMA(1, 0, At, B0); PG8_MMA(1, 1, At, B1); } PG8_BAR; PG8_SCHED;
            PG8_LDB(B0, 1, 0); PG8_LDB(B1, 1, 1); PG8_SCHED; PG8_LDA(At, 1, 0); PG8_STAGE_A(PG8_SA(0, 1), s10, s11, k2);
            PG8_WAIT_V(8); PG8_WAIT_L(0); PG8_BAR; PG8_MMA(0, 0, At, B0); PG8_MMA(0, 1, At, B1); PG8_BAR; PG8_SCHED;
            if (!hf) PG8_LDA(At, 1, 1); PG8_STAGE_B(PG8_SB(1, 0), b3); PG8_STAGE_B(PG8_SB(1, 1), b3 + hstepB); PG8_STAGE_A(PG8_SA(1, 0), s00, s01, k3);
            PG8_WAIT_V(8); PG8_WAIT_L(0); PG8_BAR; if (!hf) { PG8_MMA(1, 0, At, B0); PG8_MMA(1, 1, At, B1); } PG8_BAR; PG8_SCHED;
        }
        if (wr == 0) PG8_BAR;
        S.epi(acc, cur, wr, wc, fr, fq);
        if (!has_next) break;
#pragma unroll
        for (int a = 0; a < 2; ++a)
#pragma unroll
            for (int b = 0; b < 2; ++b)
#pragma unroll
                for (int m = 0; m < 4; ++m)
#pragma unroll
                    for (int n = 0; n < 2; ++n) acc[a][b][m][n] = (f32x4){0.f, 0.f, 0.f, 0.f};
        { int t4 = tid; asm volatile("" : "+v"(t4)); int r0_, c0_, r1_, c1_; stage_rc(t4 * 16, r0_, c0_); stage_rc(t4 * 16 + 8192, r1_, c1_);
          c00 = (nslot[lane] * (unsigned)K + c0_) * 2u; c01 = (nslot[64 + lane] * (unsigned)K + c1_) * 2u; c10 = (nslot[128 + lane] * (unsigned)K + c0_) * 2u; c11 = (nslot[192 + lane] * (unsigned)K + c1_) * 2u; }
        cur = nxt; cB = nB; ++ui;
        if (wr == 1) PG8_BAR;
    }
    PG8_WAIT_V(0);
    PG8_BAR;
#undef PG8_SA
#undef PG8_SB
#undef PG8_STAGE_A
#undef PG8_STAGE_B
#undef PG8_LDA
#undef PG8_LDB
#undef PG8_MMA
#undef PG8_WAIT_V
#undef PG8_WAIT_L
#undef PG8_BAR
#undef PG8_SCHED
}
}
struct Args { In in; float* out; unsigned char* ws; int ph_lo, ph_hi, flags, pad; };
typedef const __attribute__((address_space(4))) Args* KArgs;
__device__ __forceinline__ KArgs kargs() { KArgs a = (KArgs)__builtin_amdgcn_kernarg_segment_ptr(); asm volatile("" : "+s"(a)); return a; }
struct Ctx {
    LAS unsigned char* lds; int tid, lane, wave, G, bid;
};
extern __shared__ __attribute__((aligned(16))) unsigned char lds_raw[];
__device__ __forceinline__ Ctx mkctx() { Ctx F; int t = threadIdx.x; asm volatile("" : "+v"(t)); F.lds = (LAS unsigned char*)lds_raw; F.tid = t; F.lane = t & 63; F.wave = __builtin_amdgcn_readfirstlane(t >> 6); F.G = gridDim.x; F.bid = (int)__builtin_amdgcn_readfirstlane(((volatile LAS unsigned*)(lds_raw + MISC_OFF))[12]); return F; }

struct MapIdent { float qs; int qlo, qhi; __device__ __forceinline__ int row(int n) const { return n; } __device__ __forceinline__ float scale(int n) const { return (n >= qlo && n < qhi) ? qs : 1.f; } };
struct MapW13 { int sel; __device__ __forceinline__ int row(int j) const { return 256 * (j >> 7) + 128 * ((j >> 2) & 1) + 32 * ((j >> 5) & 3) + 16 * sel + 4 * ((j >> 3) & 3) + (j & 3); } __device__ __forceinline__ float scale(int) const { return 1.f; } };
template <bool DEEP, class Map>
__device__ __forceinline__ void transpose_item(const float* W, int ldn, int k0, int n0, bf16_t* WT, int ldk, LAS float* scr, int lane, const Map& map) {
    if (DEEP) {
        float ld[32];
#pragma unroll
        for (int i = 0; i < 32; ++i) ld[i] = __builtin_nontemporal_load(W + (size_t)(k0 + 2 * i + (lane >> 5)) * ldn + n0 + (lane & 31));
#pragma unroll
        for (int i = 0; i < 32; ++i) scr[(2 * i + (lane >> 5)) * 33 + (lane & 31)] = ld[i];
    } else {
#pragma unroll 8
        for (int i = 0; i < 32; ++i) { const int kk = 2 * i + (lane >> 5); scr[kk * 33 + (lane & 31)] = __builtin_nontemporal_load(W + (size_t)(k0 + kk) * ldn + n0 + (lane & 31)); }
    }
    LDS_WAIT(); asm volatile("" ::: "memory");
    const int c = lane & 7;
#pragma unroll
    for (int j = 0; j < 4; ++j) { const int n = (lane >> 3) + 8 * j; const LAS float* s = scr + (8 * c) * 33 + n; const float sc = map.scale(n0 + n);
        v4u o; o.x = pk2(s[0 * 33] * sc, s[1 * 33] * sc); o.y = pk2(s[2 * 33] * sc, s[3 * 33] * sc); o.z = pk2(s[4 * 33] * sc, s[5 * 33] * sc); o.w = pk2(s[6 * 33] * sc, s[7 * 33] * sc);
        __builtin_nontemporal_store(o, (GAS v4u*)(WT + (size_t)map.row(n0 + n) * ldk + k0 + 8 * c)); }
    LDS_WAIT(); asm volatile("" ::: "memory");
}

constexpr int CV_EARLY = 16 * 65 + 4 * 8 + 224 + 16 * 32;
template <bool DEEP>
__device__ __forceinline__ void convert_layer_items(const Ctx& F, KArgs A, int l, int widx, int nw, int nmax = 1 << 30) {
    unsigned char* const ws = A->ws;
    LAS float* scr = (LAS float*)(F.lds + F.wave * 16384);
    bf16_t* WIN = (bf16_t*)(ws + WS_WIN) + (size_t)l * PLD * D; bf16_t* WOUT = (bf16_t*)(ws + WS_WOUT) + (size_t)l * D * D;
    bf16_t* W13 = (bf16_t*)(ws + WS_W13) + (size_t)l * NE * 1024 * D; bf16_t* W2 = (bf16_t*)(ws + WS_W2) + (size_t)l * NE * D * DE; bf16_t* WPL = (bf16_t*)(ws + WS_WPOOL) + (size_t)l * 4 * 128 * 128;
    constexpr int I_IN = 16 * 65, I_OUT = 16 * 32, I_W1 = NE * 256, I_W2 = NE * 256, I_PL = 4 * 8, I_Z = 224;
    constexpr int NITEMS = I_IN + I_OUT + 2 * I_W1 + I_W2 + I_PL + I_Z;
    for (int it = widx; it < NITEMS && it < nmax; it += nw) {
        int r = it;
        if (r < I_IN) { const int kb = r / 65, nb = r % 65;
            transpose_item<DEEP>(A->in.w_in + (size_t)l * D * INW, INW, kb * 64, nb * 32, WIN, D, scr, F.lane, MapIdent{0.125f, 512, 768}); continue; } r -= I_IN;
        if (r < I_PL) { const int g = r / 8, q = r % 8, kb = q / 4, nb = q % 4;
            transpose_item<DEEP>(A->in.w_pool + ((size_t)l * 4 + g) * 128 * 128, 128, kb * 64, nb * 32, WPL + (size_t)g * 128 * 128, 128, scr, F.lane, MapIdent{1.f, 0, 0}); continue; } r -= I_PL;
        if (r < I_Z) { const int row = INW + r; v4u z = {0u, 0u, 0u, 0u}; GAS v4u* p = (GAS v4u*)(WIN + (size_t)row * D) + F.lane; p[0] = z; p[64] = z; continue; } r -= I_Z;
        if (r < I_OUT) { const int kb = r / 32, nb = r % 32;
            transpose_item<DEEP>(A->in.w_out + (size_t)l * D * D, D, kb * 64, nb * 32, WOUT, D, scr, F.lane, MapIdent{1.f, 0, 0}); continue; } r -= I_OUT;
        if (r < 2 * I_W1) { const int sel = r >= I_W1; if (sel) r -= I_W1; const int e = r / 256, q = r % 256, kb = q / 16, nb = q % 16;
            transpose_item<DEEP>((sel ? A->in.w3 : A->in.w1) + ((size_t)l * NE + e) * D * DE, DE, kb * 64, nb * 32, W13 + (size_t)e * 1024 * D, D, scr, F.lane, MapW13{sel}); continue; } r -= 2 * I_W1;
        { const int e = r / 256, q = r % 256, kb = q / 32, nb = q % 32;
            transpose_item<DEEP>(A->in.w2 + ((size_t)l * NE + e) * DE * D, D, kb * 64, nb * 32, W2 + (size_t)e * D * DE, DE, scr, F.lane, MapIdent{1.f, 0, 0}); }
    }
}

__device__ __forceinline__ void convert_from_cursor(int l, int max_rounds, int limit = 1 << 30) {
    const Ctx F = mkctx(); KArgs A = kargs();
    gu32* const cur0 = (gu32*)(A->ws + WS_CTL) + CW_CVT;
    volatile LAS unsigned* slot = (volatile LAS unsigned*)(F.lds + LDSCTL_OFF + 256);
    constexpr int NITEMS = 16 * 65 + 16 * 32 + 3 * NE * 256 + 4 * 8 + 224;
    for (int r = 0; max_rounds < 0 || r < max_rounds; ++r) {
        if (F.tid == 0) { unsigned st = 0x7fffffffu, ly = (unsigned)l; const int base = l == 0 ? CV_EARLY : 0;
            if (max_rounds < 0) { if ((int)__hip_atomic_load(cur0 + l * 64, RLX_AGENT) + base < (limit < NITEMS ? limit : NITEMS)) st = __hip_atomic_fetch_add(cur0 + l * 64, 8u, RLX_AGENT) + (unsigned)base; }
            else { st = __hip_atomic_fetch_add(cur0 + l * 64, 8u, RLX_AGENT) + (unsigned)base;
                   if ((int)st >= NITEMS && l + 1 < DEPTH) { st = __hip_atomic_fetch_add(cur0 + (l + 1) * 64, 8u, RLX_AGENT); ly = (unsigned)(l + 1); } }
            slot[0] = st; slot[1] = ly; }
        __syncthreads();
        const int start = (int)slot[0], ly = (int)slot[1];
        __syncthreads();
        if (start >= NITEMS) break;
        convert_layer_items<true>(F, A, ly, start + F.wave, NITEMS + 8);
    }
}

__device__ __forceinline__ void p0_prologue() {
    const Ctx F = mkctx(); KArgs A = kargs(); unsigned char* const ws = A->ws;
    {
        LAS float* sc = (LAS float*)F.lds;
        LAS float* red = (LAS float*)(F.lds + 9 * 1024 * 4);
        for (int i = F.tid; i < 9 * 1024; i += NTHR) { const int v = i >> 10, k = i & 1023; const float cv = v < 8 ? A->in.c[v * D + k] : A->in.c_ctx[k]; sc[i] = silu_f(cv); }
        __syncthreads();
        float* MOD = (float*)(ws + WS_MOD);
        for (int it = F.bid; it < DEPTH * 96; it += F.G) {
            const int l = it / 96, j0 = (it % 96) * 64;
            const float* w = A->in.w_mod + ((size_t)l * D + F.wave * 128) * 6144 + j0 + F.lane;
            float acc[9];
#pragma unroll
            for (int v = 0; v < 9; ++v) acc[v] = 0.f;
            for (int k0 = 0; k0 < 128; k0 += 32) { float wv[32];
#pragma unroll
                for (int kk = 0; kk < 32; ++kk) wv[kk] = w[(size_t)(k0 + kk) * 6144];
#pragma unroll
                for (int kk = 0; kk < 32; ++kk) {
#pragma unroll
                    for (int v = 0; v < 9; ++v) acc[v] += sc[v * 1024 + F.wave * 128 + k0 + kk] * wv[kk]; } }
#pragma unroll
            for (int v = 0; v < 9; ++v) red[(F.wave * 9 + v) * 64 + F.lane] = acc[v];
            __syncthreads();
            for (int o = F.tid; o < 9 * 64; o += NTHR) { const int v = o >> 6, jj = o & 63; float s = 0.f;
#pragma unroll
                for (int wv = 0; wv < 8; ++wv) s += red[(wv * 9 + v) * 64 + jj];
                MOD[((size_t)l * 9 + v) * 6144 + j0 + jj] = s + A->in.b_mod[l * 6144 + j0 + jj]; }
            __syncthreads();
        }
    }
    { bf16_t* WGP = (bf16_t*)(ws + WS_WGP);
      for (int i = F.bid * NTHR + F.tid; i < DEPTH * 2 * 4 * 64 * 16; i += F.G * NTHR) { const int r = i & 15, d = (i >> 4) & 63, h = (i >> 10) & 3, n = (i >> 12) & 1, l = i >> 13;
          const float w = A->in.w_gk2[((size_t)(l * 2 + n) * 16 + r) * 256 + h * 64 + d]; const unsigned hi = f2bf(w); const float rem = w - __builtin_bit_cast(float, hi << 16);
          bf16_t* o = WGP + (size_t)l * 2 * 2 * 4 * 64 * 16 + ((size_t)(n * 4 + h) * 64 + d) * 16 + r; o[0] = (bf16_t)hi; o[2 * 4 * 64 * 16] = (bf16_t)f2bf(rem); } }
    { bf16_t* WRP = (bf16_t*)(ws + WS_WRP);
      for (int i = F.bid * NTHR + F.tid; i < NE * D; i += F.G * NTHR) { const int e = i & 15, k = i >> 4; const float w = A->in.w_router[i]; const unsigned hi = f2bf(w); const float rem = w - __builtin_bit_cast(float, hi << 16);
          WRP[(size_t)e * D + k] = (bf16_t)hi; WRP[(size_t)NE * D + (size_t)e * D + k] = (bf16_t)f2bf(rem); } }
    convert_layer_items<false>(F, A, 0, F.bid * NWAVES + F.wave, F.G * NWAVES, CV_EARLY);
}

__device__ __forceinline__ int batch_row(int vb, int i) { const int x = vb >> 5; return i < 2048 ? x * 2048 + i : NX + x * 256 + (i - 2048); }
template <bool FINAL, bool FROMIN>
__device__ __forceinline__ void rowpass_n1(int l, bool combine, int nrows, bool zero_w) {
    const Ctx F = mkctx(); KArgs A = kargs(); unsigned char* const ws = A->ws; float* const outp = A->out; gu32* const ctl = (gu32*)(ws + WS_CTL);
    const int gw = F.bid * NWAVES + F.wave, NGW = F.G * NWAVES;
    bf16_t* XB = (bf16_t*)(ws + WS_XB);
    const float* MOD = (const float*)(ws + WS_MOD);
    bf16_t* H = (bf16_t*)(ws + WS_HB);
    const bf16_t* YB = (const bf16_t*)(ws + WS_P);
    const int* TOK = (const int*)(ws + WS_TOK); const float* WTS = (const float*)(ws + WS_WTS);
    LAS int* pst = (LAS int*)(F.lds);
    if (combine) {
        if (F.tid < 64) {
            const int cnt = F.tid < NE ? (int)__hip_atomic_load(ctl + CW_ECNT + ((l - 1) * NE + F.tid) * 64, RLX_AGENT) : 0; const int pad = ((cnt + 255) >> 8) << 8; int inc = pad;
#pragma unroll
            for (int o = 1; o < 16; o <<= 1) { const int v = __shfl_up(inc, o, 16); if ((F.tid & 15) >= o) inc += v; }
            if (F.tid < NE) pst[F.tid] = inc - pad; }
        __syncthreads();
    }
    const int rpw = nrows / NGW, ibase = ((F.bid & 31) * NWAVES + F.wave) * rpw;
    const int c0l = 4 * F.lane;
    int vcur = -1; f32x4 gt[4], st[4], g2v[4];
    if (FINAL) {
#pragma unroll
        for (int j = 0; j < 4; ++j) gt[j] = *(const GAS f32x4*)(A->in.norm_f + c0l + 256 * j);
    }
    v2u pxb[3][4]; f32x4 pxf[3][4]; int pt0[3], pt1[3]; float pw0[3], pw1[3];
#define N1_LOAD_GROUP(G0) do { _Pragma("unroll") for (int r = 0; r < 3; ++r) { const int rr = ((G0) + r < rpw) ? (G0) + r : rpw - 1; const int row = batch_row(F.bid, ibase + rr); \
        if (FROMIN) { const float* src = row < NX ? A->in.x + (size_t)row * D : A->in.ctx + (size_t)(row - NX) * D; _Pragma("unroll") for (int j = 0; j < 4; ++j) pxf[r][j] = *(const GAS f32x4*)(src + c0l + 256 * j); } \
        else { _Pragma("unroll") for (int j = 0; j < 4; ++j) pxb[r][j] = __builtin_nontemporal_load((const GAS v2u*)(XB + (size_t)row * D + c0l + 256 * j)); } \
        pt0[r] = 0; pt1[r] = 0; pw0[r] = 0.f; pw1[r] = 0.f; \
        if (combine) { pt0[r] = TOK[row * 2]; pt1[r] = TOK[row * 2 + 1]; pw0[r] = WTS[row * 2]; pw1[r] = WTS[row * 2 + 1]; } } } while (0)
    N1_LOAD_GROUP(0);
    for (int g0 = 0; g0 < rpw; g0 += 3) {
        int rows[3]; bool valid[3]; f32x4 x[3][4]; int t0[3], t1[3]; float w0[3], w1[3];
#pragma unroll
        for (int r = 0; r < 3; ++r) { valid[r] = g0 + r < rpw; rows[r] = batch_row(F.bid, ibase + (valid[r] ? g0 + r : rpw - 1)); t0[r] = pt0[r]; t1[r] = pt1[r]; w0[r] = zero_w ? 0.f : pw0[r]; w1[r] = zero_w ? 0.f : pw1[r];
#pragma unroll
            for (int j = 0; j < 4; ++j) { if (FROMIN) x[r][j] = pxf[r][j]; else { const v2u a = pxb[r][j];
                x[r][j] = (f32x4){__builtin_bit_cast(float, a.x << 16), __builtin_bit_cast(float, a.x & 0xffff0000u), __builtin_bit_cast(float, a.y << 16), __builtin_bit_cast(float, a.y & 0xffff0000u)}; } } }
        v2u ya[3][4], yb[3][4];
        if (combine) {
#pragma unroll
            for (int r = 0; r < 3; ++r) { const bf16_t* y0 = YB + (size_t)(pst[t0[r] & 15] + (t0[r] >> 4)) * D; const bf16_t* y1 = YB + (size_t)(pst[t1[r] & 15] + (t1[r] >> 4)) * D;
#pragma unroll
                for (int j = 0; j < 4; ++j) { ya[r][j] = __builtin_nontemporal_load((const GAS v2u*)(y0 + c0l + 256 * j)); yb[r][j] = __builtin_nontemporal_load((const GAS v2u*)(y1 + c0l + 256 * j)); } }
        }
        if (g0 + 3 < rpw) N1_LOAD_GROUP(g0 + 3);
#pragma unroll
        for (int r = 0; r < 3; ++r) { const int row = rows[r]; const int v = variant_of_row(row);
            if (!FINAL && v != vcur) {
                vcur = v; const float* m = MOD + ((size_t)l * 9 + v) * 6144; f32x4 gn[4], scl[4];
#pragma unroll
                for (int j = 0; j < 4; ++j) { gn[j] = *(const GAS f32x4*)(A->in.norm1 + l * D + c0l + 256 * j); scl[j] = *(const GAS f32x4*)(m + D + c0l + 256 * j); st[j] = *(const GAS f32x4*)(m + c0l + 256 * j); }
#pragma unroll
                for (int j = 0; j < 4; ++j) gt[j] = gn[j] * (scl[j] + 1.f);
                if (combine) {
#pragma unroll
                    for (int j = 0; j < 4; ++j) g2v[j] = *(const GAS f32x4*)(MOD + ((size_t)(l - 1) * 9 + v) * 6144 + 5 * D + c0l + 256 * j); }
            }
            if (FINAL && combine && v != vcur) { vcur = v;
#pragma unroll
                for (int j = 0; j < 4; ++j) g2v[j] = *(const GAS f32x4*)(MOD + ((size_t)(l - 1) * 9 + v) * 6144 + 5 * D + c0l + 256 * j); }
            if (combine) {
#pragma unroll
                for (int j = 0; j < 4; ++j) { const v2u a = ya[r][j], b = yb[r][j];
                    const f32x4 fa = {__builtin_bit_cast(float, a.x << 16), __builtin_bit_cast(float, a.x & 0xffff0000u), __builtin_bit_cast(float, a.y << 16), __builtin_bit_cast(float, a.y & 0xffff0000u)};
                    const f32x4 fb = {__builtin_bit_cast(float, b.x << 16), __builtin_bit_cast(float, b.x & 0xffff0000u), __builtin_bit_cast(float, b.y << 16), __builtin_bit_cast(float, b.y & 0xffff0000u)};
                    x[r][j] = x[r][j] + g2v[j] * (fa * w0[r] + fb * w1[r]); } }
            if (!FINAL && (combine || FROMIN) && valid[r]) {
#pragma unroll
                for (int j = 0; j < 4; ++j) { v2u o; o.x = pk2(x[r][j].x, x[r][j].y); o.y = pk2(x[r][j].z, x[r][j].w); __builtin_nontemporal_store(o, (GAS v2u*)(XB + (size_t)row * D + c0l + 256 * j)); }
            }
            float ss = 0.f;
#pragma unroll
            for (int j = 0; j < 4; ++j) ss += (x[r][j].x * x[r][j].x + x[r][j].y * x[r][j].y) + (x[r][j].z * x[r][j].z + x[r][j].w * x[r][j].w);
            const float rinv = rsqrtf(wave_sum(ss) * (1.f / D) + 1e-6f);
            if (valid[r]) {
                if (FINAL) { float* dst = outp + (size_t)row * D;
#pragma unroll
                    for (int j = 0; j < 4; ++j) *(GAS f32x4*)(dst + c0l + 256 * j) = x[r][j] * rinv * gt[j];
                } else {
#pragma unroll
                    for (int j = 0; j < 4; ++j) { const f32x4 h = x[r][j] * rinv * gt[j] + st[j];
                        v2u o; o.x = pk2(h.x, h.y); o.y = pk2(h.z, h.w); *(GAS v2u*)(H + (size_t)row * D + c0l + 256 * j) = o; }
                }
            }
        }
    }
#undef N1_LOAD_GROUP
}
#define HAVE_GLA 1
constexpr int G_LG = 0;
constexpr int G_TMP = 32768;
constexpr int G_AO = 51200;
constexpr int G_VN = 76800;
constexpr int G_BS = 94208;
constexpr int G_OUT = 0;
__device__ __forceinline__ f32x16 mfma32(bf16x8 a, bf16x8 b, f32x16 c) { return __builtin_amdgcn_mfma_f32_32x32x16_bf16(a, b, c, 0, 0, 0); }
__device__ __forceinline__ float fast_logsigmoid(float x) { return fminf(x, 0.f) - __logf(1.f + __expf(-fabsf(x))); }
__device__ __forceinline__ void unpack8(const v4u w, float (&f)[8]) {
    f[0] = __builtin_bit_cast(float, w.x << 16); f[1] = __builtin_bit_cast(float, w.x & 0xffff0000u); f[2] = __builtin_bit_cast(float, w.y << 16); f[3] = __builtin_bit_cast(float, w.y & 0xffff0000u);
    f[4] = __builtin_bit_cast(float, w.z << 16); f[5] = __builtin_bit_cast(float, w.z & 0xffff0000u); f[6] = __builtin_bit_cast(float, w.w << 16); f[7] = __builtin_bit_cast(float, w.w & 0xffff0000u);
}
__device__ __forceinline__ v4u pack8(const float (&f)[8]) { v4u w; w.x = pk2(f[0], f[1]); w.y = pk2(f[2], f[3]); w.z = pk2(f[4], f[5]); w.w = pk2(f[6], f[7]); return w; }

typedef short v4i16_t __attribute__((ext_vector_type(4)));
__device__ __forceinline__ bf16x8 tr_frag(const LAS bf16_t* T, int ld, int k0, int n0, int lane) {
    const int hh = lane >> 5, blk = (lane >> 4) & 1, q = (lane & 15) >> 2, p = lane & 3;
    const LAS bf16_t* a0 = T + (k0 + 8 * hh + q) * ld + n0 + 16 * blk + 4 * p;
    const v4i16_t lo = __builtin_amdgcn_ds_read_tr16_b64_v4i16((LAS v4i16_t*)a0), hi = __builtin_amdgcn_ds_read_tr16_b64_v4i16((LAS v4i16_t*)(a0 + 4 * ld));
    bf16x8 r; r[0] = lo[0]; r[1] = lo[1]; r[2] = lo[2]; r[3] = lo[3]; r[4] = hi[0]; r[5] = hi[1]; r[6] = hi[2]; r[7] = hi[3]; return r;
}
struct DecPre { v4u a, bhi, blo; float bias; };
__device__ __forceinline__ void decays_load(DecPre& p, const Ctx& F, const bf16_t* P, const bf16_t* WGPl, const float* b_gkl, int r0, int h) {
    const int n = F.wave >> 2, tt = (F.wave >> 1) & 1, dt = F.wave & 1, r = F.lane & 31, hh = F.lane >> 5;
    p.a = *(const GAS v4u*)(P + (size_t)(r0 + 32 * tt + r) * PLD + 2048 + n * 16 + 8 * hh);
    const bf16_t* wg = WGPl + ((size_t)(n * 4 + h) * 64 + 32 * dt + r) * 16 + 8 * hh;
    p.bhi = *(const GAS v4u*)wg; p.blo = *(const GAS v4u*)(wg + 2 * 4 * 64 * 16);
    p.bias = b_gkl[n * 256 + h * 64 + 32 * dt + r];
}
__device__ __forceinline__ void chunk_decays(const Ctx& F, const DecPre& p) {
    LAS float* LG = (LAS float*)(F.lds + G_LG); LAS float* TT = (LAS float*)(F.lds + G_TMP);
    const int n = F.wave >> 2, tt = (F.wave >> 1) & 1, dt = F.wave & 1, r = F.lane & 31, hh = F.lane >> 5;
    f32x16 acc = {0.f, 0.f, 0.f, 0.f, 0.f, 0.f, 0.f, 0.f, 0.f, 0.f, 0.f, 0.f, 0.f, 0.f, 0.f, 0.f};
    acc = mfma32(__builtin_bit_cast(bf16x8, p.a), __builtin_bit_cast(bf16x8, p.bhi), acc);
    acc = mfma32(__builtin_bit_cast(bf16x8, p.a), __builtin_bit_cast(bf16x8, p.blo), acc);
    float v[16];
#pragma unroll
    for (int g = 0; g < 16; ++g) v[g] = fast_logsigmoid(acc[g] + p.bias) * (1.f / 16.f);
    float T[4], Pq[4];
    if (n == 0) {
#pragma unroll
        for (int q = 0; q < 4; ++q) { v[4 * q + 1] += v[4 * q]; v[4 * q + 2] += v[4 * q + 1]; v[4 * q + 3] += v[4 * q + 2]; T[q] = v[4 * q + 3]; }
    } else {
#pragma unroll
        for (int q = 0; q < 4; ++q) { v[4 * q + 2] += v[4 * q + 3]; v[4 * q + 1] += v[4 * q + 2]; v[4 * q] += v[4 * q + 1]; T[q] = v[4 * q]; }
    }
#pragma unroll
    for (int q = 0; q < 4; ++q) Pq[q] = __shfl_xor(T[q], 32);
    const float tot = ((T[0] + Pq[0]) + (T[1] + Pq[1])) + ((T[2] + Pq[2]) + (T[3] + Pq[3]));
    if (hh == 0) TT[(n * 2 + tt) * 64 + 32 * dt + r] = tot;
    float off[4];
    if (n == 0) { float run = 0.f;
#pragma unroll
        for (int q = 0; q < 4; ++q) { off[q] = run + (hh ? Pq[q] : 0.f); run += T[q] + Pq[q]; }
    } else { float run = 0.f;
#pragma unroll
        for (int q = 3; q >= 0; --q) { off[q] = run + (hh ? 0.f : Pq[q]); run += T[q] + Pq[q]; }
    }
    __syncthreads();
    const float xo = (n == 0) ? (tt == 1 ? TT[(0 * 2 + 0) * 64 + 32 * dt + r] : 0.f) : (tt == 0 ? TT[(1 * 2 + 1) * 64 + 32 * dt + r] : 0.f);
#pragma unroll
    for (int g = 0; g < 16; ++g) { const int t = 32 * tt + (g & 3) + 8 * (g >> 2) + 4 * hh; LG[(n * 64 + t) * 64 + 32 * dt + r] = v[g] + off[g >> 2] + xo; }
    __syncthreads();
}

struct KvPre { DecPre dec; v4u k, v0, v1; };
__device__ __forceinline__ void kv_decode(int job, int& b, int& h, int& j) { b = job / 144; const int rem = job % 144; h = rem / NCH; j = rem % NCH; }
__device__ __forceinline__ void kv_load(KvPre& p, const Ctx& F, KArgs A, int l, int job) {
    int b, h, j; kv_decode(job, b, h, j); const bf16_t* P = (const bf16_t*)(A->ws + WS_P); const int r0 = chunk_row0(b, j);
    decays_load(p.dec, F, P, (const bf16_t*)(A->ws + WS_WGP) + (size_t)l * 2 * 2 * 4 * 64 * 16, A->in.b_gk + (size_t)l * 2 * 256, r0, h);
    const int t = F.tid >> 3, dg = F.tid & 7; const bf16_t* pr = P + (size_t)(r0 + t) * PLD;
    p.k = *(const GAS v4u*)(pr + 768 + h * 64 + 8 * dg); p.v0 = *(const GAS v4u*)(pr + 1024 + h * 128 + 16 * dg); p.v1 = *(const GAS v4u*)(pr + 1024 + h * 128 + 16 * dg + 8);
}
__device__ __forceinline__ void kv_compute(const KvPre& p, const Ctx& F, unsigned char* ws, int job) {
    int b, h, j; kv_decode(job, b, h, j);
    chunk_decays(F, p.dec);
    LAS float* LG = (LAS float*)(F.lds + G_LG);
    LAS bf16_t* KEF = (LAS bf16_t*)(F.lds + G_AO); LAS bf16_t* KEB = KEF + 64 * 72; LAS bf16_t* VN = (LAS bf16_t*)(F.lds + G_VN);
    { const int t = F.tid >> 3, dg = F.tid & 7;
      float k[8]; unpack8(p.k, k); float kf[8], kb[8];
#pragma unroll
      for (int i = 0; i < 8; ++i) { const int d = 8 * dg + i;
          kf[i] = k[i] * __expf(LG[63 * 64 + d] - LG[t * 64 + d]); kb[i] = k[i] * __expf(LG[64 * 64 + d] - LG[(64 + t) * 64 + d]); }
      *(LAS v4u*)(KEF + t * 72 + 8 * dg) = pack8(kf); *(LAS v4u*)(KEB + t * 72 + 8 * dg) = pack8(kb);
      *(LAS v4u*)(VN + t * 136 + 16 * dg) = p.v0; *(LAS v4u*)(VN + t * 136 + 16 * dg + 8) = p.v1; }
    const int seq0 = (b * 4 + h) * 2;
    if (F.tid < 128) { const int n = F.tid >> 6, d = F.tid & 63; float* ADEC = (float*)(ws + WS_ADEC);
        ADEC[((size_t)(seq0 + n) * NCH + j) * 64 + d] = __expf(n == 0 ? LG[63 * 64 + d] : LG[64 * 64 + d]); }
    __syncthreads();
    { const int dir = F.wave >> 2, et = F.wave & 3, r = F.lane & 31, hh = F.lane >> 5;
      const LAS bf16_t* KE = dir ? KEB : KEF;
      f32x16 a0 = {0.f, 0.f, 0.f, 0.f, 0.f, 0.f, 0.f, 0.f, 0.f, 0.f, 0.f, 0.f, 0.f, 0.f, 0.f, 0.f}, a1 = a0;
#pragma unroll
      for (int ks = 0; ks < 4; ++ks) { const bf16x8 av = tr_frag(VN, 136, 16 * ks, 32 * et, F.lane);
          const bf16x8 b0 = tr_frag(KE, 72, 16 * ks, 0, F.lane), b1 = tr_frag(KE, 72, 16 * ks, 32, F.lane);
          a0 = mfma32(av, b0, a0); a1 = mfma32(av, b1, a1); }
      bf16_t* KVS = (bf16_t*)(ws + WS_KVS) + ((size_t)(seq0 + dir) * NCH + j) * 8192;
#pragma unroll
      for (int g = 0; g < 16; ++g) { const int e = 32 * et + (g & 3) + 8 * (g >> 2) + 4 * hh; KVS[e * 64 + r] = (bf16_t)pk2(a0[g], 0.f); KVS[e * 64 + 32 + r] = (bf16_t)pk2(a1[g], 0.f); } }
    __syncthreads();
}

template <int HW>
__device__ __forceinline__ void pool_job_t(int l, int pj, int g) {
    const Ctx F = mkctx(); KArgs A = kargs(); unsigned char* const ws = A->ws;
    const bf16_t* P = (const bf16_t*)(ws + WS_P);
    LAS float* VS = (LAS float*)(F.lds);
    LAS bf16_t* PD = (LAS bf16_t*)(F.lds + 33792);
    LAS bf16_t* WP = (LAS bf16_t*)(F.lds + 33792 + 17408);
    const bool latent = pj < 1024;
    int b, i64; if (latent) { b = pj >> 7; i64 = (pj >> 2) & 31; } else { const int q = pj - 1024; b = q >> 4; i64 = (q >> 2) & 3; }
    const int row0 = latent ? b * SEQ + i64 * 64 : NX + b * CTXL + i64 * 64;
    v4u wpre[4];
    { const bf16_t* wsrc = (const bf16_t*)(ws + WS_WPOOL) + (size_t)(l * 4 + g) * 128 * 128;
#pragma unroll
      for (int c = 0; c < 4; ++c) { const int u = F.tid + NTHR * c, d = u >> 4, q = u & 15; wpre[c] = *(const GAS v4u*)(wsrc + d * 128 + 8 * q); } }
    const float psc = A->in.pool_scale[l * 512 + g * 128 + 32 * (F.wave & 3) + (F.lane & 31)];
    v4u upre[2];
#pragma unroll
    for (int c = 0; c < 2; ++c) { const int u = F.tid + NTHR * c, jc = u >> 4, cg = u & 15; upre[c] = *(const GAS v4u*)(P + (size_t)(row0 + jc) * PLD + g * 128 + 8 * cg); }
    if (latent) {
        const int rlo = max(i64 - HW, 0), rhi = min(i64 + HW, 32); const float rc = 1.f / (float)(rhi - rlo);
#pragma unroll
        for (int c = 0; c < 2; ++c) { const int u = F.tid + NTHR * c, jc = u >> 4, cg = u & 15; float s[8];
#pragma unroll
            for (int i = 0; i < 8; ++i) s[i] = 0.f;
            v4u ld[2 * HW];
#pragma unroll
            for (int k = 0; k < 2 * HW; ++k) { const int r2 = min(max(i64 - HW + k, 0), 31); ld[k] = *(const GAS v4u*)(P + (size_t)(b * SEQ + r2 * 64 + jc) * PLD + g * 128 + 8 * cg); }
#pragma unroll
            for (int k = 0; k < 2 * HW; ++k) { const int r2 = i64 - HW + k; const float wt = (r2 >= 0 && r2 < 32) ? 1.f : 0.f; float f[8]; unpack8(ld[k], f);
#pragma unroll
                for (int i = 0; i < 8; ++i) s[i] += wt * f[i]; }
#pragma unroll
            for (int i = 0; i < 8; ++i) VS[jc * 132 + 8 * cg + i] = s[i] * rc; }
    }
#pragma unroll
    for (int c = 0; c < 4; ++c) { const int u = F.tid + NTHR * c, d = u >> 4, q = u & 15; *(LAS v4u*)(WP + d * 136 + 8 * q) = wpre[c]; }
    if (latent) __syncthreads();
#pragma unroll
    for (int c = 0; c < 2; ++c) { const int u = F.tid + NTHR * c, jc = u >> 4, cg = u & 15; float s[8];
#pragma unroll
        for (int i = 0; i < 8; ++i) s[i] = 0.f;
        float cnt;
        if (latent) { const int clo = max(jc - HW, 0), chi = min(jc + HW, 64); cnt = (float)(chi - clo);
#pragma unroll
            for (int k = 0; k < 2 * HW; ++k) { const int j2 = jc - HW + k; const float wt = (j2 >= 0 && j2 < 64) ? 1.f : 0.f; const int j2c = min(max(j2, 0), 63);
                const f32x4 v0 = *(const LAS f32x4*)(VS + j2c * 132 + 8 * cg), v1 = *(const LAS f32x4*)(VS + j2c * 132 + 8 * cg + 4);
                s[0] += wt * v0.x; s[1] += wt * v0.y; s[2] += wt * v0.z; s[3] += wt * v0.w; s[4] += wt * v1.x; s[5] += wt * v1.y; s[6] += wt * v1.z; s[7] += wt * v1.w; } }
        else { const int t = i64 * 64 + jc; const int lo = max(t - HW, 0), hi = min(t + HW, CTXL); cnt = (float)(hi - lo);
            v4u ld[2 * HW];
#pragma unroll
            for (int k = 0; k < 2 * HW; ++k) { const int t2 = min(max(t - HW + k, 0), CTXL - 1); ld[k] = *(const GAS v4u*)(P + (size_t)(NX + b * CTXL + t2) * PLD + g * 128 + 8 * cg); }
#pragma unroll
            for (int k = 0; k < 2 * HW; ++k) { const int t2 = t - HW + k; const float wt = (t2 >= 0 && t2 < CTXL) ? 1.f : 0.f; float f[8]; unpack8(ld[k], f);
#pragma unroll
                for (int i = 0; i < 8; ++i) s[i] += wt * f[i]; } }
        float uv[8]; unpack8(upre[c], uv);
        const float ic = 1.f / cnt; float pd[8];
#pragma unroll
        for (int i = 0; i < 8; ++i) pd[i] = s[i] * ic - uv[i];
        *(LAS v4u*)(PD + jc * 136 + 8 * cg) = pack8(pd); }
    __syncthreads();
    { const int mt = F.wave >> 2, nt = F.wave & 3, r = F.lane & 31, hh = F.lane >> 5;
      f32x16 acc = {0.f, 0.f, 0.f, 0.f, 0.f, 0.f, 0.f, 0.f, 0.f, 0.f, 0.f, 0.f, 0.f, 0.f, 0.f, 0.f};
#pragma unroll
      for (int ks = 0; ks < 8; ++ks) { const bf16x8 av = *(const LAS bf16x8*)(PD + (32 * mt + r) * 136 + 16 * ks + 8 * hh), bv = *(const LAS bf16x8*)(WP + (32 * nt + r) * 136 + 16 * ks + 8 * hh);
          acc = mfma32(av, bv, acc); }
      const int dcol = g * 128 + 32 * nt + r;
      bf16_t* MIX = (bf16_t*)(ws + WS_HB);
#pragma unroll
      for (int q = 0; q < 16; ++q) { const int jc = 32 * mt + (q & 3) + 8 * (q >> 2) + 4 * hh; MIX[(size_t)(row0 + jc) * D + dcol] = (bf16_t)pk2(acc[q] * psc, 0.f); } }
    __syncthreads();
}
__device__ __forceinline__ void pool_job(int l, int pj) {
    const int g = ((pj & 3) + (pj >> 5)) & 3;
    if (g == 0) pool_job_t<1>(l, pj, 0); else if (g == 1) pool_job_t<2>(l, pj, 1); else if (g == 2) pool_job_t<4>(l, pj, 2); else pool_job_t<8>(l, pj, 3);
}

__device__ __forceinline__ void gla_phase1(int l) {
    const int npl = (l < DEPTH - 1) ? 144 : 128;
    const int pflags = kargs()->flags;
    const int vb = mkctx().bid, x = vb >> 5, r = vb & 31;
    if (!(pflags & 4)) {
        const Ctx F = mkctx(); KArgs A = kargs(); unsigned char* const ws = A->ws;
        int lj = r; KvPre pre;
        const int rot = 0;
        if (lj < 144) kv_load(pre, F, A, l, x * 144 + (lj + rot) % 144);
        while (lj < 144) {
            const KvPre cur = pre; const int nj = lj + 32;
            if (nj < 144) kv_load(pre, F, A, l, x * 144 + (nj + rot) % 144);
            kv_compute(cur, F, ws, x * 144 + (lj + rot) % 144);
            lj = nj;
        }
    }
}

__device__ __forceinline__ void gla_phase2(int l) {
    const Ctx F = mkctx(); KArgs A = kargs(); unsigned char* const ws = A->ws;
    const int gid = F.bid * NTHR + F.tid; if (gid >= 64 * 2048) return;
    const int seq = gid >> 11, rem = gid & 2047, e = rem >> 4, dq = rem & 15, dir = seq & 1;
    bf16_t* base = (bf16_t*)(ws + WS_KVS) + (size_t)seq * NCH * 8192 + e * 64 + 4 * dq;
    const float* adec = (const float*)(ws + WS_ADEC) + (size_t)seq * NCH * 64 + 4 * dq;
    f32x4 S = {0.f, 0.f, 0.f, 0.f};
    for (int bt = 0; bt < 3; ++bt) {
        v2u kv[12]; f32x4 av[12];
#pragma unroll
        for (int i = 0; i < 12; ++i) { const int s = bt * 12 + i; const int jj = dir == 0 ? s : (s < 4 ? 3 - s : 39 - s);
            kv[i] = *(const GAS v2u*)(base + (size_t)jj * 8192); av[i] = *(const GAS f32x4*)(adec + jj * 64); }
#pragma unroll
        for (int i = 0; i < 12; ++i) { const int s = bt * 12 + i; const int jj = dir == 0 ? s : (s < 4 ? 3 - s : 39 - s);
            v2u o; o.x = pk2(S.x, S.y); o.y = pk2(S.z, S.w); *(GAS v2u*)(base + (size_t)jj * 8192) = o;
            const f32x4 k4 = {__builtin_bit_cast(float, kv[i].x << 16), __builtin_bit_cast(float, kv[i].x & 0xffff0000u), __builtin_bit_cast(float, kv[i].y << 16), __builtin_bit_cast(float, kv[i].y & 0xffff0000u)};
            S = av[i] * S + k4; }
    }
}

struct OutPre { DecPre dec; v4u q, k, v0, v1, g0, g1, sf0, sf1, sb0, sb1; f32x4 gg[4]; };
__device__ __forceinline__ void out_load(OutPre& p, const Ctx& F, KArgs A, int l, int job) {
    int b, h, j; kv_decode(job, b, h, j); const bf16_t* P = (const bf16_t*)(A->ws + WS_P); const int r0 = chunk_row0(b, j);
    decays_load(p.dec, F, P, (const bf16_t*)(A->ws + WS_WGP) + (size_t)l * 2 * 2 * 4 * 64 * 16, A->in.b_gk + (size_t)l * 2 * 256, r0, h);
    const int t = F.tid >> 3, dg = F.tid & 7; const bf16_t* pr = P + (size_t)(r0 + t) * PLD;
    p.q = __builtin_nontemporal_load((const GAS v4u*)(pr + 512 + h * 64 + 8 * dg)); p.k = __builtin_nontemporal_load((const GAS v4u*)(pr + 768 + h * 64 + 8 * dg));
    p.v0 = __builtin_nontemporal_load((const GAS v4u*)(pr + 1024 + h * 128 + 16 * dg)); p.v1 = __builtin_nontemporal_load((const GAS v4u*)(pr + 1024 + h * 128 + 16 * dg + 8));
    p.g0 = __builtin_nontemporal_load((const GAS v4u*)(pr + 1536 + h * 128 + 16 * dg)); p.g1 = __builtin_nontemporal_load((const GAS v4u*)(pr + 1536 + h * 128 + 16 * dg + 8));
#pragma unroll
    for (int c = 0; c < 4; ++c) p.gg[c] = *(const GAS f32x4*)(A->in.gla_gain + l * 128 + 16 * dg + 4 * c);
    const int e = F.tid >> 2, q4 = F.tid & 3; const bf16_t* sf = (const bf16_t*)(A->ws + WS_KVS) + ((size_t)((b * 4 + h) * 2) * NCH + j) * 8192 + e * 64 + 16 * q4;
    p.sf0 = __builtin_nontemporal_load((const GAS v4u*)sf); p.sf1 = __builtin_nontemporal_load((const GAS v4u*)(sf + 8)); p.sb0 = __builtin_nontemporal_load((const GAS v4u*)(sf + (size_t)NCH * 8192)); p.sb1 = __builtin_nontemporal_load((const GAS v4u*)(sf + (size_t)NCH * 8192 + 8));
}
__device__ __forceinline__ void out_compute(const OutPre& p, const Ctx& F, KArgs A, int l, int job) {
    int b, h, j; kv_decode(job, b, h, j); unsigned char* const ws = A->ws; const int r0 = chunk_row0(b, j);
    chunk_decays(F, p.dec);
    LAS float* LG = (LAS float*)(F.lds + G_LG);
    LAS bf16_t* KTF = (LAS bf16_t*)(F.lds + G_TMP); LAS bf16_t* KTB = KTF + 64 * 72;
    LAS bf16_t* AO = (LAS bf16_t*)(F.lds + G_AO); LAS bf16_t* VN = (LAS bf16_t*)(F.lds + G_VN); LAS bf16_t* BS = (LAS bf16_t*)(F.lds + G_BS);
    { const int t = F.tid >> 3, dg = F.tid & 7;
      float q[8], k[8]; unpack8(p.q, q); unpack8(p.k, k);
      float qf[8], qb[8], kf[8], kb[8];
#pragma unroll
      for (int i = 0; i < 8; ++i) { const int d = 8 * dg + i; const float bf = LG[t * 64 + d], bb = LG[(64 + t) * 64 + d];
          qf[i] = q[i] * __expf(bf); kf[i] = k[i] * __expf(-bf); qb[i] = q[i] * __expf(bb); kb[i] = k[i] * __expf(-bb); }
      *(LAS v4u*)(AO + t * 200 + 64 + 8 * dg) = pack8(qf); *(LAS v4u*)(AO + t * 200 + 128 + 8 * dg) = pack8(qb);
      *(LAS v4u*)(KTF + t * 72 + 8 * dg) = pack8(kf); *(LAS v4u*)(KTB + t * 72 + 8 * dg) = pack8(kb);
      *(LAS v4u*)(VN + t * 136 + 16 * dg) = p.v0; *(LAS v4u*)(VN + t * 136 + 16 * dg + 8) = p.v1; }
    { const int e = F.tid >> 2, q4 = F.tid & 3;
      *(LAS v4u*)(BS + e * 136 + 16 * q4) = p.sf0; *(LAS v4u*)(BS + e * 136 + 16 * q4 + 8) = p.sf1; *(LAS v4u*)(BS + e * 136 + 64 + 16 * q4) = p.sb0; *(LAS v4u*)(BS + e * 136 + 64 + 16 * q4 + 8) = p.sb1; }
    __syncthreads();
    const int mt = F.wave >> 2, nt = F.wave & 3, r = F.lane & 31, hh = F.lane >> 5;
    f32x16 acc = {0.f, 0.f, 0.f, 0.f, 0.f, 0.f, 0.f, 0.f, 0.f, 0.f, 0.f, 0.f, 0.f, 0.f, 0.f, 0.f};
    if (F.wave < 4) {
        const int tt = F.wave == 0 ? 0 : (F.wave == 1 ? 1 : (F.wave == 2 ? 1 : 0)), st = F.wave == 0 ? 0 : (F.wave == 1 ? 1 : (F.wave == 2 ? 0 : 1));
        const bool dof = F.wave != 3, dob = F.wave != 2;
        f32x16 af = {0.f, 0.f, 0.f, 0.f, 0.f, 0.f, 0.f, 0.f, 0.f, 0.f, 0.f, 0.f, 0.f, 0.f, 0.f, 0.f}, ab = af;
        if (dof) {
#pragma unroll
            for (int ks = 0; ks < 4; ++ks) af = mfma32(*(const LAS bf16x8*)(AO + (32 * tt + r) * 200 + 64 + 16 * ks + 8 * hh), *(const LAS bf16x8*)(KTF + (32 * st + r) * 72 + 16 * ks + 8 * hh), af); }
        if (dob) {
#pragma unroll
            for (int ks = 0; ks < 4; ++ks) ab = mfma32(*(const LAS bf16x8*)(AO + (32 * tt + r) * 200 + 128 + 16 * ks + 8 * hh), *(const LAS bf16x8*)(KTB + (32 * st + r) * 72 + 16 * ks + 8 * hh), ab); }
        const bool diag = tt == st;
#pragma unroll
        for (int g = 0; g < 16; ++g) { const int trow = (g & 3) + 8 * (g >> 2) + 4 * hh;
            float v = af[g] + ab[g];
            if (diag) v = (r <= trow ? af[g] : 0.f) + (r >= trow ? ab[g] : 0.f);
            AO[(32 * tt + trow) * 200 + 32 * st + r] = (bf16_t)pk2(v, 0.f); }
    }
#pragma unroll
    for (int ks = 4; ks < 12; ++ks) acc = mfma32(*(const LAS bf16x8*)(AO + (32 * mt + r) * 200 + 16 * ks + 8 * hh), *(const LAS bf16x8*)(BS + (32 * nt + r) * 136 + 16 * (ks - 4) + 8 * hh), acc);
    __syncthreads();
    {
#pragma unroll
      for (int ks = 0; ks < 4; ++ks) acc = mfma32(*(const LAS bf16x8*)(AO + (32 * mt + r) * 200 + 16 * ks + 8 * hh), tr_frag(VN, 136, 16 * ks, 32 * nt, F.lane), acc);
      LAS float* OUT = (LAS float*)(F.lds + G_OUT);
#pragma unroll
      for (int g = 0; g < 16; ++g) { const int trow = 32 * mt + (g & 3) + 8 * (g >> 2) + 4 * hh; OUT[trow * 132 + 32 * nt + r] = acc[g]; } }
    __syncthreads();
    { const int t = F.tid >> 3, eg = F.tid & 7; const LAS float* o = (const LAS float*)(F.lds + G_OUT) + t * 132 + 16 * eg;
      float ov[16]; float ss = 0.f;
#pragma unroll
      for (int i = 0; i < 4; ++i) { const f32x4 x4 = *(const LAS f32x4*)(o + 4 * i); ov[4 * i] = x4.x; ov[4 * i + 1] = x4.y; ov[4 * i + 2] = x4.z; ov[4 * i + 3] = x4.w; ss += (x4.x * x4.x + x4.y * x4.y) + (x4.z * x4.z + x4.w * x4.w); }
      ss += __shfl_xor(ss, 1); ss += __shfl_xor(ss, 2); ss += __shfl_xor(ss, 4);
      const float rinv = rsqrtf(ss * (1.f / 128.f) + 1e-6f);
      float gg[16];
#pragma unroll
      for (int c = 0; c < 4; ++c) { gg[4 * c] = p.gg[c].x; gg[4 * c + 1] = p.gg[c].y; gg[4 * c + 2] = p.gg[c].z; gg[4 * c + 3] = p.gg[c].w; }
      bf16_t* mp = (bf16_t*)(ws + WS_HB) + (size_t)(r0 + t) * D + 512 + h * 128 + 16 * eg;
#pragma unroll
      for (int c = 0; c < 2; ++c) { float gv[8]; unpack8(c ? p.g1 : p.g0, gv); float y[8];
#pragma unroll
          for (int i = 0; i < 8; ++i) { const float gx = gv[i]; y[i] = ov[8 * c + i] * rinv * gg[8 * c + i] * gx * __builtin_amdgcn_rcpf(1.f + __expf(-gx)); }
          *(GAS v4u*)(mp + 8 * c) = pack8(y); } }
    __syncthreads();
}
__device__ __forceinline__ int out_next(int l, int ls, int rot) { ls += 32; if (l == DEPTH - 1) while (ls < 144 && (((ls + rot) % 144) % NCH) < 4) ls += 32; return ls; }
__device__ __forceinline__ void gla_phase3(int l) {
    const Ctx F = mkctx(); KArgs A = kargs();
    const int x = F.bid >> 5, rot = 0; int ls = out_next(l, (F.bid & 31) - 32, rot); OutPre pre;
    if (ls < 144) out_load(pre, F, A, l, x * 144 + (ls + rot) % 144);
    while (ls < 144) {
        const OutPre cur = pre; const int ns = out_next(l, ls, rot);
        if (ns < 144) out_load(pre, F, A, l, x * 144 + (ns + rot) % 144);
        out_compute(cur, F, A, l, x * 144 + (ls + rot) % 144);
        ls = ns;
    }
    { const int npl = (l < DEPTH - 1) ? 144 : 128; const int r = F.bid & 31;
      for (int J = r; J < 144 + npl; J += 32) if (J >= 144) { const int lp = J - 144; pool_job(l, lp < 128 ? x * 128 + lp : 1024 + x * 16 + (lp - 128)); } }
}
#define HAVE_MOE 1
#define DPPF(x, ctrl) __builtin_bit_cast(float, __builtin_amdgcn_update_dpp(0, __builtin_bit_cast(int, (x)), (ctrl), 0xF, 0xF, true))
__device__ __forceinline__ float reduce16(const float (&a)[16], int lane) {
    float b8[8], b4[4], b2[2];
    bool h = (lane & 8) != 0;
#pragma unroll
    for (int i = 0; i < 8; ++i) { const float keep = h ? a[8 + i] : a[i], send = h ? a[i] : a[8 + i]; b8[i] = keep + DPPF(send, 0x140); }
    h = (lane & 4) != 0;
#pragma unroll
    for (int i = 0; i < 4; ++i) { const float keep = h ? b8[4 + i] : b8[i], send = h ? b8[i] : b8[4 + i]; b4[i] = keep + DPPF(send, 0x141); }
    h = (lane & 2) != 0;
#pragma unroll
    for (int i = 0; i < 2; ++i) { const float keep = h ? b4[2 + i] : b4[i], send = h ? b4[i] : b4[2 + i]; b2[i] = keep + DPPF(send, 0x4E); }
    h = (lane & 1) != 0;
    float r; { const float keep = h ? b2[1] : b2[0], send = h ? b2[0] : b2[1]; r = keep + DPPF(send, 0xB1); }
    r += __shfl_xor(r, 16); r += __shfl_xor(r, 32);
    return r;
}

__device__ __forceinline__ void router_phase(int l, int nrows) {
    const Ctx F = mkctx(); KArgs A = kargs(); unsigned char* const ws = A->ws;
    constexpr int WRS = D + 4;
    LAS float* WRT = (LAS float*)F.lds;
    LAS float* LGS = (LAS float*)(F.lds + 69632);
    LAS int* CNT = (LAS int*)(F.lds + 69632 + 2048);
    LAS int* BASE = CNT + 16;
    LAS int* ASG = (LAS int*)(F.lds + 69632 + 4096);
    { const float* wr = A->in.w_router;
      float wl[32];
#pragma unroll
      for (int c = 0; c < 32; ++c) wl[c] = wr[F.tid + NTHR * c];
#pragma unroll
      for (int c = 0; c < 32; ++c) { const int i = F.tid + NTHR * c; WRT[(i & 15) * WRS + (i >> 4)] = wl[c]; } }
    if (F.tid < 32) CNT[F.tid] = 0;
    __syncthreads();
    const bf16_t* XB = (const bf16_t*)(ws + WS_XB);
    const float* MODl = (const float*)(ws + WS_MOD) + (size_t)l * 9 * 6144;
    bf16_t* H = (bf16_t*)(ws + WS_HB);
    float* WTS = (float*)(ws + WS_WTS);
    const float rb_lane = A->in.router_bias[F.lane & 15];
    const int rpb = nrows / F.G, rpw = rpb / NWAVES;
    const int iblk = (F.bid & 31) * rpb, ibase = iblk + F.wave * rpw;
    LAS float* GT = (LAS float*)(F.lds + 77824); LAS float* ST = GT + 2048;
    const int v0 = variant_of_row(batch_row(F.bid, iblk)), v1 = variant_of_row(batch_row(F.bid, iblk + rpb - 1));
    { float tn[4], tsc[4], tsh[4];
#pragma unroll
      for (int c = 0; c < 4; ++c) { const int i = F.tid + NTHR * c, ti = i >> 10, k = i & 1023; const float* m = MODl + (size_t)(ti ? v1 : v0) * 6144;
          tn[c] = A->in.norm2[l * D + k]; tsc[c] = m[4 * D + k]; tsh[c] = m[3 * D + k]; }
#pragma unroll
      for (int c = 0; c < 4; ++c) { const int i = F.tid + NTHR * c; GT[i] = tn[c] * (1.f + tsc[c]); ST[i] = tsh[c]; } }
    v2u xq[3][4];
#pragma unroll
    for (int r = 0; r < 3; ++r) { const int rr = (r < rpw) ? r : rpw - 1;
#pragma unroll
        for (int j = 0; j < 4; ++j) xq[r][j] = *(const GAS v2u*)(XB + (size_t)batch_row(F.bid, ibase + rr) * D + 4 * F.lane + 256 * j); }
    __syncthreads();
    for (int g0 = 0; g0 < rpw; g0 += 3) {
        int lane_ = F.lane; asm volatile("" : "+v"(lane_));
        const int lane = lane_;
        f32x4 hx[3][4]; int rws[3]; bool vld[3];
#pragma unroll
        for (int r = 0; r < 3; ++r) {
            const int rr = (g0 + r < rpw) ? g0 + r : rpw - 1; rws[r] = batch_row(F.bid, ibase + rr); vld[r] = (g0 + r < rpw);
#pragma unroll
            for (int j = 0; j < 4; ++j) { const v2u a = xq[r][j];
                hx[r][j] = (f32x4){__builtin_bit_cast(float, a.x << 16), __builtin_bit_cast(float, a.x & 0xffff0000u), __builtin_bit_cast(float, a.y << 16), __builtin_bit_cast(float, a.y & 0xffff0000u)}; } }
        if (g0 + 3 < rpw) {
#pragma unroll
            for (int r = 0; r < 3; ++r) { const int rr = (g0 + 3 + r < rpw) ? g0 + 3 + r : rpw - 1;
#pragma unroll
                for (int j = 0; j < 4; ++j) xq[r][j] = *(const GAS v2u*)(XB + (size_t)batch_row(F.bid, ibase + rr) * D + 4 * lane + 256 * j); } }
#pragma unroll
        for (int r = 0; r < 3; ++r) { const int row = rws[r]; float ss = 0.f;
#pragma unroll
            for (int j = 0; j < 4; ++j) ss += (hx[r][j].x * hx[r][j].x + hx[r][j].y * hx[r][j].y) + (hx[r][j].z * hx[r][j].z + hx[r][j].w * hx[r][j].w);
            const float rinv = rsqrtf(wave_sum(ss) * (1.f / D) + 1e-6f);
            const int ti = variant_of_row(row) == v0 ? 0 : 1024;
#pragma unroll
            for (int j = 0; j < 4; ++j) { const int c0 = 4 * lane + 256 * j;
                const f32x4 gt = *(const LAS f32x4*)(GT + ti + c0), sh = *(const LAS f32x4*)(ST + ti + c0);
                const f32x4 h = hx[r][j] * rinv * gt + sh; hx[r][j] = h;
                if (vld[r]) { v2u o; o.x = pk2(h.x, h.y); o.y = pk2(h.z, h.w); *(GAS v2u*)(H + (size_t)row * D + c0) = o; } }
        }
#pragma unroll
        for (int r = 0; r < 3; ++r)
#pragma unroll
            for (int j = 0; j < 4; ++j) asm volatile("" : "+v"(hx[r][j]));
        typedef float f32x2 __attribute__((ext_vector_type(2)));
        float acc[3][16];
#pragma unroll
        for (int e = 0; e < 16; ++e) {
            f32x2 a2[3] = {{0.f, 0.f}, {0.f, 0.f}, {0.f, 0.f}};
#pragma unroll
            for (int j = 0; j < 4; ++j) { const f32x4 w = *(const LAS f32x4*)(WRT + e * WRS + 4 * lane + 256 * j); const f32x2 wl = {w.x, w.y}, wh = {w.z, w.w};
#pragma unroll
                for (int r = 0; r < 3; ++r) { const f32x2 xl = {hx[r][j].x, hx[r][j].y}, xh = {hx[r][j].z, hx[r][j].w}; a2[r] = __builtin_elementwise_fma(xl, wl, a2[r]); a2[r] = __builtin_elementwise_fma(xh, wh, a2[r]); } }
#pragma unroll
            for (int r = 0; r < 3; ++r) acc[r][e] = a2[r].x + a2[r].y;
            asm volatile("" : "+v"(acc[0][e]), "+v"(acc[1][e]), "+v"(acc[2][e]) :: "memory");
        }
        float tot3[3];
#pragma unroll
        for (int r = 0; r < 3; ++r) tot3[r] = reduce16(acc[r], lane);
        { const int q = lane >> 4, e = lane & 15, g = e >> 2, jp = e & 3;
          const float val = q == 0 ? tot3[0] : (q == 1 ? tot3[1] : tot3[2]);
          const float sg = sigmoid_f(val), sb = sg + rb_lane;
          const float va = DPPF(sb, 0x4E), vb = DPPF(sb, 0xB1), vc = DPPF(sb, 0x1B);
          const float hi1 = fmaxf(sb, va), lo1 = fminf(sb, va), hi2 = fmaxf(vb, vc), lo2 = fminf(vb, vc);
          const float gs = fmaxf(hi1, hi2) + fmaxf(fminf(hi1, hi2), fmaxf(lo1, lo2));
          const float gb = DPPF(gs, 0x141), gc = DPPF(gs, 0x140), ga = DPPF(gb, 0x140);
          float bestv = gs; int bestg = g;
          { const int ia = g ^ 2; if (ga > bestv || (ga == bestv && ia < bestg)) { bestv = ga; bestg = ia; } }
          { const int ib = g ^ 1; if (gb > bestv || (gb == bestv && ib < bestg)) { bestv = gb; bestg = ib; } }
          { const int ic = g ^ 3; if (gc > bestv || (gc == bestv && ic < bestg)) { bestv = gc; bestg = ic; } }
          const int rank = ((va > sb || (va == sb && (jp ^ 2) < jp)) ? 1 : 0) + ((vb > sb || (vb == sb && (jp ^ 1) < jp)) ? 1 : 0) + ((vc > sb || (vc == sb && (jp ^ 3) < jp)) ? 1 : 0);
          if (q < 3 && g == bestg && rank < 2) { LGS[((F.wave * 3 + q) * 2 + rank) * 2] = __builtin_bit_cast(float, e); LGS[((F.wave * 3 + q) * 2 + rank) * 2 + 1] = sg; } }
        LDS_WAIT(); asm volatile("" ::: "memory");
        if ((lane & 15) == 0 && (lane >> 4) < 3 && g0 + (lane >> 4) < rpw) { const int q = lane >> 4;
            const LAS float* sl = LGS + (F.wave * 3 + q) * 4;
            const int e0 = __builtin_bit_cast(int, sl[0]), e1 = __builtin_bit_cast(int, sl[2]); const float s0 = sl[1], s1 = sl[3];
            const int rl = F.wave * rpw + g0 + q, row = batch_row(F.bid, iblk + rl);
            const float wsum = s0 + s1;
            WTS[row * 2] = s0 / wsum; WTS[row * 2 + 1] = s1 / wsum;
            const int p0 = __hip_atomic_fetch_add(CNT + e0, 1, __ATOMIC_RELAXED, __HIP_MEMORY_SCOPE_WORKGROUP);
            const int p1 = __hip_atomic_fetch_add(CNT + e1, 1, __ATOMIC_RELAXED, __HIP_MEMORY_SCOPE_WORKGROUP);
            ASG[rl * 4 + 0] = e0; ASG[rl * 4 + 1] = p0; ASG[rl * 4 + 2] = e1; ASG[rl * 4 + 3] = p1;
        }
        LDS_WAIT(); asm volatile("" ::: "memory");
    }
    __syncthreads();
    gu32* ecnt = (gu32*)(ws + WS_CTL) + CW_ECNT + l * NE * 64;
    if (F.tid < NE) BASE[F.tid] = (int)__hip_atomic_fetch_add(ecnt + F.tid * 64, (unsigned)CNT[F.tid], __ATOMIC_RELAXED, __HIP_MEMORY_SCOPE_AGENT);
    __syncthreads();
    int* LIST = (int*)(ws + WS_LIST); int* TOK = (int*)(ws + WS_TOK);
    if (F.tid < rpb) { const int row = batch_row(F.bid, iblk + F.tid);
#pragma unroll
        for (int k = 0; k < 2; ++k) { const int e = ASG[F.tid * 4 + 2 * k], p = ASG[F.tid * 4 + 2 * k + 1] + BASE[e]; LIST[e * NT + p] = row; TOK[row * 2 + k] = e | (p << 4); } }
}
enum { PH_PRO = 0, PH_N1 = 0, PH_GIN = 1, PH_G1 = 2, PH_G2 = 3, PH_G3 = 4, PH_GOUT = 5, PH_R2 = 6, PH_GUP = 7, PH_GDN = 8, PH_PER_LAYER = 9, PH_FINAL = 1 + 9 * DEPTH, PH_END = PH_FINAL + 1 };

__global__ void __launch_bounds__(NTHR, 2) mega_fwd(Args args_unused) {
    LAS unsigned char* const lds = (LAS unsigned char*)lds_raw;
    volatile LAS unsigned* MISC = (volatile LAS unsigned*)(lds + MISC_OFF);
    for (int u = threadIdx.x; u < (LDS_BYTES - LDSCTL_OFF) / 4; u += NTHR) ((LAS unsigned*)(lds + LDSCTL_OFF))[u] = 0u;
    __syncthreads();
    if (threadIdx.x == 0) { MISC[12] = blockIdx.x; MISC[13] = 0u; }
    __syncthreads();
    int lo, hi; bool comb_en; unsigned* barw;
    bool probe16;
    { KArgs A = kargs(); lo = A->ph_lo; hi = A->ph_hi; comb_en = (A->flags & 1) != 0; probe16 = (A->flags & 16) != 0; if (probe16) comb_en = true; barw = (unsigned*)(A->ws + WS_CTL) + CW_BAR; }
    const bool multi = (hi - lo) > 1;
    XcdBarrier bar; bar.bar = barw; bar.x = 0; bar.st = nullptr;
    if (multi) bar = xcd_barrier_post(barw, MISC + 8);
    for (int ph = lo; ph < hi; ++ph) {
        if (ph == PH_PRO) {
            p0_prologue();
        } else if (ph == PH_FINAL) {
            rowpass_n1<true, false>(DEPTH, comb_en, NX, false);
        } else {
            const int l = (ph - 1) / PH_PER_LAYER, s = (ph - 1) % PH_PER_LAYER;
            const bool keep = l < DEPTH - 1;
            if (s == PH_N1) {
                if (l == 0 && !probe16) rowpass_n1<false, true>(l, false, NT, false); else rowpass_n1<false, false>(l, comb_en && l > 0, NT, probe16);
            } else if (s == PH_GIN || s == PH_GOUT || s == PH_GUP || s == PH_GDN) {
                KArgs A = kargs(); unsigned char* const ws = A->ws;
                const LAS int* tab = (const LAS int*)(lds + LDSCTL_OFF);
                pg8::GCfg S; S.list = (const int*)(ws + WS_LIST); S.tab = tab; S.amode = 0; S.bmode = 0; S.bexp = 0; S.K = D; S.Abase = (const char*)(ws + WS_HB);
                S.O = nullptr; S.ldc = 0; S.xl = nullptr; S.xc = nullptr; S.MODl = nullptr; S.gidx = 0; S.gscale = (A->flags & 8) ? 0.f : 1.f;
                int nM, nN;
                if (s == PH_GIN) { nM = NT / 256; nN = PLD / 256; S.Bbase = (const char*)(ws + WS_WIN) + (size_t)l * PLD * D * 2; S.emode = 0; S.O = (bf16_t*)(ws + WS_P); S.ldc = PLD; }
                else if (s == PH_GOUT) { nM = (keep ? NT : NX) / 256; nN = D / 256; S.Bbase = (const char*)(ws + WS_WOUT) + (size_t)l * D * D * 2; S.emode = 1;
                    S.O = (bf16_t*)(ws + WS_XB); S.MODl = (const float*)(ws + WS_MOD) + (size_t)l * 9 * 6144; S.gidx = 2; }
                else {
                    { LAS int* t = (LAS int*)(lds + LDSCTL_OFF); const gu32* ec = (const gu32*)(ws + WS_CTL) + CW_ECNT + l * NE * 64;
                      if (s == PH_GUP || !multi) if (threadIdx.x < 64) {
                          const int ln = (int)threadIdx.x; const int cnt = ln < NE ? (int)__hip_atomic_load(ec + ln * 64, RLX_AGENT) : 0; const int tl = (cnt + 255) >> 8; int inc = tl;
#pragma unroll
                          for (int o = 1; o < 16; o <<= 1) { const int v = __shfl_up(inc, o, 16); if ((ln & 15) >= o) inc += v; }
                          if (ln < NE) { t[32 + ln] = cnt; t[ln] = inc - tl; if (ln == NE - 1) t[16] = inc; } }
                      __syncthreads(); }
                    nM = tab[16]; nN = 4; S.bmode = 1;
                    if (s == PH_GUP) { S.amode = 1; S.Bbase = (const char*)(ws + WS_W13) + (size_t)l * NE * 1024 * D * 2; S.bexp = (size_t)1024 * D * 2; S.emode = 2; S.O = (bf16_t*)(ws + WS_HID); S.ldc = DE; }
                    else { S.K = DE; S.Abase = (const char*)(ws + WS_HID); S.Bbase = (const char*)(ws + WS_W2) + (size_t)l * NE * D * DE * 2; S.bexp = (size_t)D * DE * 2; S.emode = 0; S.O = (bf16_t*)(ws + WS_P); S.ldc = D; }
                }
                const int vb = mkctx().bid;
                const int npm = (s == PH_GIN) ? 9 : (s == PH_GOUT ? (keep ? 9 : 8) : -1);
                const int hsplit = (s == PH_GOUT && keep) ? 1 : 0;
                S.T.init(nM, nN, gridDim.x, vb, npm, s == PH_GDN ? 1 : 0, hsplit);
                pg8::gemm_phase(lds, S);
                {
                    int rounds, mine;
                    { const int xq = vb >> 5, nloc = (npm > 0 ? npm : ((xq + 1) * nM / 8 - xq * nM / 8)) * nN + (hsplit ? nN : 0), r = vb & 31; rounds = (nloc + 31) / 32; mine = r < nloc ? (nloc - r + 31) / 32 : 0; }
                    if (mine < rounds) convert_from_cursor(l, s == PH_GDN ? 2 : 3);
                    if (s == PH_GDN && keep) convert_from_cursor(l + 1, -1, CV_EARLY);
                }
            }
#ifdef HAVE_GLA
            else if (s == PH_G1) { gla_phase1(l); if ((mkctx().bid & 31) >= 16) convert_from_cursor(l, 1); }
            else if (s == PH_G2) { gla_phase2(l); }
            else if (s == PH_G3) { gla_phase3(l); }
#endif
#ifdef HAVE_MOE
            else if (s == PH_R2) { router_phase(l, keep ? NT : NX); convert_from_cursor(l, -1); }
#endif
        }
        if (ph + 1 < hi) {
            const int sdone = ph == PH_PRO ? -1 : (ph - 1) % PH_PER_LAYER;
            if (MISC[13] != 0u && ((sdone >= PH_N1 && sdone <= PH_GOUT) || sdone == PH_GUP)) xcd_barrier_local(bar); else
            xcd_barrier(bar);
#ifdef PROBE_BAR2
            xcd_barrier(bar);
#endif
        }
    }
}

static bool g_init_done = false;
static void launch_mega(const In& I, float* out, unsigned char* ws, int lo, int hi, int flags, hipStream_t st) {
    if (!g_init_done) { (void)hipFuncSetAttribute((const void*)mega_fwd, hipFuncAttributeMaxDynamicSharedMemorySize, LDS_BYTES); g_init_done = true; }
    Args a{}; a.in = I; a.out = out; a.ws = ws; a.ph_lo = lo; a.ph_hi = hi; a.flags = flags; a.pad = 0;
    hipLaunchKernelGGL(mega_fwd, dim3(256), dim3(NTHR), LDS_BYTES, st, a);
}

#ifndef FUSED
#ifndef OPT_PRO
#define OPT_PRO 1
#endif
#ifndef OPT_A
#define OPT_A 1
#endif
#ifndef OPT_B
#define OPT_B 0
#endif
#ifndef OPT_C
#define OPT_C 1
#endif
#ifndef OPT_D
#define OPT_D 0
#endif
static void run_hybrid(const In& I, float* out, unsigned char* ws, hipStream_t st) {
    float* xc = (float*)(ws + WS_XC); float* MOD = (float*)(ws + WS_MOD); bf16_t* HB = (bf16_t*)(ws + WS_HB); bf16_t* P = (bf16_t*)(ws + WS_P);
    float* OF = (float*)(ws + WS_KVS); float* OB = (float*)(ws + WS_HID); float* HIDN = (float*)(ws + WS_P);
    int* EIDX = (int*)(ws + WS_NEIDX); float* WTSN = (float*)(ws + WS_NWTS);
    (void)hipMemsetAsync(ws + WS_CTL, 0, CTL_BYTES, st);
    const int flags = OPT_D ? 1 : 0;
    if (OPT_PRO) launch_mega(I, out, ws, PH_PRO, PH_PRO + 1, flags, st);
    else nv::k_mod<<<(DEPTH * 6144 + 255) / 256, 256, 0, st>>>(I.c, I.c_ctx, I.w_mod, I.b_mod, MOD);
    if (!OPT_A) { (void)hipMemcpyAsync(out, I.x, (size_t)NX * D * 4, hipMemcpyDeviceToDevice, st); (void)hipMemcpyAsync(xc, I.ctx, (size_t)NC * D * 4, hipMemcpyDeviceToDevice, st); }
    for (int l = 0; l < DEPTH; ++l) {
        const bool keep = l < DEPTH - 1; const int Mo = keep ? NT : NX;
        const float* MODl = MOD + (size_t)l * 9 * 6144;
        const int pb = 1 + l * PH_PER_LAYER;
        if (OPT_A) { launch_mega(I, out, ws, pb + PH_N1, pb + PH_N1 + 1, flags, st); launch_mega(I, out, ws, pb + PH_GIN, pb + PH_GIN + 1, flags, st); }
        else {
            if (OPT_D && l > 0) launch_mega(I, out, ws, pb + PH_N1, pb + PH_N1 + 1, flags, st);
            nv::k_normmod<<<NT, 256, 0, st>>>(out, xc, I.norm1 + l * D, MODl, 0, 1, HB, NT);
            nv::k_gemm<<<dim3((INW + 63) / 64, NT / 64), 256, 0, st>>>(HB, D, I.w_in + (size_t)l * D * INW, INW, P, PLD, NT, INW, D, 0, nullptr, 0, nullptr, nullptr, 512, 768);
        }
        if (OPT_B) { for (int s = PH_G1; s <= PH_G3; ++s) launch_mega(I, out, ws, pb + s, pb + s + 1, flags, st); }
        else {
            nv::k_gla<<<NB * 4, 256, 0, st>>>(P, I.w_gk2 + (size_t)l * 2 * 16 * 256, I.b_gk + (size_t)l * 2 * 256, OF, OB);
            nv::k_pool<<<NT, 512, 0, st>>>(P, I.w_pool + (size_t)l * 4 * 128 * 128, I.pool_scale + l * 512, HB);
            nv::k_glaout<<<NT, 512, 0, st>>>(P, OF, OB, I.gla_gain + l * 128, HB);
        }
        if (OPT_C) launch_mega(I, out, ws, pb + PH_GOUT, pb + PH_GOUT + 1, flags, st);
        else nv::k_gemm<<<dim3(D / 64, Mo / 64), 256, 0, st>>>(HB, D, I.w_out + (size_t)l * D * D, D, nullptr, 0, Mo, D, D, 1, MODl, 2, out, xc, 0, 0);
        if (OPT_D) { for (int s = PH_R2; s <= PH_GDN; ++s) launch_mega(I, out, ws, pb + s, pb + s + 1, flags, st); }
        else {
            nv::k_normmod<<<Mo, 256, 0, st>>>(out, xc, I.norm2 + l * D, MODl, 3, 4, HB, Mo);
            nv::k_router<<<Mo, 64, 0, st>>>(out, xc, I.norm2 + l * D, MODl, I.w_router, I.router_bias, EIDX, WTSN, Mo);
            nv::k_moe_up<<<Mo * 2, 512, 0, st>>>(HB, EIDX, I.w1 + (size_t)l * NE * D * DE, I.w3 + (size_t)l * NE * D * DE, HIDN);
            nv::k_moe_down_combine<<<Mo, 256, 0, st>>>(HIDN, EIDX, WTSN, I.w2 + (size_t)l * NE * DE * D, MODl, out, xc);
        }
    }
    if (OPT_D) launch_mega(I, out, ws, PH_FINAL, PH_FINAL + 1, flags, st);
    else nv::k_final<<<NX, 256, 0, st>>>(out, I.norm_f);
}

#endif
extern "C" void kernel_launch(void* const* d_in, const int* in_sizes, int n_in, void* d_out, int out_size, void* d_ws, size_t ws_size, hipStream_t stream) {
    In I;
    const float** f = (const float**)&I;
    for (int i = 0; i < 21; ++i) f[i] = (const float*)d_in[i];
    if (ws_size < WS_END) { fprintf(stderr, "ws too small: %zu < %zu\n", ws_size, (size_t)WS_END); return; }
#ifdef FUSED
    (void)hipMemsetAsync((unsigned char*)d_ws + WS_CTL, 0, CTL_BYTES, stream);
    launch_mega(I, (float*)d_out, (unsigned char*)d_ws, 0, PH_END, 1, stream);
#ifndef PROBE_FLAGS
#define PROBE_FLAGS 0
#endif
#ifdef PROBE_KIND
    if (PROBE_KIND < 0) launch_mega(I, (float*)d_out, (unsigned char*)d_ws, PH_PRO, PH_PRO + 1, 0, stream);
    else for (int l = 0; l < DEPTH; ++l) launch_mega(I, (float*)d_out, (unsigned char*)d_ws, 1 + l * PH_PER_LAYER + PROBE_KIND, 1 + l * PH_PER_LAYER + PROBE_KIND + 1, PROBE_FLAGS, stream);
#endif
#else
    run_hybrid(I, (float*)d_out, (unsigned char*)d_ws, stream);
#endif
}
```
